# Optimizing an MI355X kernel written in HIP

```python
import jax
import jax.numpy as jnp
from jax import lax
import numpy as np

D_MODEL = 1024
BATCH = 2
SEQ = 8192
DEPTH = 2
DEC_BATCH = 2
DEC_SEQ = 16384
PAST_LEN = 128

BRANCH_W = 256
N_BRANCH = 4
EPS = 1e-6
NEG_INF = -1e30

HEAD_DIM = 64
ATTN_GROUPS = ((128, 1), (512, 4), (2048, 16))
N_GROUPS = 3
HEADS_PER_GROUP = 4
N_ATTN_HEADS = N_GROUPS * HEADS_PER_GROUP
ATTN_QKV = N_ATTN_HEADS * HEAD_DIM
HALF_KEYS = 64
Q_BLOCK = 128

POOL_WINDOWS = (2, 4, 8, 16)
POOL_GROUP = BRANCH_W // 4

CHUNK = 128
SG_GROUPS = 4
SG_GROUP_W = BRANCH_W // SG_GROUPS

RWKV_HEADS = 4
RWKV_N = BRANCH_W // RWKV_HEADS
DECAY_RANK = 64
AAA_RANK = 64
LAT_W = DECAY_RANK + AAA_RANK
N_DIRS = 2
GN_EPS = 64e-5

SEG_WIDTHS = (3 * ATTN_QKV, BRANCH_W, BRANCH_W, BRANCH_W, 2 * BRANCH_W, BRANCH_W, 3 * BRANCH_W, N_DIRS * LAT_W, BRANCH_W, N_BRANCH * D_MODEL)
PROJ_WIDTH = 3 * ATTN_QKV + 10 * BRANCH_W + N_DIRS * LAT_W + N_BRANCH * D_MODEL

kernel_name = "hybrid_bidir_encoder"


def rms_norm(x, g):
    xf = x.astype(jnp.float32)
    y = xf * lax.rsqrt(jnp.mean(xf * xf, axis=-1, keepdims=True) + EPS)
    return (y * g.astype(jnp.float32)).astype(x.dtype)


def dilated_attention(q, k, v, q_norm_g, k_norm_g):
    B, S, _ = q.shape

    def split_heads(t):
        return t.reshape(B, S, N_GROUPS, HEADS_PER_GROUP, HEAD_DIM).transpose(0, 2, 3, 1, 4)

    qh = split_heads(rms_norm(q.reshape(B, S, N_ATTN_HEADS, HEAD_DIM), q_norm_g)) * (HEAD_DIM ** -0.5)
    kh = split_heads(rms_norm(k.reshape(B, S, N_ATTN_HEADS, HEAD_DIM), k_norm_g))
    vh = split_heads(v)
    dil = jnp.array([d for _, d in ATTN_GROUPS], dtype=jnp.int32)
    offsets = dil[:, None] * jnp.arange(-HALF_KEYS, HALF_KEYS + 1, dtype=jnp.int32)[None, :]
    slopes = 2.0 ** (-8.0 * jnp.arange(1, N_ATTN_HEADS + 1, dtype=jnp.float32) / N_ATTN_HEADS)
    bias = -slopes.reshape(N_GROUPS, HEADS_PER_GROUP)[:, :, None] * jnp.abs(offsets).astype(jnp.float32)[:, None, :]
    gather = jax.vmap(lambda t, ii: t[:, :, ii], in_axes=(1, 0), out_axes=1)

    def attend_block(i):
        start = i * Q_BLOCK
        pos = start + jnp.arange(Q_BLOCK, dtype=jnp.int32)
        idx = pos[None, :, None] + offsets[:, None, :]
        valid = (idx >= 0) & (idx < S)
        idx = jnp.clip(idx, 0, S - 1)
        qb = lax.dynamic_slice_in_dim(qh, start, Q_BLOCK, axis=3)
        kb = gather(kh, idx)
        vb = gather(vh, idx)
        s = jnp.einsum('bghqd,bghqwd->bghqw', qb, kb).astype(jnp.float32) + bias[None, :, :, None, :]
        s = jnp.where(valid[None, :, None], s, NEG_INF)
        lse = jax.nn.logsumexp(s, axis=-1)
        p = jnp.exp(s - lse[..., None])
        o = jnp.einsum('bghqw,bghqwd->bghqd', p.astype(vb.dtype), vb)
        alpha = jax.nn.softmax(lse, axis=1)
        return jnp.einsum('bghq,bghqd->bhqd', alpha.astype(o.dtype), o)

    out = lax.map(attend_block, jnp.arange(S // Q_BLOCK, dtype=jnp.int32))
    return out.transpose(1, 0, 3, 2, 4).reshape(B, S, HEADS_PER_GROUP * HEAD_DIM)


def pool_mixer(u, pool_w, pool_scale):
    B, S, _ = u.shape
    uf = u.astype(jnp.float32)
    t = jnp.arange(S)
    diffs = []
    for gi, w in enumerate(POOL_WINDOWS):
        h = w // 2
        ug = uf[..., gi * POOL_GROUP:(gi + 1) * POOL_GROUP]
        padded = jnp.pad(ug, ((0, 0), (h, h), (0, 0)))
        cs = jnp.concatenate([jnp.zeros_like(padded[:, :1]), jnp.cumsum(padded, axis=1)], axis=1)
        win_sum = cs[:, 2 * h:2 * h + S] - cs[:, :S]
        count = (jnp.minimum(t + h, S) - jnp.maximum(t - h, 0)).astype(jnp.float32)
        diffs.append(win_sum / count[None, :, None] - ug)
    d = jnp.stack(diffs, axis=2)
    y = jnp.einsum('bsgc,gce->bsge', d, pool_w.astype(jnp.float32)).reshape(B, S, BRANCH_W)
    return (y * pool_scale.astype(jnp.float32)).astype(u.dtype)


def spatial_gating(uv, sg_norm_g, sg_w, sg_b):
    B, S, _ = uv.shape
    u, v = jnp.split(uv, 2, axis=-1)
    v = rms_norm(v, sg_norm_g).reshape(B, S // CHUNK, CHUNK, SG_GROUPS, SG_GROUP_W)
    sv = jnp.einsum('gts,bcsgd->bctgd', sg_w, v) + sg_b.T[None, None, :, :, None]
    return u * sv.reshape(B, S, BRANCH_W)


def token_shift(x, direction):
    if direction == 0:
        return jnp.pad(x, ((0, 0), (1, 0), (0, 0)))[:, :-1]
    return jnp.pad(x, ((0, 0), (0, 1), (0, 0)))[:, 1:]


def rwkv_step(state, inp):
    r, decay, k, v, kk, a = inp[0], inp[1], inp[2], inp[3], inp[4], inp[5]
    sa = jnp.einsum('...ij,...j->...i', state, -kk)
    state = state * decay[..., None, :] + sa[..., :, None] * (kk * a)[..., None, :] + v[..., :, None] * k[..., None, :]
    return state, jnp.einsum('...ij,...j->...i', state, r)


def rwkv7_bidirectional(rkv, lat, mu_rkv, mu_lat, w0, w_up, a0, a_up, k_k, k_a, r_k, ln_g, ln_b):
    B, S, _ = rkv.shape
    dtype = rkv.dtype
    rkv = rkv.astype(jnp.float32)
    lat = lat.astype(jnp.float32)

    def heads(t):
        return t.reshape(t.shape[:-1] + (RWKV_HEADS, RWKV_N))

    lat_dirs = jnp.split(lat, N_DIRS, axis=-1)
    seqs, bonus = [], []
    for d in range(N_DIRS):
        xr = rkv + (token_shift(rkv, d) - rkv) * mu_rkv[d]
        xl = lat_dirs[d] + (token_shift(lat_dirs[d], d) - lat_dirs[d]) * mu_lat[d]
        r, k, v = (heads(t) for t in jnp.split(xr, 3, axis=-1))
        lw, la = jnp.split(xl, [DECAY_RANK], axis=-1)
        w_log = -jax.nn.softplus(-(w0[d] + jnp.tanh(lw) @ w_up[d])) - 0.5
        decay = heads(jnp.exp(-jnp.exp(w_log)))
        a = heads(jax.nn.sigmoid(a0[d] + la @ a_up[d]))
        kk = k * heads(k_k[d])
        kk = kk * lax.rsqrt(jnp.sum(kk * kk, axis=-1, keepdims=True) + 1e-12)
        k = k * (1.0 + (a - 1.0) * heads(k_a[d]))
        bonus.append((jnp.sum(r * k * heads(r_k[d]), axis=-1, keepdims=True) * v).reshape(B, S, BRANCH_W))
        step_in = jnp.stack([r, decay, k, v, kk, a], axis=0)
        if d == 1:
            step_in = step_in[:, :, ::-1]
        seqs.append(step_in)
    xs = jnp.moveaxis(jnp.stack(seqs, axis=1), 3, 0)
    state0 = jnp.zeros((N_DIRS, B, RWKV_HEADS, RWKV_N, RWKV_N), jnp.float32)
    _, o = lax.scan(rwkv_step, state0, xs)
    o = jnp.moveaxis(o, 0, 2)
    outs = (o[0], o[1][:, ::-1])
    y = 0.0
    for d in range(N_DIRS):
        od = outs[d]
        mu = jnp.mean(od, axis=-1, keepdims=True)
        var = jnp.mean(jnp.square(od - mu), axis=-1, keepdims=True)
        on = ((od - mu) * lax.rsqrt(var + GN_EPS)).reshape(B, S, BRANCH_W) * ln_g + ln_b
        y = y + on + bonus[d]
    return y.astype(dtype)


def encoder_layer(x, norm_g, w_in, q_norm_g, k_norm_g, pool_w, pool_scale, sg_norm_g, sg_w, sg_b,
                  mu_rkv, mu_lat, w0, w_up, a0, a_up, k_k, k_a, r_k, ln_g, ln_b, w_branch, w_out):
    B, S, _ = x.shape
    h = rms_norm(x, norm_g)
    proj = jnp.einsum('bsd,de->bse', h, w_in)
    split_points = [int(p) for p in np.cumsum(SEG_WIDTHS)[:-1]]
    qkv, z_a, u_b, z_b, uv_c, z_c, rkv_d, lat_d, z_d, gate_logits = jnp.split(proj, split_points, axis=-1)
    q, k, v = jnp.split(qkv, 3, axis=-1)
    y_a = dilated_attention(q, k, v, q_norm_g, k_norm_g)
    y_b = pool_mixer(u_b, pool_w, pool_scale)
    y_c = spatial_gating(uv_c, sg_norm_g, sg_w, sg_b)
    y_d = rwkv7_bidirectional(rkv_d, lat_d, mu_rkv, mu_lat, w0, w_up, a0, a_up, k_k, k_a, r_k, ln_g, ln_b)
    ys = jnp.stack([(y * jax.nn.silu(z)).astype(x.dtype)
                    for y, z in ((y_a, z_a), (y_b, z_b), (y_c, z_c), (y_d, z_d))], axis=2)
    branch = jnp.einsum('bsnc,ncd->bsnd', ys, w_branch)
    gates = jax.nn.sigmoid(gate_logits.reshape(B, S, N_BRANCH, D_MODEL))
    merged = jnp.sum(gates * branch, axis=2)
    return x + jnp.einsum('bsd,de->bse', merged, w_out)


def encoder_trunk(x, params):
    for l in range(DEPTH):
        x = encoder_layer(x, *[p[l] for p in params])
    return x


def setup_inputs(seed: int = 0) -> dict:
    key = jax.random.key(seed)
    ks = jax.random.split(key, 24)
    L = DEPTH

    def nrm(k, shape, scale):
        return jax.random.normal(k, shape, jnp.float32) * scale

    return {
        "x_prompt": nrm(ks[0], (BATCH, SEQ, D_MODEL), 1.0),
        "x_sample": nrm(ks[1], (DEC_BATCH, DEC_SEQ, D_MODEL), 1.0),
        "norm_g": 1.0 + nrm(ks[2], (L, D_MODEL), 0.02),
        "w_in": nrm(ks[3], (L, D_MODEL, PROJ_WIDTH), D_MODEL ** -0.5),
        "q_norm_g": 1.0 + nrm(ks[4], (L, HEAD_DIM), 0.02),
        "k_norm_g": 1.0 + nrm(ks[5], (L, HEAD_DIM), 0.02),
        "pool_w": nrm(ks[6], (L, len(POOL_WINDOWS), POOL_GROUP, POOL_GROUP), POOL_GROUP ** -0.5),
        "pool_scale": 1.0 + nrm(ks[7], (L, BRANCH_W), 0.02),
        "sg_norm_g": 1.0 + nrm(ks[8], (L, BRANCH_W), 0.02),
        "sg_w": nrm(ks[9], (L, SG_GROUPS, CHUNK, CHUNK), CHUNK ** -0.5),
        "sg_b": 1.0 + nrm(ks[10], (L, SG_GROUPS, CHUNK), 0.02),
        "mu_rkv": jax.random.uniform(ks[11], (L, N_DIRS, 3 * BRANCH_W), jnp.float32),
        "mu_lat": jax.random.uniform(ks[12], (L, N_DIRS, LAT_W), jnp.float32),
        "w0": jax.random.uniform(ks[13], (L, N_DIRS, BRANCH_W), jnp.float32, minval=-6.0, maxval=1.0),
        "w_up": nrm(ks[14], (L, N_DIRS, DECAY_RANK, BRANCH_W), 0.1),
        "a0": nrm(ks[15], (L, N_DIRS, BRANCH_W), 0.1),
        "a_up": nrm(ks[16], (L, N_DIRS, AAA_RANK, BRANCH_W), 0.1),
        "k_k": 0.85 + nrm(ks[17], (L, N_DIRS, BRANCH_W), 0.02),
        "k_a": 1.0 + nrm(ks[18], (L, N_DIRS, BRANCH_W), 0.02),
        "r_k": nrm(ks[19], (L, N_DIRS, BRANCH_W), 0.1),
        "ln_g": 1.0 + nrm(ks[20], (L, BRANCH_W), 0.02),
        "ln_b": nrm(ks[21], (L, BRANCH_W), 0.02),
        "w_branch": nrm(ks[22], (L, N_BRANCH, BRANCH_W, D_MODEL), BRANCH_W ** -0.5),
        "w_out": nrm(ks[23], (L, D_MODEL, D_MODEL), D_MODEL ** -0.5),
    }


def reference(x_prompt, x_sample, norm_g, w_in, q_norm_g, k_norm_g, pool_w, pool_scale, sg_norm_g, sg_w, sg_b,
              mu_rkv, mu_lat, w0, w_up, a0, a_up, k_k, k_a, r_k, ln_g, ln_b, w_branch, w_out):
    params = (norm_g, w_in, q_norm_g, k_norm_g, pool_w, pool_scale, sg_norm_g, sg_w, sg_b,
              mu_rkv, mu_lat, w0, w_up, a0, a_up, k_k, k_a, r_k, ln_g, ln_b, w_branch, w_out)
    y_prompt = encoder_trunk(x_prompt, params)
    y_sample = encoder_trunk(x_sample, params)
    return (y_prompt, y_sample)
```

```cpp
#include <hip/hip_runtime.h>
#include <hip/hip_cooperative_groups.h>
#include <cstdio>
namespace cg = cooperative_groups;

#ifndef MULTI_LAUNCH
#define MULTI_LAUNCH 0
#endif

typedef unsigned short bf16_t;
typedef short bf16x8 __attribute__((ext_vector_type(8)));
typedef float f32x4 __attribute__((ext_vector_type(4)));
typedef __bf16 bf2v __attribute__((ext_vector_type(2)));

constexpr int MTOK = 49152;
constexpr int DM = 1024;
constexpr int PW = 9216;
constexpr int QKVW = 2304;
constexpr int RESTW = 1792;
constexpr int SMEM_BYTES = 140 * 1024;
constexpr int NPH = 9;

struct Params {
  const float* xp; const float* xs;
  const float* norm_g; const float* w_in; const float* q_norm_g; const float* k_norm_g;
  const float* pool_w; const float* pool_scale; const float* sg_norm_g; const float* sg_w; const float* sg_b;
  const float* mu_rkv; const float* mu_lat; const float* w0; const float* w_up; const float* a0; const float* a_up;
  const float* k_k; const float* k_a; const float* r_k; const float* ln_g; const float* ln_b;
  const float* w_branch; const float* w_out;
  float* out;
  bf16_t* qkv; bf16_t* rest; bf16_t* ys;
  bf16_t* w1t; bf16_t* wgt; bf16_t* wbrt; bf16_t* woutt;
  float* rstd; float* pg; bf16_t* branch;
  int phase_lo, phase_hi;
};

__device__ __forceinline__ float bf2f(bf16_t v) { return __uint_as_float(((unsigned)v) << 16); }
__device__ __forceinline__ bf16_t f2bf(float f) { unsigned u = __float_as_uint(f); u += 0x7fffu + ((u >> 16) & 1u); return (bf16_t)(u >> 16); }
__device__ __forceinline__ unsigned pack2(float a, float b) { return (unsigned)f2bf(a) | ((unsigned)f2bf(b) << 16); }
__device__ __forceinline__ float sigmoidf_(float x) { return 1.f / (1.f + __expf(-x)); }
__device__ __forceinline__ float wave_sum(float v) {
#pragma unroll
  for (int o = 32; o >= 1; o >>= 1) v += __shfl_xor(v, o);
  return v;
}
__device__ __forceinline__ const float* xrow_ptr(const Params& p, int layer, int row) {
  if (layer == 0) return row < 16384 ? p.xp + (size_t)row * DM : p.xs + (size_t)(row - 16384) * DM;
  return p.out + (size_t)row * DM;
}
__device__ __forceinline__ void seq_of(int T0, int& sstart, int& slen) {
  if (T0 < 16384) { sstart = T0 & ~8191; slen = 8192; } else { sstart = 16384 + ((T0 - 16384) & ~16383); slen = 16384; }
}

__device__ void phase_prep(const Params& p, int layer) {
  const int tid = threadIdx.x, lane = tid & 63;
  const int gw = (blockIdx.x * 256 + tid) >> 6, nw = gridDim.x * 4;
  for (int row = gw; row < MTOK; row += nw) {
    const float4* x = (const float4*)xrow_ptr(p, layer, row);
    float ss = 0.f;
#pragma unroll
    for (int i = 0; i < 4; ++i) { float4 v = x[lane + i * 64]; ss += v.x * v.x + v.y * v.y + v.z * v.z + v.w * v.w; }
    ss = wave_sum(ss);
    if (lane == 0) p.rstd[row] = rsqrtf(ss * (1.f / 1024.f) + 1e-6f);
  }
  const float* w_in = p.w_in + (size_t)layer * DM * PW;
  const float* ng = p.norm_g + layer * DM;
  const long gt = (long)blockIdx.x * 256 + tid, nthr = (long)gridDim.x * 256;
  for (long idx = gt; idx < 5120L * 128; idx += nthr) {
    int n = (int)(idx % 5120), kc = (int)(idx / 5120);
    int col;
    if (n < 2304) col = n; else if (n < 2560) col = 2560 + (n - 2304); else if (n < 3072) col = 3072 + (n - 2560);
    else if (n < 3840) col = 3840 + (n - 3072); else if (n < 4096) col = 4608 + (n - 3840);
    else if (n < 4352) col = 2304 + (n - 4096); else if (n < 4608) col = 2816 + (n - 4352);
    else if (n < 4864) col = 3584 + (n - 4608); else col = 4864 + (n - 4864);
    float v[8];
#pragma unroll
    for (int j = 0; j < 8; ++j) { int k = kc * 8 + j; v[j] = ng[k] * w_in[(size_t)k * PW + col]; }
    uint4 o; o.x = pack2(v[0], v[1]); o.y = pack2(v[2], v[3]); o.z = pack2(v[4], v[5]); o.w = pack2(v[6], v[7]);
    *(uint4*)(p.w1t + (size_t)n * 1024 + kc * 8) = o;
  }
  for (long idx = gt; idx < 4096L * 128; idx += nthr) {
    int n = (int)(idx % 4096), kc = (int)(idx / 4096);
    int tn = n >> 7, c = n & 127, wn = c >> 6, b = (c >> 4) & 3, dl = c & 15;
    int col = 5120 + b * 1024 + tn * 32 + wn * 16 + dl;
    float v[8];
#pragma unroll
    for (int j = 0; j < 8; ++j) { int k = kc * 8 + j; v[j] = ng[k] * w_in[(size_t)k * PW + col]; }
    uint4 o; o.x = pack2(v[0], v[1]); o.y = pack2(v[2], v[3]); o.z = pack2(v[4], v[5]); o.w = pack2(v[6], v[7]);
    *(uint4*)(p.wgt + (size_t)n * 1024 + kc * 8) = o;
  }
  const float* wb = p.w_branch + (size_t)layer * 4 * 256 * 1024;
  for (long idx = gt; idx < 4096L * 32; idx += nthr) {
    int n = (int)(idx % 4096), kc = (int)(idx / 4096);
    int b = n >> 10, d = n & 1023;
    float v[8];
#pragma unroll
    for (int j = 0; j < 8; ++j) { int k = kc * 8 + j; v[j] = wb[((size_t)b * 256 + k) * 1024 + d]; }
    uint4 o; o.x = pack2(v[0], v[1]); o.y = pack2(v[2], v[3]); o.z = pack2(v[4], v[5]); o.w = pack2(v[6], v[7]);
    *(uint4*)(p.wbrt + (size_t)n * 256 + kc * 8) = o;
  }
  const float* wo = p.w_out + (size_t)layer * 1024 * 1024;
  for (long idx = gt; idx < 1024L * 128; idx += nthr) {
    int n = (int)(idx % 1024), kc = (int)(idx / 1024);
    float v[8];
#pragma unroll
    for (int j = 0; j < 8; ++j) { int k = kc * 8 + j; v[j] = wo[(size_t)k * 1024 + n]; }
    uint4 o; o.x = pack2(v[0], v[1]); o.y = pack2(v[2], v[3]); o.z = pack2(v[4], v[5]); o.w = pack2(v[6], v[7]);
    *(uint4*)(p.woutt + (size_t)n * 1024 + kc * 8) = o;
  }
}

__device__ __forceinline__ int lds_off(int r, int c) { return r * 128 + ((c ^ ((r >> 1) & 7)) << 4); }

template <bool AF32>
__device__ __forceinline__ void gemm_core(f32x4 (&acc)[4][4], const void* Aptr, int lda, const bf16_t* Bt, int ldb, int K, unsigned char* smem) {
  const int tid = threadIdx.x, lane = tid & 63, wave = tid >> 6, wm = wave >> 1, wn = wave & 1;
  float4 ra[AF32 ? 8 : 1]; uint4 rab[AF32 ? 1 : 4]; uint4 rb[4];
  const int nt = K >> 6;
  auto gload = [&](int t) {
#pragma unroll
    for (int i = 0; i < 4; ++i) {
      int id = tid + i * 256, r = id >> 3, c = id & 7;
      if (AF32) { const float* a = (const float*)Aptr + (size_t)r * lda + t * 64 + c * 8; ra[i * 2] = *(const float4*)a; ra[i * 2 + 1] = *(const float4*)(a + 4); }
      else { const bf16_t* a = (const bf16_t*)Aptr + (size_t)r * lda + t * 64 + c * 8; rab[i] = *(const uint4*)a; }
      rb[i] = *(const uint4*)(Bt + (size_t)r * ldb + t * 64 + c * 8);
    }
  };
  auto lwrite = [&](int b) {
#pragma unroll
    for (int i = 0; i < 4; ++i) {
      int id = tid + i * 256, r = id >> 3, c = id & 7; int off = lds_off(r, c);
      unsigned char* sa_ = smem + b * 32768; unsigned char* sb_ = sa_ + 16384;
      if (AF32) { uint4 o; o.x = pack2(ra[i * 2].x, ra[i * 2].y); o.y = pack2(ra[i * 2].z, ra[i * 2].w); o.z = pack2(ra[i * 2 + 1].x, ra[i * 2 + 1].y); o.w = pack2(ra[i * 2 + 1].z, ra[i * 2 + 1].w); *(uint4*)(sa_ + off) = o; }
      else *(uint4*)(sa_ + off) = rab[i];
      *(uint4*)(sb_ + off) = rb[i];
    }
  };
  gload(0); lwrite(0); __syncthreads();
  for (int t = 0; t < nt; ++t) {
    if (t + 1 < nt) gload(t + 1);
    const unsigned char* a_ = smem + (t & 1) * 32768; const unsigned char* b_ = a_ + 16384;
#pragma unroll
    for (int ks = 0; ks < 2; ++ks) {
      bf16x8 af[4], bfr[4];
      const int c = ks * 4 + (lane >> 4);
#pragma unroll
      for (int m = 0; m < 4; ++m) { int r = wm * 64 + m * 16 + (lane & 15); af[m] = *(const bf16x8*)(a_ + lds_off(r, c)); }
#pragma unroll
      for (int n = 0; n < 4; ++n) { int r = wn * 64 + n * 16 + (lane & 15); bfr[n] = *(const bf16x8*)(b_ + lds_off(r, c)); }
#pragma unroll
      for (int m = 0; m < 4; ++m)
#pragma unroll
        for (int n = 0; n < 4; ++n) acc[m][n] = __builtin_amdgcn_mfma_f32_16x16x32_bf16(bfr[n], af[m], acc[m][n], 0, 0, 0);
    }
    if (t + 1 < nt) lwrite((t + 1) & 1);
    __syncthreads();
  }
}

__device__ __forceinline__ void zero_acc(f32x4 (&acc)[4][4]) {
#pragma unroll
  for (int m = 0; m < 4; ++m)
#pragma unroll
    for (int n = 0; n < 4; ++n) acc[m][n] = (f32x4){0.f, 0.f, 0.f, 0.f};
}

__device__ void phase_g1(const Params& p, int layer, unsigned char* smem) {
  const int lane = threadIdx.x & 63, wave = threadIdx.x >> 6, wm = wave >> 1, wn = wave & 1;
  for (int tile = blockIdx.x; tile < 384 * 40; tile += gridDim.x) {
    const int tm = tile / 40, tn = tile % 40, row0 = tm * 128, col0 = tn * 128;
    f32x4 acc[4][4]; zero_acc(acc);
    gemm_core<true>(acc, xrow_ptr(p, layer, row0), DM, p.w1t + (size_t)col0 * 1024, 1024, 1024, smem);
#pragma unroll
    for (int m = 0; m < 4; ++m) {
      const int row = row0 + wm * 64 + m * 16 + (lane & 15);
      const float rs = p.rstd[row];
#pragma unroll
      for (int n = 0; n < 4; ++n) {
        const int col = col0 + wn * 64 + n * 16 + (lane >> 4) * 4;
        float v0 = acc[m][n][0] * rs, v1 = acc[m][n][1] * rs, v2 = acc[m][n][2] * rs, v3 = acc[m][n][3] * rs;
        bf16_t* dst;
        if (col < QKVW) dst = p.qkv + (size_t)row * QKVW + col;
        else if (col < 4096) dst = p.rest + (size_t)row * RESTW + (col - QKVW);
        else { dst = p.ys + (size_t)row * 1024 + (col - 4096); v0 *= sigmoidf_(v0); v1 *= sigmoidf_(v1); v2 *= sigmoidf_(v2); v3 *= sigmoidf_(v3); }
        uint2 o; o.x = pack2(v0, v1); o.y = pack2(v2, v3);
        *(uint2*)dst = o;
      }
    }
  }
}

__device__ void phase_branch(const Params& p, unsigned char* smem) {
  const int lane = threadIdx.x & 63, wave = threadIdx.x >> 6, wm = wave >> 1, wn = wave & 1;
  for (int tile = blockIdx.x; tile < 384 * 32; tile += gridDim.x) {
    const int tm = tile / 32, tn = tile % 32, row0 = tm * 128, col0 = tn * 128, b = tn >> 3;
    f32x4 acc[4][4]; zero_acc(acc);
    gemm_core<false>(acc, p.ys + (size_t)row0 * 1024 + b * 256, 1024, p.wbrt + (size_t)col0 * 256, 256, 256, smem);
#pragma unroll
    for (int m = 0; m < 4; ++m) {
      const int row = row0 + wm * 64 + m * 16 + (lane & 15);
#pragma unroll
      for (int n = 0; n < 4; ++n) {
        const int col = col0 + wn * 64 + n * 16 + (lane >> 4) * 4;
        uint2 o; o.x = pack2(acc[m][n][0], acc[m][n][1]); o.y = pack2(acc[m][n][2], acc[m][n][3]);
        *(uint2*)(p.branch + (size_t)row * 4096 + col) = o;
      }
    }
  }
}

__device__ void phase_gate(const Params& p, int layer, unsigned char* smem) {
  const int lane = threadIdx.x & 63, wave = threadIdx.x >> 6, wm = wave >> 1, wn = wave & 1;
  for (int tile = blockIdx.x; tile < 384 * 32; tile += gridDim.x) {
    const int tm = tile / 32, tn = tile % 32, row0 = tm * 128;
    f32x4 acc[4][4]; zero_acc(acc);
    gemm_core<true>(acc, xrow_ptr(p, layer, row0), DM, p.wgt + (size_t)tn * 128 * 1024, 1024, 1024, smem);
#pragma unroll
    for (int m = 0; m < 4; ++m) {
      const int row = row0 + wm * 64 + m * 16 + (lane & 15);
      const float rs = p.rstd[row];
      const int d = tn * 32 + wn * 16 + (lane >> 4) * 4;
      float s0 = 0.f, s1 = 0.f, s2 = 0.f, s3 = 0.f;
#pragma unroll
      for (int b = 0; b < 4; ++b) {
        uint2 br = *(const uint2*)(p.branch + (size_t)row * 4096 + b * 1024 + d);
        s0 += sigmoidf_(acc[m][b][0] * rs) * __uint_as_float(br.x << 16);
        s1 += sigmoidf_(acc[m][b][1] * rs) * __uint_as_float(br.x & 0xffff0000u);
        s2 += sigmoidf_(acc[m][b][2] * rs) * __uint_as_float(br.y << 16);
        s3 += sigmoidf_(acc[m][b][3] * rs) * __uint_as_float(br.y & 0xffff0000u);
      }
      uint2 o; o.x = pack2(s0, s1); o.y = pack2(s2, s3);
      *(uint2*)(p.ys + (size_t)row * 1024 + d) = o;
    }
  }
}

__device__ void phase_out(const Params& p, int layer, unsigned char* smem) {
  const int lane = threadIdx.x & 63, wave = threadIdx.x >> 6, wm = wave >> 1, wn = wave & 1;
  for (int tile = blockIdx.x; tile < 384 * 8; tile += gridDim.x) {
    const int tm = tile / 8, tn = tile % 8, row0 = tm * 128, col0 = tn * 128;
    f32x4 acc[4][4]; zero_acc(acc);
    gemm_core<false>(acc, p.ys + (size_t)row0 * 1024, 1024, p.woutt + (size_t)col0 * 1024, 1024, 1024, smem);
#pragma unroll
    for (int m = 0; m < 4; ++m) {
      const int row = row0 + wm * 64 + m * 16 + (lane & 15);
      const float* xr = xrow_ptr(p, layer, row);
#pragma unroll
      for (int n = 0; n < 4; ++n) {
        const int col = col0 + wn * 64 + n * 16 + (lane >> 4) * 4;
        float4 xv = *(const float4*)(xr + col);
        float4 o; o.x = xv.x + acc[m][n][0]; o.y = xv.y + acc[m][n][1]; o.z = xv.z + acc[m][n][2]; o.w = xv.w + acc[m][n][3];
        *(float4*)(p.out + (size_t)row * 1024 + col) = o;
      }
    }
  }
}

constexpr int KROW = 136;

template <int NC>
__device__ __forceinline__ void attn_sub(const Params& p, int layer, int sstart, int slen, int P0, int n, int d, int r, int i0,
                                         float* num, float* den, unsigned char* kt, unsigned char* vt) {
  constexpr int NQ = 256 / NC;
  constexpr int NROWS = NQ + 128;
  const int tid = threadIdx.x;
  const float* kg = p.k_norm_g + layer * 64;
  const float* qg = p.q_norm_g + layer * 64;
  for (int rr = tid >> 2; rr < ((NROWS + 63) & ~63); rr += 64) {
    const int part = tid & 3;
    const int pos = d * (i0 - 64 + rr) + r;
    const bool ok = (rr < NROWS) && pos >= 0 && pos < slen;
    uint4 k0 = {0, 0, 0, 0}, k1 = {0, 0, 0, 0}, v0 = {0, 0, 0, 0}, v1 = {0, 0, 0, 0};
    if (ok) {
      const bf16_t* base = p.qkv + (size_t)(sstart + pos) * QKVW + n * 64 + part * 16;
      k0 = *(const uint4*)(base + 768); k1 = *(const uint4*)(base + 768 + 8);
      v0 = *(const uint4*)(base + 1536); v1 = *(const uint4*)(base + 1536 + 8);
    }
    unsigned kw[8] = {k0.x, k0.y, k0.z, k0.w, k1.x, k1.y, k1.z, k1.w};
    float kf[16]; float ss = 0.f;
#pragma unroll
    for (int j = 0; j < 8; ++j) { kf[2 * j] = __uint_as_float(kw[j] << 16); kf[2 * j + 1] = __uint_as_float(kw[j] & 0xffff0000u); ss += kf[2 * j] * kf[2 * j] + kf[2 * j + 1] * kf[2 * j + 1]; }
    ss += __shfl_xor(ss, 1); ss += __shfl_xor(ss, 2);
    const float rs = rsqrtf(ss * (1.f / 64.f) + 1e-6f);
    if (rr < NROWS) {
      unsigned* kd = (unsigned*)(kt + rr * KROW + part * 32);
      unsigned* vd = (unsigned*)(vt + rr * KROW + part * 32);
#pragma unroll
      for (int j = 0; j < 8; ++j) kd[j] = pack2(kf[2 * j] * rs * kg[part * 16 + 2 * j], kf[2 * j + 1] * rs * kg[part * 16 + 2 * j + 1]);
      vd[0] = v0.x; vd[1] = v0.y; vd[2] = v0.z; vd[3] = v0.w; vd[4] = v1.x; vd[5] = v1.y; vd[6] = v1.z; vd[7] = v1.w;
    }
  }
  const int q = tid / NC, c = tid % NC;
  const int pq = d * (i0 + q) + r;
  unsigned qp2[32];
  {
    const uint4* qp = (const uint4*)(p.qkv + (size_t)(sstart + pq) * QKVW + n * 64);
    float qv[64];
    float ss = 0.f;
#pragma unroll
    for (int j = 0; j < 8; ++j) {
      uint4 w = qp[j]; unsigned ww[4] = {w.x, w.y, w.z, w.w};
#pragma unroll
      for (int e = 0; e < 4; ++e) { float a = __uint_as_float(ww[e] << 16), b = __uint_as_float(ww[e] & 0xffff0000u); qv[j * 8 + e * 2] = a; qv[j * 8 + e * 2 + 1] = b; ss += a * a + b * b; }
    }
    const float rs = rsqrtf(ss * (1.f / 64.f) + 1e-6f) * 0.125f;
#pragma unroll
    for (int e = 0; e < 32; ++e) qp2[e] = pack2(qv[2 * e] * rs * qg[2 * e], qv[2 * e + 1] * rs * qg[2 * e + 1]);
  }
  __syncthreads();
  const float slope = exp2f(-8.f * (float)(n + 1) / 12.f) * (float)d;
  float acc[64];
#pragma unroll
  for (int e = 0; e < 64; ++e) acc[e] = 0.f;
  float dacc = 0.f;
  for (int m = c; m < 129; m += NC) {
    const int kr = q + m;
    const int pos = d * (i0 - 64 + kr) + r;
    const bool ok = pos >= 0 && pos < slen;
    const uint2* kp = (const uint2*)(kt + kr * KROW);
    float s = 0.f;
#pragma unroll
    for (int j = 0; j < 16; ++j) {
      uint2 w = kp[j];
      s = __builtin_amdgcn_fdot2_f32_bf16(__builtin_bit_cast(bf2v, qp2[2 * j]), __builtin_bit_cast(bf2v, w.x), s, false);
      s = __builtin_amdgcn_fdot2_f32_bf16(__builtin_bit_cast(bf2v, qp2[2 * j + 1]), __builtin_bit_cast(bf2v, w.y), s, false);
    }
    s -= slope * fabsf((float)(m - 64));
    const float pe = ok ? __expf(s) : 0.f;
    dacc += pe;
    const uint2* vp = (const uint2*)(vt + kr * KROW);
#pragma unroll
    for (int j = 0; j < 16; ++j) {
      uint2 w = vp[j];
      acc[4 * j] += pe * __uint_as_float(w.x << 16); acc[4 * j + 1] += pe * __uint_as_float(w.x & 0xffff0000u);
      acc[4 * j + 2] += pe * __uint_as_float(w.y << 16); acc[4 * j + 3] += pe * __uint_as_float(w.y & 0xffff0000u);
    }
  }
#pragma unroll
  for (int o = 1; o < NC; o <<= 1) {
    dacc += __shfl_xor(dacc, o);
#pragma unroll
    for (int e = 0; e < 64; ++e) acc[e] += __shfl_xor(acc[e], o);
  }
  if (c == 0) {
    const int pl = pq - P0;
    float* np = num + pl * 65;
#pragma unroll
    for (int e = 0; e < 64; ++e) np[e] += acc[e];
    den[pl] += dacc;
  }
  __syncthreads();
}

__device__ void attn_item(const Params& p, int layer, int item, unsigned char* smem) {
  const int tid = threadIdx.x;
  const int h = item & 3, blk = item >> 2, T0 = blk * 256;
  int sstart, slen; seq_of(T0, sstart, slen);
  const int P0 = T0 - sstart;
  float* num = (float*)smem;
  float* den = num + 256 * 65;
  unsigned char* kt = (unsigned char*)(den + 256);
  unsigned char* vt = kt + 192 * KROW;
  for (int i = tid; i < 256 * 65 + 256; i += 256) num[i] = 0.f;
  __syncthreads();
  for (int s = 0; s < 4; ++s) attn_sub<4>(p, layer, sstart, slen, P0, 0 * 4 + h, 1, 0, P0 + 64 * s, num, den, kt, vt);
  for (int r = 0; r < 4; ++r) attn_sub<4>(p, layer, sstart, slen, P0, 1 * 4 + h, 4, r, P0 / 4, num, den, kt, vt);
  for (int r = 0; r < 16; ++r) attn_sub<16>(p, layer, sstart, slen, P0, 2 * 4 + h, 16, r, P0 / 16, num, den, kt, vt);
  for (int it = 0; it < 64; ++it) {
    const int idx = it * 256 + tid, pl = idx >> 6, e = idx & 63;
    bf16_t* y = p.ys + (size_t)(T0 + pl) * 1024 + h * 64 + e;
    *y = f2bf(bf2f(*y) * num[pl * 65 + e] / den[pl]);
  }
  __syncthreads();
}

__device__ void pool_item(const Params& p, int layer, int item, unsigned char* smem) {
  const int tid = threadIdx.x;
  const int g = item & 3, T0 = (item >> 2) * 64;
  int sstart, slen; seq_of(T0, sstart, slen);
  const int P0 = T0 - sstart;
  const int hw = 1 << g;
  float* u = (float*)smem;
  float* dd = u + 80 * 64;
  float* w = dd + 64 * 65;
  for (int i = tid; i < 80 * 64; i += 256) {
    const int rr = i >> 6, c = i & 63, pos = P0 - 8 + rr;
    u[i] = (pos >= 0 && pos < slen) ? bf2f(p.rest[(size_t)(sstart + pos) * RESTW + g * 64 + c]) : 0.f;
  }
  const float* pw = p.pool_w + ((size_t)layer * 4 + g) * 4096;
  for (int i = tid; i < 4096; i += 256) w[i] = pw[i];
  __syncthreads();
  for (int i = tid; i < 64 * 64; i += 256) {
    const int t = i >> 6, c = i & 63, pos = P0 + t;
    float s = 0.f;
    for (int o = -hw; o < hw; ++o) s += u[(t + 8 + o) * 64 + c];
    const int lo = pos - hw > 0 ? pos - hw : 0, hi = pos + hw < slen ? pos + hw : slen;
    dd[t * 65 + c] = s / (float)(hi - lo) - u[(t + 8) * 64 + c];
  }
  __syncthreads();
  {
    const int t = tid >> 2, e0 = (tid & 3) * 16;
    float acc[16];
#pragma unroll
    for (int e = 0; e < 16; ++e) acc[e] = 0.f;
    for (int c = 0; c < 64; ++c) {
      const float dv = dd[t * 65 + c];
#pragma unroll
      for (int e = 0; e < 16; ++e) acc[e] += dv * w[c * 64 + e0 + e];
    }
    const float* sc = p.pool_scale + layer * 256 + g * 64 + e0;
    bf16_t* y = p.ys + (size_t)(T0 + t) * 1024 + 256 + g * 64 + e0;
#pragma unroll
    for (int e = 0; e < 16; ++e) y[e] = f2bf(bf2f(y[e]) * acc[e] * sc[e]);
  }
  __syncthreads();
}

__device__ void sg_item(const Params& p, int layer, int item, unsigned char* smem) {
  const int tid = threadIdx.x, lane = tid & 63, wave = tid >> 6;
  const int g = item & 3, T0 = (item >> 2) * 128;
  float* vn = (float*)smem;
  float* sw = vn + 128 * 64;
  for (int s = wave; s < 128; s += 4) {
    const bf16_t* vr = p.rest + (size_t)(T0 + s) * RESTW + 512;
    float ss = 0.f; float mine = 0.f;
#pragma unroll
    for (int j = 0; j < 4; ++j) { float v = bf2f(vr[j * 64 + lane]); ss += v * v; if (j == g) mine = v; }
    ss = wave_sum(ss);
    const float rs = rsqrtf(ss * (1.f / 256.f) + 1e-6f);
    vn[s * 64 + lane] = mine * rs * p.sg_norm_g[layer * 256 + g * 64 + lane];
  }
  const float* gw = p.sg_w + ((size_t)layer * 4 + g) * 128 * 128;
  for (int i = tid; i < 128 * 128; i += 256) sw[(i >> 7) * 129 + (i & 127)] = gw[i];
  __syncthreads();
  {
    const int t = tid >> 1, d0 = (tid & 1) * 32;
    float acc[32];
#pragma unroll
    for (int e = 0; e < 32; ++e) acc[e] = 0.f;
    for (int s = 0; s < 128; ++s) {
      const float wv = sw[t * 129 + s];
      const float4* vp = (const float4*)(vn + s * 64 + d0);
#pragma unroll
      for (int e = 0; e < 8; ++e) { float4 v = vp[e]; acc[4 * e] += wv * v.x; acc[4 * e + 1] += wv * v.y; acc[4 * e + 2] += wv * v.z; acc[4 * e + 3] += wv * v.w; }
    }
    const float bias = p.sg_b[(layer * 4 + g) * 128 + t];
    const bf16_t* ur = p.rest + (size_t)(T0 + t) * RESTW + 256 + g * 64 + d0;
    bf16_t* y = p.ys + (size_t)(T0 + t) * 1024 + 512 + g * 64 + d0;
#pragma unroll
    for (int e = 0; e < 32; ++e) y[e] = f2bf(bf2f(y[e]) * bf2f(ur[e]) * (acc[e] + bias));
  }
  __syncthreads();
}

__device__ void phase_mix(const Params& p, int layer, unsigned char* smem) {
  const int NA = 768, NS = 1536, NP = 3072;
  for (int it = blockIdx.x; it < NA + NS + NP; it += gridDim.x) {
    if (it < NA) attn_item(p, layer, it, smem);
    else if (it < NA + NS) sg_item(p, layer, it - NA, smem);
    else pool_item(p, layer, it - NA - NS, smem);
  }
}

struct RwkvLds {
  float wup[64 * 64], aup[64 * 64];
  float tw[32 * 64], ta[32 * 64];
  float R[32 * 64], W[32 * 64], K[32 * 64], V[32 * 64], KK[32 * 64], B[32 * 64];
  float ot[32 * 64];
  float yt[128 * 64];
};

__device__ __forceinline__ float red8(float v) { v += __shfl_xor(v, 1); v += __shfl_xor(v, 2); v += __shfl_xor(v, 4); return v; }

template <bool PASS_C>
__device__ void rwkv_job(const Params& p, int layer, int job, unsigned char* smem) {
  RwkvLds& L = *(RwkvLds*)smem;
  const int tid = threadIdx.x, lane = tid & 63, wave = tid >> 6;
  const int hd = job & 3, cp = job >> 2, t0 = cp * 128;
  int sstart, slen; seq_of(t0, sstart, slen);
  const int send = sstart + slen;
  const int rp = tid >> 3, jg = tid & 7, row0 = rp * 2, j0 = jg * 8;
  if (PASS_C) { for (int i = tid; i < 128 * 64; i += 256) L.yt[i] = 0.f; }
  for (int dir = 0; dir < 2; ++dir) {
    const int ld = layer * 2 + dir;
    float* slot = p.pg + ((size_t)cp * 8 + dir * 4 + hd) * 8192;
    __syncthreads();
    for (int i = tid; i < 4096; i += 256) {
      const int m = i >> 6, j = i & 63;
      L.wup[i] = p.w_up[((size_t)ld * 64 + m) * 256 + hd * 64 + j];
      L.aup[i] = p.a_up[((size_t)ld * 64 + m) * 256 + hd * 64 + j];
    }
    float S[2][8], Pst[2][8];
#pragma unroll
    for (int rr = 0; rr < 2; ++rr)
#pragma unroll
      for (int j = 0; j < 8; ++j) {
        if (PASS_C) { S[rr][j] = slot[4096 + (row0 + rr) * 64 + j0 + j]; Pst[rr][j] = 0.f; }
        else { S[rr][j] = 0.f; Pst[rr][j] = (row0 + rr == j0 + j) ? 1.f : 0.f; }
      }
    const int cidx = hd * 64 + lane;
    const float mu_r = p.mu_rkv[ld * 768 + cidx], mu_k = p.mu_rkv[ld * 768 + 256 + cidx], mu_v = p.mu_rkv[ld * 768 + 512 + cidx];
    const float mu_w = p.mu_lat[ld * 128 + lane], mu_a = p.mu_lat[ld * 128 + 64 + lane];
    const float w0v = p.w0[ld * 256 + cidx], a0v = p.a0[ld * 256 + cidx];
    const float kkv = p.k_k[ld * 256 + cidx], kav = p.k_a[ld * 256 + cidx], rkv_ = p.r_k[ld * 256 + cidx];
    for (int sb = 0; sb < 4; ++sb) {
      __syncthreads();
#pragma unroll
      for (int i = 0; i < 8; ++i) {
        const int tk = wave * 8 + i, tau = sb * 32 + tk;
        const int t = dir ? (t0 + 127 - tau) : (t0 + tau);
        const int tp = dir ? t + 1 : t - 1;
        const bool pv = tp >= sstart && tp < send;
        const bf16_t* cr = p.rest + (size_t)t * RESTW;
        const bf16_t* pr = p.rest + (size_t)(pv ? tp : t) * RESTW;
        float cr_r = bf2f(cr[768 + cidx]), cr_k = bf2f(cr[1024 + cidx]), cr_v = bf2f(cr[1280 + cidx]);
        float cr_w = bf2f(cr[1536 + dir * 128 + lane]), cr_a = bf2f(cr[1536 + dir * 128 + 64 + lane]);
        float pr_r = 0.f, pr_k = 0.f, pr_v = 0.f, pr_w = 0.f, pr_a = 0.f;
        if (pv) { pr_r = bf2f(pr[768 + cidx]); pr_k = bf2f(pr[1024 + cidx]); pr_v = bf2f(pr[1280 + cidx]); pr_w = bf2f(pr[1536 + dir * 128 + lane]); pr_a = bf2f(pr[1536 + dir * 128 + 64 + lane]); }
        L.R[tk * 64 + lane] = cr_r + (pr_r - cr_r) * mu_r;
        L.K[tk * 64 + lane] = cr_k + (pr_k - cr_k) * mu_k;
        L.V[tk * 64 + lane] = cr_v + (pr_v - cr_v) * mu_v;
        L.tw[tk * 64 + lane] = tanhf(cr_w + (pr_w - cr_w) * mu_w);
        L.ta[tk * 64 + lane] = cr_a + (pr_a - cr_a) * mu_a;
      }
      __syncthreads();
      float accw[8], acca[8];
#pragma unroll
      for (int i = 0; i < 8; ++i) { accw[i] = 0.f; acca[i] = 0.f; }
      for (int m4 = 0; m4 < 16; ++m4) {
        float wu[4], au[4];
#pragma unroll
        for (int e = 0; e < 4; ++e) { wu[e] = L.wup[(m4 * 4 + e) * 64 + lane]; au[e] = L.aup[(m4 * 4 + e) * 64 + lane]; }
#pragma unroll
        for (int i = 0; i < 8; ++i) {
          const float4 tw4 = *(const float4*)(L.tw + (wave * 8 + i) * 64 + m4 * 4);
          const float4 ta4 = *(const float4*)(L.ta + (wave * 8 + i) * 64 + m4 * 4);
          accw[i] += tw4.x * wu[0] + tw4.y * wu[1] + tw4.z * wu[2] + tw4.w * wu[3];
          acca[i] += ta4.x * au[0] + ta4.y * au[1] + ta4.z * au[2] + ta4.w * au[3];
        }
      }
#pragma unroll
      for (int i = 0; i < 8; ++i) {
        const int tk = wave * 8 + i, tau = sb * 32 + tk;
        const int tl = dir ? (127 - tau) : tau;
        const float wpre = w0v + accw[i];
        const float nx = -wpre;
        const float sp = fmaxf(nx, 0.f) + log1pf(__expf(-fabsf(nx)));
        const float wlog = -sp - 0.5f;
        const float decay = __expf(-__expf(wlog));
        const float a = sigmoidf_(a0v + acca[i]);
        const float k = L.K[tk * 64 + lane], r = L.R[tk * 64 + lane], v = L.V[tk * 64 + lane];
        float kk = k * kkv;
        const float ss = wave_sum(kk * kk);
        kk *= rsqrtf(ss + 1e-12f);
        const float k2 = k * (1.f + (a - 1.f) * kav);
        const float bs = wave_sum(r * k2 * rkv_);
        L.W[tk * 64 + lane] = decay; L.K[tk * 64 + lane] = k2; L.KK[tk * 64 + lane] = kk; L.B[tk * 64 + lane] = kk * a;
        if (PASS_C) L.yt[tl * 64 + lane] += bs * v;
      }
      __syncthreads();
      for (int tk = 0; tk < 32; ++tk) {
        float w[8], b[8], kkr[8], k[8];
        {
          const float4* pw = (const float4*)(L.W + tk * 64 + j0); float4 x0 = pw[0], x1 = pw[1];
          w[0] = x0.x; w[1] = x0.y; w[2] = x0.z; w[3] = x0.w; w[4] = x1.x; w[5] = x1.y; w[6] = x1.z; w[7] = x1.w;
          const float4* pb = (const float4*)(L.B + tk * 64 + j0); x0 = pb[0]; x1 = pb[1];
          b[0] = x0.x; b[1] = x0.y; b[2] = x0.z; b[3] = x0.w; b[4] = x1.x; b[5] = x1.y; b[6] = x1.z; b[7] = x1.w;
          const float4* pk = (const float4*)(L.KK + tk * 64 + j0); x0 = pk[0]; x1 = pk[1];
          kkr[0] = x0.x; kkr[1] = x0.y; kkr[2] = x0.z; kkr[3] = x0.w; kkr[4] = x1.x; kkr[5] = x1.y; kkr[6] = x1.z; kkr[7] = x1.w;
          const float4* pk2 = (const float4*)(L.K + tk * 64 + j0); x0 = pk2[0]; x1 = pk2[1];
          k[0] = x0.x; k[1] = x0.y; k[2] = x0.z; k[3] = x0.w; k[4] = x1.x; k[5] = x1.y; k[6] = x1.z; k[7] = x1.w;
        }
        const float2 vv = *(const float2*)(L.V + tk * 64 + row0);
        const float vr[2] = {vv.x, vv.y};
        float sa[2] = {0.f, 0.f}, sp[2] = {0.f, 0.f};
#pragma unroll
        for (int rr = 0; rr < 2; ++rr)
#pragma unroll
          for (int j = 0; j < 8; ++j) { sa[rr] += S[rr][j] * kkr[j]; if (!PASS_C) sp[rr] += Pst[rr][j] * kkr[j]; }
        sa[0] = red8(sa[0]); sa[1] = red8(sa[1]);
        if (!PASS_C) { sp[0] = red8(sp[0]); sp[1] = red8(sp[1]); }
#pragma unroll
        for (int rr = 0; rr < 2; ++rr)
#pragma unroll
          for (int j = 0; j < 8; ++j) {
            S[rr][j] = S[rr][j] * w[j] + (vr[rr] * k[j] - sa[rr] * b[j]);
            if (!PASS_C) Pst[rr][j] = Pst[rr][j] * w[j] - sp[rr] * b[j];
          }
        if (PASS_C) {
          const float4* pr = (const float4*)(L.R + tk * 64 + j0); float4 x0 = pr[0], x1 = pr[1];
          const float rr_[8] = {x0.x, x0.y, x0.z, x0.w, x1.x, x1.y, x1.z, x1.w};
          float o0 = 0.f, o1 = 0.f;
#pragma unroll
          for (int j = 0; j < 8; ++j) { o0 += S[0][j] * rr_[j]; o1 += S[1][j] * rr_[j]; }
          o0 = red8(o0); o1 = red8(o1);
          if (jg == 0) { L.ot[tk * 64 + row0] = o0; L.ot[tk * 64 + row0 + 1] = o1; }
        }
      }
      if (PASS_C) {
        __syncthreads();
        const int tk = tid >> 3, part = tid & 7, tau = sb * 32 + tk;
        const int tl = dir ? (127 - tau) : tau;
        float o[8]; float s1 = 0.f;
#pragma unroll
        for (int e = 0; e < 8; ++e) { o[e] = L.ot[tk * 64 + part * 8 + e]; s1 += o[e]; }
        s1 = red8(s1);
        const float mu = s1 * (1.f / 64.f);
        float s2 = 0.f;
#pragma unroll
        for (int e = 0; e < 8; ++e) { o[e] -= mu; s2 += o[e] * o[e]; }
        s2 = red8(s2);
        const float rs = rsqrtf(s2 * (1.f / 64.f) + 64e-5f);
#pragma unroll
        for (int e = 0; e < 8; ++e) {
          const int ch = hd * 64 + part * 8 + e;
          L.yt[tl * 64 + part * 8 + e] += o[e] * rs * p.ln_g[layer * 256 + ch] + p.ln_b[layer * 256 + ch];
        }
      }
    }
    if (!PASS_C) {
#pragma unroll
      for (int rr = 0; rr < 2; ++rr)
#pragma unroll
        for (int j = 0; j < 8; ++j) { slot[(row0 + rr) * 64 + j0 + j] = Pst[rr][j]; slot[4096 + (row0 + rr) * 64 + j0 + j] = S[rr][j]; }
    }
  }
  if (PASS_C) {
    __syncthreads();
    for (int i = tid; i < 128 * 64; i += 256) {
      const int tl = i >> 6, e = i & 63;
      bf16_t* y = p.ys + (size_t)(t0 + tl) * 1024 + 768 + hd * 64 + e;
      *y = f2bf(bf2f(*y) * L.yt[i]);
    }
  }
  __syncthreads();
}

__device__ void rwkv_passB(const Params& p, unsigned char* smem) {
  float* Pl = (float*)smem;
  float* Sl = Pl + 4096;
  const int tid = threadIdx.x;
  for (int wk = blockIdx.x; wk < 128; wk += gridDim.x) {
    const int rg = wk & 3, hd = (wk >> 2) & 3, dir = (wk >> 4) & 1, seq = wk >> 5;
    const int cbase = seq == 0 ? 0 : seq == 1 ? 64 : seq == 2 ? 128 : 256;
    const int nch = seq < 2 ? 64 : 128;
    const int row = tid >> 4, jq = tid & 15;
    __syncthreads();
    for (int i = tid; i < 16 * 64; i += 256) Sl[i] = 0.f;
    __syncthreads();
    for (int ci = 0; ci < nch; ++ci) {
      const int c = dir ? nch - 1 - ci : ci;
      float* slot = p.pg + ((size_t)(cbase + c) * 8 + dir * 4 + hd) * 8192;
      for (int i = tid; i < 1024; i += 256) ((float4*)Pl)[i] = ((const float4*)slot)[i];
      float* gp = slot + 4096 + (rg * 16 + row) * 64 + jq * 4;
      float4 g = *(const float4*)gp;
      __syncthreads();
      float4 sold = *(const float4*)(Sl + row * 64 + jq * 4);
      float4 acc = g;
      for (int m4 = 0; m4 < 16; ++m4) {
        const float4 s4 = *(const float4*)(Sl + row * 64 + m4 * 4);
        const float sv[4] = {s4.x, s4.y, s4.z, s4.w};
#pragma unroll
        for (int e = 0; e < 4; ++e) {
          const float4 pv = *(const float4*)(Pl + (m4 * 4 + e) * 64 + jq * 4);
          acc.x += sv[e] * pv.x; acc.y += sv[e] * pv.y; acc.z += sv[e] * pv.z; acc.w += sv[e] * pv.w;
        }
      }
      *(float4*)gp = sold;
      __syncthreads();
      *(float4*)(Sl + row * 64 + jq * 4) = acc;
      __syncthreads();
    }
  }
}

__global__ void __launch_bounds__(256) mega(Params p) {
  extern __shared__ __attribute__((aligned(16))) unsigned char smem[];
  cg::grid_group grid = cg::this_grid();
  for (int ph = p.phase_lo; ph < p.phase_hi; ++ph) {
    const int layer = ph / NPH, sub = ph % NPH;
    switch (sub) {
      case 0: phase_prep(p, layer); break;
      case 1: phase_g1(p, layer, smem); break;
      case 2: phase_mix(p, layer, smem); break;
      case 3: for (int j = blockIdx.x; j < 1536; j += gridDim.x) rwkv_job<false>(p, layer, j, smem); break;
      case 4: rwkv_passB(p, smem); break;
      case 5: for (int j = blockIdx.x; j < 1536; j += gridDim.x) rwkv_job<true>(p, layer, j, smem); break;
      case 6: phase_branch(p, smem); break;
      case 7: phase_gate(p, layer, smem); break;
      case 8: phase_out(p, layer, smem); break;
    }
    if (ph + 1 < p.phase_hi) grid.sync();
  }
}

extern "C" void kernel_launch(void* const* d_in, const int* in_sizes, int n_in, void* d_out, int out_size, void* d_ws, size_t ws_size, hipStream_t stream) {
  static int grid_blocks = 0;
  if (!grid_blocks) {
    hipFuncSetAttribute((const void*)mega, hipFuncAttributeMaxDynamicSharedMemorySize, SMEM_BYTES);
    int dev = 0, cus = 0, per_cu = 0;
    hipGetDevice(&dev);
    hipDeviceGetAttribute(&cus, hipDeviceAttributeMultiprocessorCount, dev);
    hipOccupancyMaxActiveBlocksPerMultiprocessor(&per_cu, mega, 256, SMEM_BYTES);
    if (per_cu < 1) per_cu = 1;
    grid_blocks = cus * per_cu;
  }
  Params p{};
  p.xp = (const float*)d_in[0]; p.xs = (const float*)d_in[1];
  p.norm_g = (const float*)d_in[2]; p.w_in = (const float*)d_in[3]; p.q_norm_g = (const float*)d_in[4]; p.k_norm_g = (const float*)d_in[5];
  p.pool_w = (const float*)d_in[6]; p.pool_scale = (const float*)d_in[7]; p.sg_norm_g = (const float*)d_in[8]; p.sg_w = (const float*)d_in[9]; p.sg_b = (const float*)d_in[10];
  p.mu_rkv = (const float*)d_in[11]; p.mu_lat = (const float*)d_in[12]; p.w0 = (const float*)d_in[13]; p.w_up = (const float*)d_in[14]; p.a0 = (const float*)d_in[15]; p.a_up = (const float*)d_in[16];
  p.k_k = (const float*)d_in[17]; p.k_a = (const float*)d_in[18]; p.r_k = (const float*)d_in[19]; p.ln_g = (const float*)d_in[20]; p.ln_b = (const float*)d_in[21];
  p.w_branch = (const float*)d_in[22]; p.w_out = (const float*)d_in[23];
  p.out = (float*)d_out;
  unsigned char* ws = (unsigned char*)d_ws;
  size_t off = 0;
  p.qkv = (bf16_t*)(ws + off); off += (size_t)MTOK * QKVW * 2;
  p.rest = (bf16_t*)(ws + off); off += (size_t)MTOK * RESTW * 2;
  p.ys = (bf16_t*)(ws + off); off += (size_t)MTOK * 1024 * 2;
  p.w1t = (bf16_t*)(ws + off); off += (size_t)5120 * 1024 * 2;
  p.wgt = (bf16_t*)(ws + off); off += (size_t)4096 * 1024 * 2;
  p.wbrt = (bf16_t*)(ws + off); off += (size_t)4096 * 256 * 2;
  p.woutt = (bf16_t*)(ws + off); off += (size_t)1024 * 1024 * 2;
  p.rstd = (float*)(ws + off); off += (size_t)MTOK * 4;
  p.pg = (float*)p.qkv;
  p.branch = p.qkv;
  if (off > ws_size) { fprintf(stderr, "workspace too small: need %zu have %zu\n", off, ws_size); return; }
#if MULTI_LAUNCH
  for (int ph = 0; ph < 2 * NPH; ++ph) {
    p.phase_lo = ph; p.phase_hi = ph + 1;
    hipLaunchKernelGGL(mega, dim3(grid_blocks), dim3(256), SMEM_BYTES, stream, p);
  }
#else
  p.phase_lo = 0; p.phase_hi = 2 * NPH;
  void* args[] = {&p};
  hipError_t e = hipLaunchCooperativeKernel((void*)mega, dim3(grid_blocks), dim3(256), args, SMEM_BYTES, stream);
  if (e != hipSuccess) fprintf(stderr, "cooperative launch failed: %s (grid %d)\n", hipGetErrorString(e), grid_blocks);
#endif
}
```

```cpp
#include <hip/hip_runtime.h>
#include <hip/hip_cooperative_groups.h>
#include <cstdio>
namespace cg = cooperative_groups;

#ifndef PROBE_MASK
#define PROBE_MASK 0
#endif
#if PROBE_MASK
__shared__ int s_dry;
#define DRY(p) (s_dry)
#else
#define DRY(p) 0
#endif
#ifndef MULTI_LAUNCH
#define MULTI_LAUNCH 0
#endif

typedef unsigned short bf16_t;
typedef short bf16x8 __attribute__((ext_vector_type(8)));
typedef float f32x4 __attribute__((ext_vector_type(4)));
typedef __bf16 bf2v __attribute__((ext_vector_type(2)));

constexpr int MTOK = 49152;
constexpr int DM = 1024;
constexpr int PW = 9216;
constexpr int QKVW = 2304;
constexpr int RESTW = 1792;
constexpr int SMEM_BYTES = 140 * 1024;
constexpr int NPH = 9;

struct Params {
  const float* xp; const float* xs;
  const float* norm_g; const float* w_in; const float* q_norm_g; const float* k_norm_g;
  const float* pool_w; const float* pool_scale; const float* sg_norm_g; const float* sg_w; const float* sg_b;
  const float* mu_rkv; const float* mu_lat; const float* w0; const float* w_up; const float* a0; const float* a_up;
  const float* k_k; const float* k_a; const float* r_k; const float* ln_g; const float* ln_b;
  const float* w_branch; const float* w_out;
  float* out;
  bf16_t* qkv; bf16_t* rest; bf16_t* ys;
  bf16_t* w1t; bf16_t* wgt; bf16_t* wbrt; bf16_t* woutt;
  float* rstd; float* pg; bf16_t* branch; bf16_t* xb; float* pnum; float* pden;
  int phase_lo, phase_hi;
  int dry, pad_;
};

__device__ __forceinline__ int get_tid() { int t = threadIdx.x; asm volatile("" : "+v"(t)); return t; }
__device__ __forceinline__ float bf2f(bf16_t v) { return __uint_as_float(((unsigned)v) << 16); }
__device__ __forceinline__ bf16_t f2bf(float f) { unsigned u = __float_as_uint(f); u += 0x7fffu + ((u >> 16) & 1u); return (bf16_t)(u >> 16); }
__device__ __forceinline__ unsigned pack2(float a, float b) { return (unsigned)f2bf(a) | ((unsigned)f2bf(b) << 16); }
__device__ __forceinline__ float sigmoidf_(float x) { return __builtin_amdgcn_rcpf(1.f + __expf(-x)); }
__device__ __forceinline__ float wave_sum(float v) {
#pragma unroll
  for (int o = 32; o >= 1; o >>= 1) v += __shfl_xor(v, o);
  return v;
}
__device__ __forceinline__ const float* xrow_ptr(const Params& p, int layer, int row) {
  if (layer == 0) return row < 16384 ? p.xp + (size_t)row * DM : p.xs + (size_t)(row - 16384) * DM;
  return p.out + (size_t)row * DM;
}
__device__ __forceinline__ void seq_of(int T0, int& sstart, int& slen) {
  if (T0 < 16384) { sstart = T0 & ~8191; slen = 8192; } else { sstart = 16384 + ((T0 - 16384) & ~16383); slen = 16384; }
}

__device__ void phase_prep(const Params& p, int layer) {
  const int tid = get_tid(), lane = tid & 63;
  const int gw = (blockIdx.x * 256 + tid) >> 6, nw = gridDim.x * 4;
  for (int row = gw; row < MTOK; row += nw) {
    const float4* x = (const float4*)xrow_ptr(p, layer, row);
    float ss = 0.f;
#pragma unroll
    for (int i = 0; i < 4; ++i) { float4 v = x[lane + i * 64]; ss += v.x * v.x + v.y * v.y + v.z * v.z + v.w * v.w; }
    ss = wave_sum(ss);
    const float rs = rsqrtf(ss * (1.f / 1024.f) + 1e-6f);
#pragma unroll
    for (int i = 0; i < 4; ++i) { float4 v = x[lane + i * 64]; uint2 o; o.x = pack2(v.x * rs, v.y * rs); o.y = pack2(v.z * rs, v.w * rs); *(uint2*)(p.xb + (size_t)row * 1024 + (lane + i * 64) * 4) = o; }
  }
  const float* w_in = p.w_in + (size_t)layer * DM * PW;
  const float* ng = p.norm_g + layer * DM;
  const long gt = (long)blockIdx.x * 256 + tid, nthr = (long)gridDim.x * 256;
  for (long idx = gt; idx < 5120L * 128; idx += nthr) {
    int n = (int)(idx % 5120), kc = (int)(idx / 5120);
    int col;
    if (n < 2304) col = n; else if (n < 2560) col = 2560 + (n - 2304); else if (n < 3072) col = 3072 + (n - 2560);
    else if (n < 3840) col = 3840 + (n - 3072); else if (n < 4096) col = 4608 + (n - 3840);
    else if (n < 4352) col = 2304 + (n - 4096); else if (n < 4608) col = 2816 + (n - 4352);
    else if (n < 4864) col = 3584 + (n - 4608); else col = 4864 + (n - 4864);
    float v[8];
#pragma unroll
    for (int j = 0; j < 8; ++j) { int k = kc * 8 + j; v[j] = ng[k] * w_in[(size_t)k * PW + col]; }
    uint4 o; o.x = pack2(v[0], v[1]); o.y = pack2(v[2], v[3]); o.z = pack2(v[4], v[5]); o.w = pack2(v[6], v[7]);
    *(uint4*)(p.w1t + (size_t)n * 1024 + kc * 8) = o;
  }
  for (long idx = gt; idx < 4096L * 128; idx += nthr) {
    int n = (int)(idx % 4096), kc = (int)(idx / 4096);
    int tn = n >> 8, c = n & 255, wn = c >> 7, nn = (c >> 4) & 7, dl = c & 15, dg = nn >> 2, b = nn & 3;
    int col = 5120 + b * 1024 + tn * 64 + wn * 32 + dg * 16 + dl;
    float v[8];
#pragma unroll
    for (int j = 0; j < 8; ++j) { int k = kc * 8 + j; v[j] = ng[k] * w_in[(size_t)k * PW + col]; }
    uint4 o; o.x = pack2(v[0], v[1]); o.y = pack2(v[2], v[3]); o.z = pack2(v[4], v[5]); o.w = pack2(v[6], v[7]);
    *(uint4*)(p.wgt + (size_t)n * 1024 + kc * 8) = o;
  }
  const float* wb = p.w_branch + (size_t)layer * 4 * 256 * 1024;
  for (long idx = gt; idx < 4096L * 32; idx += nthr) {
    int n = (int)(idx % 4096), kc = (int)(idx / 4096);
    int b = n >> 10, d = n & 1023;
    float v[8];
#pragma unroll
    for (int j = 0; j < 8; ++j) { int k = kc * 8 + j; v[j] = wb[((size_t)b * 256 + k) * 1024 + d]; }
    uint4 o; o.x = pack2(v[0], v[1]); o.y = pack2(v[2], v[3]); o.z = pack2(v[4], v[5]); o.w = pack2(v[6], v[7]);
    *(uint4*)(p.wbrt + (size_t)n * 256 + kc * 8) = o;
  }
  const float* wo = p.w_out + (size_t)layer * 1024 * 1024;
  for (long idx = gt; idx < 1024L * 128; idx += nthr) {
    int n = (int)(idx % 1024), kc = (int)(idx / 1024);
    float v[8];
#pragma unroll
    for (int j = 0; j < 8; ++j) { int k = kc * 8 + j; v[j] = wo[(size_t)k * 1024 + n]; }
    uint4 o; o.x = pack2(v[0], v[1]); o.y = pack2(v[2], v[3]); o.z = pack2(v[4], v[5]); o.w = pack2(v[6], v[7]);
    *(uint4*)(p.woutt + (size_t)n * 1024 + kc * 8) = o;
  }
}

__device__ __forceinline__ int lds_off(int r, int c) { return r * 128 + ((c ^ ((r >> 1) & 7)) << 4); }

#define GA_LOAD1(i, RA) { const int id = tid + (i) * 256, r = id >> 3, c = id & 7; RA = *(const f32x4*)(Aptr + (size_t)r * lda + tt * 64 + c * 8); }
#define GB_LOAD1(i, RB) { const int id = tid + (i) * 256, r = id >> 3, c = id & 7; RB = *(const f32x4*)(Bt + (size_t)r * ldb + tt * 64 + c * 8); }
#define LA_WRITE1(i, RA) { const int id = tid + (i) * 256, r = id >> 3, c = id & 7; *(f32x4*)(sa_ + lds_off(r, c)) = RA; }
#define LB_WRITE1(i, RB) { const int id = tid + (i) * 256, r = id >> 3, c = id & 7; *(f32x4*)(sa_ + 16384 + lds_off(r, c)) = RB; }
#define G_LOAD(T) { const int tt = (T); GA_LOAD1(0, ra0) GA_LOAD1(1, ra1) GA_LOAD1(2, ra2) GA_LOAD1(3, ra3) \
    GB_LOAD1(0, rb0) GB_LOAD1(1, rb1) GB_LOAD1(2, rb2) GB_LOAD1(3, rb3) GB_LOAD1(4, rb4) GB_LOAD1(5, rb5) GB_LOAD1(6, rb6) GB_LOAD1(7, rb7) }
#define L_WRITE(P) { unsigned char* sa_ = (P); LA_WRITE1(0, ra0) LA_WRITE1(1, ra1) LA_WRITE1(2, ra2) LA_WRITE1(3, ra3) \
    LB_WRITE1(0, rb0) LB_WRITE1(1, rb1) LB_WRITE1(2, rb2) LB_WRITE1(3, rb3) LB_WRITE1(4, rb4) LB_WRITE1(5, rb5) LB_WRITE1(6, rb6) LB_WRITE1(7, rb7) }
constexpr int GSTAGE = 49152;

__device__ __forceinline__ void gemm_core(f32x4 (&acc)[4][8], const bf16_t* Aptr, int lda, const bf16_t* Bt, int ldb, int K, unsigned char* smem) {
  const int tid = get_tid(), lane = tid & 63, wave = tid >> 6, wm = wave >> 1, wn = wave & 1;
  f32x4 ra0, ra1, ra2, ra3, rb0, rb1, rb2, rb3, rb4, rb5, rb6, rb7;
  const int nt = K >> 6;
  G_LOAD(0) L_WRITE(smem) __syncthreads();
#pragma unroll 1
  for (int t = 0; t < nt; ++t) {
    if (t + 1 < nt) G_LOAD(t + 1)
    const unsigned char* a_ = smem + (t & 1) * GSTAGE; const unsigned char* b_ = a_ + 16384;
#pragma unroll
    for (int ks = 0; ks < 2; ++ks) {
      bf16x8 af[4], bfr[8];
      const int c = ks * 4 + (lane >> 4);
#pragma unroll
      for (int m = 0; m < 4; ++m) { int r = wm * 64 + m * 16 + (lane & 15); af[m] = *(const bf16x8*)(a_ + lds_off(r, c)); }
#pragma unroll
      for (int n = 0; n < 8; ++n) { int r = wn * 128 + n * 16 + (lane & 15); bfr[n] = *(const bf16x8*)(b_ + lds_off(r, c)); }
#pragma unroll
      for (int m = 0; m < 4; ++m)
#pragma unroll
        for (int n = 0; n < 8; ++n) acc[m][n] = __builtin_amdgcn_mfma_f32_16x16x32_bf16(bfr[n], af[m], acc[m][n], 0, 0, 0);
    }
    if (t + 1 < nt) L_WRITE(smem + ((t + 1) & 1) * GSTAGE)
    __syncthreads();
  }
}

__device__ __forceinline__ void zero_acc(f32x4 (&acc)[4][8]) {
#pragma unroll
  for (int m = 0; m < 4; ++m)
#pragma unroll
    for (int n = 0; n < 8; ++n) acc[m][n] = (f32x4){0.f, 0.f, 0.f, 0.f};
}

__device__ __forceinline__ bool tile_of(int it, int ntn, int& tm, int& tn) {
  if (gridDim.x == 256) {
    const int xcd = blockIdx.x & 7, s = blockIdx.x >> 3;
    const int gn_cnt = ntn >> 2, g = it * 8 + xcd;
    if (g >= 48 * gn_cnt) return false;
    const int gm = g / gn_cnt, gn = g % gn_cnt;
    tm = gm * 8 + (s & 7); tn = gn * 4 + (s >> 3);
    return true;
  }
  const int tile = blockIdx.x + it * gridDim.x;
  if (tile >= 384 * ntn) return false;
  tm = tile / ntn; tn = tile % ntn; return true;
}

__device__ void phase_g1(const Params& p, int layer, unsigned char* smem) {
  const int lane = get_tid() & 63, wave = get_tid() >> 6, wm = wave >> 1, wn = wave & 1;
  int tm, tn;
  for (int it = 0; tile_of(it, 20, tm, tn); ++it) {
    const int row0 = tm * 128, col0 = tn * 256;
    f32x4 acc[4][8]; zero_acc(acc);
    gemm_core(acc, p.xb + (size_t)row0 * 1024, 1024, p.w1t + (size_t)col0 * 1024, 1024, 1024, smem);
#pragma unroll
    for (int m = 0; m < 4; ++m) {
      const int row = row0 + wm * 64 + m * 16 + (lane & 15);
#pragma unroll
      for (int n = 0; n < 8; ++n) {
        const int col = col0 + wn * 128 + n * 16 + (lane >> 4) * 4;
        float v0 = acc[m][n][0], v1 = acc[m][n][1], v2 = acc[m][n][2], v3 = acc[m][n][3];
        bf16_t* dst;
        if (col < QKVW) dst = p.qkv + (size_t)row * QKVW + col;
        else if (col < 4096) dst = p.rest + (size_t)row * RESTW + (col - QKVW);
        else { dst = p.ys + (size_t)row * 1024 + (col - 4096); v0 *= sigmoidf_(v0); v1 *= sigmoidf_(v1); v2 *= sigmoidf_(v2); v3 *= sigmoidf_(v3); }
        uint2 o; o.x = pack2(v0, v1); o.y = pack2(v2, v3);
        *(uint2*)dst = o;
      }
    }
  }
}

__device__ void phase_branch(const Params& p, unsigned char* smem) {
  const int lane = get_tid() & 63, wave = get_tid() >> 6, wm = wave >> 1, wn = wave & 1;
  int tm, tn;
  for (int it = 0; tile_of(it, 16, tm, tn); ++it) {
    const int row0 = tm * 128, col0 = tn * 256, b = tn >> 2;
    f32x4 acc[4][8]; zero_acc(acc);
    gemm_core(acc, p.ys + (size_t)row0 * 1024 + b * 256, 1024, p.wbrt + (size_t)col0 * 256, 256, 256, smem);
#pragma unroll
    for (int m = 0; m < 4; ++m) {
      const int row = row0 + wm * 64 + m * 16 + (lane & 15);
#pragma unroll
      for (int n = 0; n < 8; ++n) {
        const int col = col0 + wn * 128 + n * 16 + (lane >> 4) * 4;
        uint2 o; o.x = pack2(acc[m][n][0], acc[m][n][1]); o.y = pack2(acc[m][n][2], acc[m][n][3]);
        *(uint2*)(p.branch + (size_t)row * 4096 + col) = o;
      }
    }
  }
}

__device__ void phase_gate(const Params& p, int layer, unsigned char* smem) {
  const int lane = get_tid() & 63, wave = get_tid() >> 6, wm = wave >> 1, wn = wave & 1;
  int tm, tn;
  for (int it = 0; tile_of(it, 16, tm, tn); ++it) {
    const int row0 = tm * 128;
    f32x4 acc[4][8]; zero_acc(acc);
    gemm_core(acc, p.xb + (size_t)row0 * 1024, 1024, p.wgt + (size_t)tn * 256 * 1024, 1024, 1024, smem);
#pragma unroll
    for (int m = 0; m < 4; ++m) {
      const int row = row0 + wm * 64 + m * 16 + (lane & 15);
#pragma unroll
      for (int dg = 0; dg < 2; ++dg) {
        const int d = tn * 64 + wn * 32 + dg * 16 + (lane >> 4) * 4;
        float s0 = 0.f, s1 = 0.f, s2 = 0.f, s3 = 0.f;
#pragma unroll
        for (int b = 0; b < 4; ++b) {
          uint2 br = *(const uint2*)(p.branch + (size_t)row * 4096 + b * 1024 + d);
          s0 += sigmoidf_(acc[m][dg * 4 + b][0]) * __uint_as_float(br.x << 16);
          s1 += sigmoidf_(acc[m][dg * 4 + b][1]) * __uint_as_float(br.x & 0xffff0000u);
          s2 += sigmoidf_(acc[m][dg * 4 + b][2]) * __uint_as_float(br.y << 16);
          s3 += sigmoidf_(acc[m][dg * 4 + b][3]) * __uint_as_float(br.y & 0xffff0000u);
        }
        uint2 o; o.x = pack2(s0, s1); o.y = pack2(s2, s3);
        *(uint2*)(p.ys + (size_t)row * 1024 + d) = o;
      }
    }
  }
}

__device__ void phase_out(const Params& p, int layer, unsigned char* smem) {
  const int lane = get_tid() & 63, wave = get_tid() >> 6, wm = wave >> 1, wn = wave & 1;
  int tm, tn;
  for (int it = 0; tile_of(it, 4, tm, tn); ++it) {
    const int row0 = tm * 128, col0 = tn * 256;
    f32x4 acc[4][8]; zero_acc(acc);
    gemm_core(acc, p.ys + (size_t)row0 * 1024, 1024, p.woutt + (size_t)col0 * 1024, 1024, 1024, smem);
#pragma unroll
    for (int m = 0; m < 4; ++m) {
      const int row = row0 + wm * 64 + m * 16 + (lane & 15);
      const float* xr = xrow_ptr(p, layer, row);
#pragma unroll
      for (int n = 0; n < 8; ++n) {
        const int col = col0 + wn * 128 + n * 16 + (lane >> 4) * 4;
        float4 xv = *(const float4*)(xr + col);
        float4 o; o.x = xv.x + acc[m][n][0]; o.y = xv.y + acc[m][n][1]; o.z = xv.z + acc[m][n][2]; o.w = xv.w + acc[m][n][3];
        if (!DRY(p)) *(float4*)(p.out + (size_t)row * 1024 + col) = o;
      }
    }
  }
}

constexpr int QS_STRIDE = 144, KS_STRIDE = 144, VT_STRIDE = 432;
__device__ void attn_item(const Params& p, int layer, int item, unsigned char* smem) {
  const int tid = get_tid(), lane = tid & 63, w = tid >> 6;
  const int n = item % 12, run = item / 12, T0 = run * 64;
  const int g = n >> 2, h = n & 3, d = g == 0 ? 1 : (g == 1 ? 4 : 16);
  int sstart, slen; seq_of(T0, sstart, slen);
  const int rho = (T0 - sstart) >> 6;
  const int r = rho % d, i0 = (rho / d) * 64;
  unsigned char* Qs = smem;
  unsigned char* Ks = smem + 64 * QS_STRIDE;
  unsigned char* Vt = Ks + 208 * KS_STRIDE;
  const float* kg = p.k_norm_g + layer * 64;
  const float* qg = p.q_norm_g + layer * 64;
  const int part = tid & 3;
  {
    const int q = tid >> 2;
    const int pq = d * (i0 + q) + r;
    const bf16_t* base = p.qkv + (size_t)(sstart + pq) * QKVW + n * 64 + part * 16;
    const uint4 a0 = *(const uint4*)base, a1 = *(const uint4*)(base + 8);
    const unsigned ww[8] = {a0.x, a0.y, a0.z, a0.w, a1.x, a1.y, a1.z, a1.w};
    float f[16]; float ss = 0.f;
#pragma unroll
    for (int j = 0; j < 8; ++j) { f[2 * j] = __uint_as_float(ww[j] << 16); f[2 * j + 1] = __uint_as_float(ww[j] & 0xffff0000u); ss += f[2 * j] * f[2 * j] + f[2 * j + 1] * f[2 * j + 1]; }
    ss += __shfl_xor(ss, 1); ss += __shfl_xor(ss, 2);
    const float rs = rsqrtf(ss * (1.f / 64.f) + 1e-6f) * 0.125f;
    unsigned* qd = (unsigned*)(Qs + q * QS_STRIDE + part * 32);
#pragma unroll
    for (int j = 0; j < 8; ++j) qd[j] = pack2(f[2 * j] * rs * qg[part * 16 + 2 * j], f[2 * j + 1] * rs * qg[part * 16 + 2 * j + 1]);
  }
#pragma unroll 1
  for (int it = 0; it < 4; ++it) {
    const int rr = (tid >> 2) + it * 64;
    const int pos = d * (i0 - 64 + rr) + r;
    const bool ok = rr < 192 && pos >= 0 && pos < slen;
    uint4 k0 = {0, 0, 0, 0}, k1 = {0, 0, 0, 0}, v0 = {0, 0, 0, 0}, v1 = {0, 0, 0, 0};
    if (ok) {
      const bf16_t* base = p.qkv + (size_t)(sstart + pos) * QKVW + n * 64 + part * 16;
      k0 = *(const uint4*)(base + 768); k1 = *(const uint4*)(base + 768 + 8);
      v0 = *(const uint4*)(base + 1536); v1 = *(const uint4*)(base + 1536 + 8);
    }
    const unsigned kw[8] = {k0.x, k0.y, k0.z, k0.w, k1.x, k1.y, k1.z, k1.w};
    float kf[16]; float ss = 0.f;
#pragma unroll
    for (int j = 0; j < 8; ++j) { kf[2 * j] = __uint_as_float(kw[j] << 16); kf[2 * j + 1] = __uint_as_float(kw[j] & 0xffff0000u); ss += kf[2 * j] * kf[2 * j] + kf[2 * j + 1] * kf[2 * j + 1]; }
    ss += __shfl_xor(ss, 1); ss += __shfl_xor(ss, 2);
    const float rs = rsqrtf(ss * (1.f / 64.f) + 1e-6f);
    if (rr < 208) {
      unsigned* kd = (unsigned*)(Ks + rr * KS_STRIDE + part * 32);
#pragma unroll
      for (int j = 0; j < 8; ++j) kd[j] = pack2(kf[2 * j] * rs * kg[part * 16 + 2 * j], kf[2 * j + 1] * rs * kg[part * 16 + 2 * j + 1]);
      const unsigned vw[8] = {v0.x, v0.y, v0.z, v0.w, v1.x, v1.y, v1.z, v1.w};
#pragma unroll
      for (int j = 0; j < 8; ++j) {
        *(bf16_t*)(Vt + (part * 16 + 2 * j) * VT_STRIDE + rr * 2) = (bf16_t)(vw[j] & 0xffffu);
        *(bf16_t*)(Vt + (part * 16 + 2 * j + 1) * VT_STRIDE + rr * 2) = (bf16_t)(vw[j] >> 16);
      }
    }
  }
  __syncthreads();
  const int dl = lane & 15, gq = lane >> 4;
  bf16x8 qf0 = *(const bf16x8*)(Qs + (16 * w + dl) * QS_STRIDE + gq * 16);
  bf16x8 qf1 = *(const bf16x8*)(Qs + (16 * w + dl) * QS_STRIDE + 64 + gq * 16);
  const float slope = exp2f(-8.f * (float)(n + 1) / 12.f) * (float)d;
  float pv[10][4];
  float dsum = 0.f;
#pragma unroll
  for (int t = 0; t < 10; ++t) {
    const unsigned char* kp = Ks + ((w + t) * 16 + dl) * KS_STRIDE + gq * 16;
    f32x4 sacc = {0.f, 0.f, 0.f, 0.f};
    sacc = __builtin_amdgcn_mfma_f32_16x16x32_bf16(*(const bf16x8*)kp, qf0, sacc, 0, 0, 0);
    sacc = __builtin_amdgcn_mfma_f32_16x16x32_bf16(*(const bf16x8*)(kp + 64), qf1, sacc, 0, 0, 0);
#pragma unroll
    for (int j = 0; j < 4; ++j) {
      const int m = 16 * t + 4 * gq + j - dl;
      const int kr = (w + t) * 16 + 4 * gq + j;
      const int pos = d * (i0 - 64 + kr) + r;
      const bool ok = m >= 0 && m <= 128 && pos >= 0 && pos < slen;
      const float e = ok ? __expf(sacc[j] - slope * fabsf((float)(m - 64))) : 0.f;
      pv[t][j] = e; dsum += e;
    }
  }
  f32x4 oacc[4];
#pragma unroll
  for (int dt = 0; dt < 4; ++dt) oacc[dt] = (f32x4){0.f, 0.f, 0.f, 0.f};
#pragma unroll
  for (int u = 0; u < 5; ++u) {
    union { bf16x8 v; unsigned uu[4]; } pb;
    pb.uu[0] = pack2(pv[2 * u][0], pv[2 * u][1]); pb.uu[1] = pack2(pv[2 * u][2], pv[2 * u][3]);
    pb.uu[2] = pack2(pv[2 * u + 1][0], pv[2 * u + 1][1]); pb.uu[3] = pack2(pv[2 * u + 1][2], pv[2 * u + 1][3]);
#pragma unroll
    for (int dt = 0; dt < 4; ++dt) {
      const unsigned char* vp = Vt + (dt * 16 + dl) * VT_STRIDE + ((w + 2 * u) * 16 + 4 * gq) * 2;
      union { bf16x8 v; uint2 h2[2]; } va;
      va.h2[0] = *(const uint2*)vp; va.h2[1] = *(const uint2*)(vp + 32);
      oacc[dt] = __builtin_amdgcn_mfma_f32_16x16x32_bf16(va.v, pb.v, oacc[dt], 0, 0, 0);
    }
  }
  dsum += __shfl_xor(dsum, 16); dsum += __shfl_xor(dsum, 32);
  {
    const int ql = 16 * w + dl;
    const size_t tok = (size_t)(sstart + d * (i0 + ql) + r);
    float* np = p.pnum + (size_t)g * ((size_t)MTOK * 256) + (tok * 4 + h) * 64 + 4 * gq;
#pragma unroll
    for (int dt = 0; dt < 4; ++dt) *(f32x4*)(np + dt * 16) = oacc[dt];
    if (gq == 0) p.pden[(size_t)g * ((size_t)MTOK * 4) + tok * 4 + h] = dsum;
  }
  __syncthreads();
}

__device__ void attn_combine(const Params& p) {
  const size_t nvec = (size_t)MTOK * 64;
  for (size_t i = (size_t)blockIdx.x * 256 + get_tid(); i < nvec; i += (size_t)gridDim.x * 256) {
    const size_t th = i >> 4;
    const int e4 = (int)(i & 15);
    const f32x4 a = *(const f32x4*)(p.pnum + i * 4), b = *(const f32x4*)(p.pnum + (size_t)MTOK * 256 + i * 4), c = *(const f32x4*)(p.pnum + 2 * (size_t)MTOK * 256 + i * 4);
    const float den = p.pden[th] + p.pden[(size_t)MTOK * 4 + th] + p.pden[2 * (size_t)MTOK * 4 + th];
    const float inv = 1.f / den;
    const size_t tok = th >> 2; const int h = (int)(th & 3);
    bf16_t* y = p.ys + tok * 1024 + h * 64 + e4 * 4;
    uint2 yv = *(const uint2*)y;
    float y0 = __uint_as_float(yv.x << 16), y1 = __uint_as_float(yv.x & 0xffff0000u), y2 = __uint_as_float(yv.y << 16), y3 = __uint_as_float(yv.y & 0xffff0000u);
    uint2 o; o.x = pack2(y0 * (a[0] + b[0] + c[0]) * inv, y1 * (a[1] + b[1] + c[1]) * inv); o.y = pack2(y2 * (a[2] + b[2] + c[2]) * inv, y3 * (a[3] + b[3] + c[3]) * inv);
    if (!DRY(p)) *(uint2*)y = o;
  }
}

__device__ void pool_item(const Params& p, int layer, int item, unsigned char* smem) {
  const int tid = get_tid();
  const int g = item & 3, T0 = (item >> 2) * 64;
  int sstart, slen; seq_of(T0, sstart, slen);
  const int P0 = T0 - sstart;
  const int hw = 1 << g;
  float* u = (float*)smem;
  float* dd = u + 80 * 64;
  float* w = dd + 64 * 65;
  for (int i = tid; i < 80 * 64; i += 256) {
    const int rr = i >> 6, c = i & 63, pos = P0 - 8 + rr;
    u[i] = (pos >= 0 && pos < slen) ? bf2f(p.rest[(size_t)(sstart + pos) * RESTW + g * 64 + c]) : 0.f;
  }
  const float* pw = p.pool_w + ((size_t)layer * 4 + g) * 4096;
  for (int i = tid; i < 4096; i += 256) w[i] = pw[i];
  __syncthreads();
  for (int i = tid; i < 64 * 64; i += 256) {
    const int t = i >> 6, c = i & 63, pos = P0 + t;
    float s = 0.f;
    for (int o = -hw; o < hw; ++o) s += u[(t + 8 + o) * 64 + c];
    const int lo = pos - hw > 0 ? pos - hw : 0, hi = pos + hw < slen ? pos + hw : slen;
    dd[t * 65 + c] = s / (float)(hi - lo) - u[(t + 8) * 64 + c];
  }
  __syncthreads();
  {
    const int t = tid >> 2, e0 = (tid & 3) * 16;
    float acc[16];
#pragma unroll
    for (int e = 0; e < 16; ++e) acc[e] = 0.f;
    for (int c = 0; c < 64; ++c) {
      const float dv = dd[t * 65 + c];
#pragma unroll
      for (int e = 0; e < 16; ++e) acc[e] += dv * w[c * 64 + e0 + e];
    }
    const float* sc = p.pool_scale + layer * 256 + g * 64 + e0;
    bf16_t* y = p.ys + (size_t)(T0 + t) * 1024 + 256 + g * 64 + e0;
#pragma unroll
    for (int e = 0; e < 16; ++e) if (!DRY(p)) y[e] = f2bf(bf2f(y[e]) * acc[e] * sc[e]);
  }
  __syncthreads();
}

__device__ void sg_item(const Params& p, int layer, int item, unsigned char* smem) {
  const int tid = get_tid(), lane = tid & 63, wave = tid >> 6;
  const int g = item & 3, T0 = (item >> 2) * 128;
  float* vn = (float*)smem;
  float* sw = vn + 128 * 64;
  for (int s = wave; s < 128; s += 4) {
    const bf16_t* vr = p.rest + (size_t)(T0 + s) * RESTW + 512;
    float ss = 0.f; float mine = 0.f;
#pragma unroll
    for (int j = 0; j < 4; ++j) { float v = bf2f(vr[j * 64 + lane]); ss += v * v; if (j == g) mine = v; }
    ss = wave_sum(ss);
    const float rs = rsqrtf(ss * (1.f / 256.f) + 1e-6f);
    vn[s * 64 + lane] = mine * rs * p.sg_norm_g[layer * 256 + g * 64 + lane];
  }
  const float* gw = p.sg_w + ((size_t)layer * 4 + g) * 128 * 128;
  for (int i = tid; i < 128 * 128; i += 256) sw[(i >> 7) * 129 + (i & 127)] = gw[i];
  __syncthreads();
  {
    const int t = tid >> 1, d0 = (tid & 1) * 32;
    float acc[32];
#pragma unroll
    for (int e = 0; e < 32; ++e) acc[e] = 0.f;
    for (int s = 0; s < 128; ++s) {
      const float wv = sw[t * 129 + s];
      const float4* vp = (const float4*)(vn + s * 64 + d0);
#pragma unroll
      for (int e = 0; e < 8; ++e) { float4 v = vp[e]; acc[4 * e] += wv * v.x; acc[4 * e + 1] += wv * v.y; acc[4 * e + 2] += wv * v.z; acc[4 * e + 3] += wv * v.w; }
    }
    const float bias = p.sg_b[(layer * 4 + g) * 128 + t];
    const bf16_t* ur = p.rest + (size_t)(T0 + t) * RESTW + 256 + g * 64 + d0;
    bf16_t* y = p.ys + (size_t)(T0 + t) * 1024 + 512 + g * 64 + d0;
#pragma unroll
    for (int e = 0; e < 32; ++e) if (!DRY(p)) y[e] = f2bf(bf2f(y[e]) * bf2f(ur[e]) * (acc[e] + bias));
  }
  __syncthreads();
}

__device__ void phase_mix(const Params& p, int layer, unsigned char* smem) {
  const int NA = 9216, NS = 1536, NP = 3072;
  for (int it = blockIdx.x; it < NA + NS + NP; it += gridDim.x) {
    if (it < NA) attn_item(p, layer, it, smem);
    else if (it < NA + NS) sg_item(p, layer, it - NA, smem);
    else pool_item(p, layer, it - NA - NS, smem);
  }
}

struct RwkvLds {
  float wup[64 * 64], aup[64 * 64];
  float tw[32 * 64], ta[32 * 64];
  float R[32 * 64], W[32 * 64], K[32 * 64], V[32 * 64], KK[32 * 64], B[32 * 64];
  float ot[32 * 64];
  float yt[128 * 64];
};

__device__ __forceinline__ float dpp_qx1(float v) { return __int_as_float(__builtin_amdgcn_update_dpp(0, __float_as_int(v), 0xB1, 0xF, 0xF, true)); }
__device__ __forceinline__ float dpp_qx2(float v) { return __int_as_float(__builtin_amdgcn_update_dpp(0, __float_as_int(v), 0x4E, 0xF, 0xF, true)); }
__device__ __forceinline__ float dpp_hm(float v) { return __int_as_float(__builtin_amdgcn_update_dpp(0, __float_as_int(v), 0x141, 0xF, 0xF, true)); }
__device__ __forceinline__ float red8(float v) { v += dpp_qx1(v); v += dpp_qx2(v); v += dpp_hm(v); return v; }

struct ScanOps { f32x4 w0, w1, b0, b1, kk0, kk1, k0, k1, r0, r1; float2 v; };
template <bool PASS_C>
__device__ __forceinline__ ScanOps load_ops(const RwkvLds& L, int tk, int j0, int row0) {
  ScanOps o;
  o.w0 = *(const f32x4*)(L.W + tk * 64 + j0); o.w1 = *(const f32x4*)(L.W + tk * 64 + j0 + 4);
  o.b0 = *(const f32x4*)(L.B + tk * 64 + j0); o.b1 = *(const f32x4*)(L.B + tk * 64 + j0 + 4);
  o.kk0 = *(const f32x4*)(L.KK + tk * 64 + j0); o.kk1 = *(const f32x4*)(L.KK + tk * 64 + j0 + 4);
  o.k0 = *(const f32x4*)(L.K + tk * 64 + j0); o.k1 = *(const f32x4*)(L.K + tk * 64 + j0 + 4);
  if (PASS_C) { o.r0 = *(const f32x4*)(L.R + tk * 64 + j0); o.r1 = *(const f32x4*)(L.R + tk * 64 + j0 + 4); }
  else { o.r0 = o.w0; o.r1 = o.w1; }
  o.v = *(const float2*)(L.V + tk * 64 + row0);
  return o;
}
template <bool PASS_C>
__device__ void rwkv_job(const Params& p, int layer, int job, unsigned char* smem) {
  RwkvLds& L = *(RwkvLds*)smem;
  const int tid = get_tid(), lane = tid & 63, wave = tid >> 6;
  const int hd = job & 3, cp = job >> 2, t0 = cp * 128;
  int sstart, slen; seq_of(t0, sstart, slen);
  const int send = sstart + slen;
  const int rp = tid >> 3, jg = tid & 7, row0 = rp * 2, j0 = jg * 8;
  if (PASS_C) { for (int i = tid; i < 128 * 64; i += 256) L.yt[i] = 0.f; }
#pragma unroll 1
  for (int dir = 0; dir < 2; ++dir) {
    const int ld = layer * 2 + dir;
    float* slot = p.pg + ((size_t)cp * 8 + dir * 4 + hd) * 8192;
    __syncthreads();
    for (int i = tid; i < 4096; i += 256) {
      const int m = i >> 6, j = i & 63;
      L.wup[i] = p.w_up[((size_t)ld * 64 + m) * 256 + hd * 64 + j];
      L.aup[i] = p.a_up[((size_t)ld * 64 + m) * 256 + hd * 64 + j];
    }
    float S[2][8], Pst[2][8];
#pragma unroll
    for (int rr = 0; rr < 2; ++rr)
#pragma unroll
      for (int j = 0; j < 8; ++j) {
        if (PASS_C) { S[rr][j] = slot[4096 + (row0 + rr) * 64 + j0 + j]; Pst[rr][j] = 0.f; }
        else { S[rr][j] = 0.f; Pst[rr][j] = (row0 + rr == j0 + j) ? 1.f : 0.f; }
      }
    const int cidx = hd * 64 + lane;
    const float mu_r = p.mu_rkv[ld * 768 + cidx], mu_k = p.mu_rkv[ld * 768 + 256 + cidx], mu_v = p.mu_rkv[ld * 768 + 512 + cidx];
    const float mu_w = p.mu_lat[ld * 128 + lane], mu_a = p.mu_lat[ld * 128 + 64 + lane];
    const float w0v = p.w0[ld * 256 + cidx], a0v = p.a0[ld * 256 + cidx];
    const float kkv = p.k_k[ld * 256 + cidx], kav = p.k_a[ld * 256 + cidx], rkv_ = p.r_k[ld * 256 + cidx];
#pragma unroll 1
    for (int sb = 0; sb < 4; ++sb) {
      __syncthreads();
#pragma unroll
      for (int i = 0; i < 8; ++i) {
        const int tk = wave * 8 + i, tau = sb * 32 + tk;
        const int t = dir ? (t0 + 127 - tau) : (t0 + tau);
        const int tp = dir ? t + 1 : t - 1;
        const bool pv = tp >= sstart && tp < send;
        const bf16_t* cr = p.rest + (size_t)t * RESTW;
        const bf16_t* pr = p.rest + (size_t)(pv ? tp : t) * RESTW;
        float cr_r = bf2f(cr[768 + cidx]), cr_k = bf2f(cr[1024 + cidx]), cr_v = bf2f(cr[1280 + cidx]);
        float cr_w = bf2f(cr[1536 + dir * 128 + lane]), cr_a = bf2f(cr[1536 + dir * 128 + 64 + lane]);
        float pr_r = 0.f, pr_k = 0.f, pr_v = 0.f, pr_w = 0.f, pr_a = 0.f;
        if (pv) { pr_r = bf2f(pr[768 + cidx]); pr_k = bf2f(pr[1024 + cidx]); pr_v = bf2f(pr[1280 + cidx]); pr_w = bf2f(pr[1536 + dir * 128 + lane]); pr_a = bf2f(pr[1536 + dir * 128 + 64 + lane]); }
        L.R[tk * 64 + lane] = cr_r + (pr_r - cr_r) * mu_r;
        L.K[tk * 64 + lane] = cr_k + (pr_k - cr_k) * mu_k;
        L.V[tk * 64 + lane] = cr_v + (pr_v - cr_v) * mu_v;
        { const float xw = cr_w + (pr_w - cr_w) * mu_w; L.tw[tk * 64 + lane] = 1.f - 2.f * __builtin_amdgcn_rcpf(1.f + __expf(2.f * xw)); }
        L.ta[tk * 64 + lane] = cr_a + (pr_a - cr_a) * mu_a;
      }
      __syncthreads();
      float accw[8], acca[8];
#pragma unroll
      for (int i = 0; i < 8; ++i) { accw[i] = 0.f; acca[i] = 0.f; }
#pragma unroll 1
      for (int m4 = 0; m4 < 16; ++m4) {
        float wu[4], au[4];
#pragma unroll
        for (int e = 0; e < 4; ++e) { wu[e] = L.wup[(m4 * 4 + e) * 64 + lane]; au[e] = L.aup[(m4 * 4 + e) * 64 + lane]; }
#pragma unroll
        for (int i = 0; i < 8; ++i) {
          const float4 tw4 = *(const float4*)(L.tw + (wave * 8 + i) * 64 + m4 * 4);
          const float4 ta4 = *(const float4*)(L.ta + (wave * 8 + i) * 64 + m4 * 4);
          accw[i] += tw4.x * wu[0] + tw4.y * wu[1] + tw4.z * wu[2] + tw4.w * wu[3];
          acca[i] += ta4.x * au[0] + ta4.y * au[1] + ta4.z * au[2] + ta4.w * au[3];
        }
      }
#pragma unroll
      for (int i = 0; i < 8; ++i) {
        const int tk = wave * 8 + i, tau = sb * 32 + tk;
        const int tl = dir ? (127 - tau) : tau;
        const float wpre = w0v + accw[i];
        const float nx = -wpre;
        const float sp = fmaxf(nx, 0.f) + log1pf(__expf(-fabsf(nx)));
        const float wlog = -sp - 0.5f;
        const float decay = __expf(-__expf(wlog));
        const float a = sigmoidf_(a0v + acca[i]);
        const float k = L.K[tk * 64 + lane], r = L.R[tk * 64 + lane], v = L.V[tk * 64 + lane];
        float kk = k * kkv;
        const float ss = wave_sum(kk * kk);
        kk *= rsqrtf(ss + 1e-12f);
        const float k2 = k * (1.f + (a - 1.f) * kav);
        const float bs = wave_sum(r * k2 * rkv_);
        L.W[tk * 64 + lane] = decay; L.K[tk * 64 + lane] = k2; L.KK[tk * 64 + lane] = kk; L.B[tk * 64 + lane] = kk * a;
        if (PASS_C) L.yt[tl * 64 + lane] += bs * v;
      }
      __syncthreads();
      ScanOps cur = load_ops<PASS_C>(L, 0, j0, row0);
#pragma unroll 2
      for (int tk = 0; tk < 32; ++tk) {
        const ScanOps nx = load_ops<PASS_C>(L, (tk + 1) & 31, j0, row0);
        float w[8], b[8], kkr[8], k[8];
#pragma unroll
        for (int j = 0; j < 4; ++j) { w[j] = cur.w0[j]; w[j + 4] = cur.w1[j]; b[j] = cur.b0[j]; b[j + 4] = cur.b1[j]; kkr[j] = cur.kk0[j]; kkr[j + 4] = cur.kk1[j]; k[j] = cur.k0[j]; k[j + 4] = cur.k1[j]; }
        const float vr[2] = {cur.v.x, cur.v.y};
        float sa[2], sp[2] = {0.f, 0.f};
#pragma unroll
        for (int rr = 0; rr < 2; ++rr) {
          float a0 = S[rr][0] * kkr[0], a1 = S[rr][1] * kkr[1];
#pragma unroll
          for (int j = 2; j < 8; j += 2) { a0 += S[rr][j] * kkr[j]; a1 += S[rr][j + 1] * kkr[j + 1]; }
          sa[rr] = a0 + a1;
          if (!PASS_C) {
            float p0 = Pst[rr][0] * kkr[0], p1 = Pst[rr][1] * kkr[1];
#pragma unroll
            for (int j = 2; j < 8; j += 2) { p0 += Pst[rr][j] * kkr[j]; p1 += Pst[rr][j + 1] * kkr[j + 1]; }
            sp[rr] = p0 + p1;
          }
        }
        sa[0] = red8(sa[0]); sa[1] = red8(sa[1]);
        if (!PASS_C) { sp[0] = red8(sp[0]); sp[1] = red8(sp[1]); }
#pragma unroll
        for (int rr = 0; rr < 2; ++rr)
#pragma unroll
          for (int j = 0; j < 8; ++j) {
            S[rr][j] = S[rr][j] * w[j] + (vr[rr] * k[j] - sa[rr] * b[j]);
            if (!PASS_C) Pst[rr][j] = Pst[rr][j] * w[j] - sp[rr] * b[j];
          }
        if (PASS_C) {
          float o0 = 0.f, o1 = 0.f;
#pragma unroll
          for (int j = 0; j < 4; ++j) { o0 += S[0][j] * cur.r0[j] + S[0][j + 4] * cur.r1[j]; o1 += S[1][j] * cur.r0[j] + S[1][j + 4] * cur.r1[j]; }
          o0 = red8(o0); o1 = red8(o1);
          if (jg == 0) { L.ot[tk * 64 + row0] = o0; L.ot[tk * 64 + row0 + 1] = o1; }
        }
        cur = nx;
      }
      if (PASS_C) {
        __syncthreads();
        const int tk = tid >> 3, part = tid & 7, tau = sb * 32 + tk;
        const int tl = dir ? (127 - tau) : tau;
        float o[8]; float s1 = 0.f;
#pragma unroll
        for (int e = 0; e < 8; ++e) { o[e] = L.ot[tk * 64 + part * 8 + e]; s1 += o[e]; }
        s1 = red8(s1);
        const float mu = s1 * (1.f / 64.f);
        float s2 = 0.f;
#pragma unroll
        for (int e = 0; e < 8; ++e) { o[e] -= mu; s2 += o[e] * o[e]; }
        s2 = red8(s2);
        const float rs = rsqrtf(s2 * (1.f / 64.f) + 64e-5f);
#pragma unroll
        for (int e = 0; e < 8; ++e) {
          const int ch = hd * 64 + part * 8 + e;
          L.yt[tl * 64 + part * 8 + e] += o[e] * rs * p.ln_g[layer * 256 + ch] + p.ln_b[layer * 256 + ch];
        }
      }
    }
    if (!PASS_C) {
#pragma unroll
      for (int rr = 0; rr < 2; ++rr)
#pragma unroll
        for (int j = 0; j < 8; ++j) { slot[(row0 + rr) * 64 + j0 + j] = Pst[rr][j]; slot[4096 + (row0 + rr) * 64 + j0 + j] = S[rr][j]; }
    }
  }
  if (PASS_C) {
    __syncthreads();
    for (int i = tid; i < 128 * 64; i += 256) {
      const int tl = i >> 6, e = i & 63;
      bf16_t* y = p.ys + (size_t)(t0 + tl) * 1024 + 768 + hd * 64 + e;
      if (!DRY(p)) *y = f2bf(bf2f(*y) * L.yt[i]);
    }
  }
  __syncthreads();
}

__device__ void rwkv_passB(const Params& p, unsigned char* smem) {
  float* Pl = (float*)smem;
  float* Sl = Pl + 4096;
  const int tid = get_tid();
  for (int wk = blockIdx.x; wk < 128; wk += gridDim.x) {
    const int rg = wk & 3, hd = (wk >> 2) & 3, dir = (wk >> 4) & 1, seq = wk >> 5;
    const int cbase = seq == 0 ? 0 : seq == 1 ? 64 : seq == 2 ? 128 : 256;
    const int nch = seq < 2 ? 64 : 128;
    const int row = tid >> 4, jq = tid & 15;
    __syncthreads();
    for (int i = tid; i < 16 * 64; i += 256) Sl[i] = 0.f;
    __syncthreads();
    float4 pf0, pf1, pf2, pf3, gf;
    {
      const int c = dir ? nch - 1 : 0;
      const float* slot = p.pg + ((size_t)(cbase + c) * 8 + dir * 4 + hd) * 8192;
      pf0 = ((const float4*)slot)[tid]; pf1 = ((const float4*)slot)[tid + 256]; pf2 = ((const float4*)slot)[tid + 512]; pf3 = ((const float4*)slot)[tid + 768];
      gf = *(const float4*)(slot + 4096 + (rg * 16 + row) * 64 + jq * 4);
    }
#pragma unroll 1
    for (int ci = 0; ci < nch; ++ci) {
      const int c = dir ? nch - 1 - ci : ci;
      float* slot = p.pg + ((size_t)(cbase + c) * 8 + dir * 4 + hd) * 8192;
      ((float4*)Pl)[tid] = pf0; ((float4*)Pl)[tid + 256] = pf1; ((float4*)Pl)[tid + 512] = pf2; ((float4*)Pl)[tid + 768] = pf3;
      float* gp = slot + 4096 + (rg * 16 + row) * 64 + jq * 4;
      float4 acc = gf;
      if (ci + 1 < nch) {
        const int c2 = dir ? nch - 2 - ci : ci + 1;
        const float* s2 = p.pg + ((size_t)(cbase + c2) * 8 + dir * 4 + hd) * 8192;
        pf0 = ((const float4*)s2)[tid]; pf1 = ((const float4*)s2)[tid + 256]; pf2 = ((const float4*)s2)[tid + 512]; pf3 = ((const float4*)s2)[tid + 768];
        gf = *(const float4*)(s2 + 4096 + (rg * 16 + row) * 64 + jq * 4);
      }
      __syncthreads();
      float4 sold = *(const float4*)(Sl + row * 64 + jq * 4);
#pragma unroll 4
      for (int m4 = 0; m4 < 16; ++m4) {
        const float4 s4 = *(const float4*)(Sl + row * 64 + m4 * 4);
        const float sv[4] = {s4.x, s4.y, s4.z, s4.w};
#pragma unroll
        for (int e = 0; e < 4; ++e) {
          const float4 pv = *(const float4*)(Pl + (m4 * 4 + e) * 64 + jq * 4);
          acc.x += sv[e] * pv.x; acc.y += sv[e] * pv.y; acc.z += sv[e] * pv.z; acc.w += sv[e] * pv.w;
        }
      }
      if (!DRY(p)) *(float4*)gp = sold;
      __syncthreads();
      *(float4*)(Sl + row * 64 + jq * 4) = acc;
      __syncthreads();
    }
  }
}

__device__ __forceinline__ void run_phase(const Params& p, int layer, int sub, unsigned char* smem) {
  switch (sub) {
    case 0: phase_prep(p, layer); break;
    case 1: phase_g1(p, layer, smem); break;
    case 2: phase_mix(p, layer, smem); break;
    case 3: for (int j = blockIdx.x; j < 1536; j += gridDim.x) rwkv_job<false>(p, layer, j, smem); attn_combine(p); break;
    case 4: rwkv_passB(p, smem); break;
    case 5: for (int j = blockIdx.x; j < 1536; j += gridDim.x) rwkv_job<true>(p, layer, j, smem); break;
    case 6: phase_branch(p, smem); break;
    case 7: phase_gate(p, layer, smem); break;
    case 8: phase_out(p, layer, smem); break;
  }
}
__global__ void __launch_bounds__(256) mega(Params p) {
  extern __shared__ __attribute__((aligned(16))) unsigned char smem[];
  cg::grid_group grid = cg::this_grid();
  for (int ph = p.phase_lo; ph < p.phase_hi; ++ph) {
    const int layer = ph / NPH, sub = ph % NPH;
#if PROBE_MASK
    for (int rep = (PROBE_MASK >> sub) & 1; rep >= 0; --rep) {
      __syncthreads(); if (get_tid() == 0) s_dry = rep; __syncthreads();
      run_phase(p, layer, sub, smem);
      if (rep) grid.sync();
    }
#else
    run_phase(p, layer, sub, smem);
#endif
    if (ph + 1 < p.phase_hi) grid.sync();
  }
}

extern "C" void kernel_launch(void* const* d_in, const int* in_sizes, int n_in, void* d_out, int out_size, void* d_ws, size_t ws_size, hipStream_t stream) {
  static int grid_blocks = 0;
  if (!grid_blocks) {
    hipFuncSetAttribute((const void*)mega, hipFuncAttributeMaxDynamicSharedMemorySize, SMEM_BYTES);
    int dev = 0, cus = 0, per_cu = 0;
    hipGetDevice(&dev);
    hipDeviceGetAttribute(&cus, hipDeviceAttributeMultiprocessorCount, dev);
    hipOccupancyMaxActiveBlocksPerMultiprocessor(&per_cu, mega, 256, SMEM_BYTES);
    if (per_cu < 1) per_cu = 1;
    grid_blocks = cus * per_cu;
  }
  Params p{};
  p.xp = (const float*)d_in[0]; p.xs = (const float*)d_in[1];
  p.norm_g = (const float*)d_in[2]; p.w_in = (const float*)d_in[3]; p.q_norm_g = (const float*)d_in[4]; p.k_norm_g = (const float*)d_in[5];
  p.pool_w = (const float*)d_in[6]; p.pool_scale = (const float*)d_in[7]; p.sg_norm_g = (const float*)d_in[8]; p.sg_w = (const float*)d_in[9]; p.sg_b = (const float*)d_in[10];
  p.mu_rkv = (const float*)d_in[11]; p.mu_lat = (const float*)d_in[12]; p.w0 = (const float*)d_in[13]; p.w_up = (const float*)d_in[14]; p.a0 = (const float*)d_in[15]; p.a_up = (const float*)d_in[16];
  p.k_k = (const float*)d_in[17]; p.k_a = (const float*)d_in[18]; p.r_k = (const float*)d_in[19]; p.ln_g = (const float*)d_in[20]; p.ln_b = (const float*)d_in[21];
  p.w_branch = (const float*)d_in[22]; p.w_out = (const float*)d_in[23];
  p.out = (float*)d_out;
  unsigned char* ws = (unsigned char*)d_ws;
  size_t off = 0;
  p.qkv = (bf16_t*)(ws + off); off += (size_t)MTOK * QKVW * 2;
  p.rest = (bf16_t*)(ws + off); off += (size_t)MTOK * RESTW * 2;
  p.ys = (bf16_t*)(ws + off); off += (size_t)MTOK * 1024 * 2;
  p.w1t = (bf16_t*)(ws + off); off += (size_t)5120 * 1024 * 2;
  p.wgt = (bf16_t*)(ws + off); off += (size_t)4096 * 1024 * 2;
  p.wbrt = (bf16_t*)(ws + off); off += (size_t)4096 * 256 * 2;
  p.woutt = (bf16_t*)(ws + off); off += (size_t)1024 * 1024 * 2;
  p.rstd = (float*)(ws + off); off += (size_t)MTOK * 4;
  p.xb = (bf16_t*)(ws + off); off += (size_t)MTOK * 1024 * 2;
  p.pnum = (float*)(ws + off); off += (size_t)3 * MTOK * 256 * 4;
  p.pden = (float*)(ws + off); off += (size_t)3 * MTOK * 4 * 4;
  p.pg = (float*)p.qkv;
  p.branch = p.qkv;
  if (off > ws_size) { fprintf(stderr, "workspace too small: need %zu have %zu\n", off, ws_size); return; }
#if MULTI_LAUNCH
  for (int ph = 0; ph < 2 * NPH; ++ph) {
    p.phase_lo = ph; p.phase_hi = ph + 1;
    hipLaunchKernelGGL(mega, dim3(grid_blocks), dim3(256), SMEM_BYTES, stream, p);
  }
#else
  p.phase_lo = 0; p.phase_hi = 2 * NPH;
  void* args[] = {&p};
  hipError_t e = hipLaunchCooperativeKernel((void*)mega, dim3(grid_blocks), dim3(256), args, SMEM_BYTES, stream);
  if (e != hipSuccess) fprintf(stderr, "cooperative launch failed: %s (grid %d)\n", hipGetErrorString(e), grid_blocks);
#endif
}
```

```cpp
#include <hip/hip_runtime.h>
#include <hip/hip_cooperative_groups.h>
#include <cstdio>
namespace cg = cooperative_groups;

#ifndef PROBE_MASK
#define PROBE_MASK 0
#endif
#if PROBE_MASK
__shared__ int s_dry;
#define DRY(p) (s_dry)
#else
#define DRY(p) 0
#endif
#ifndef MULTI_LAUNCH
#define MULTI_LAUNCH 0
#endif

typedef unsigned short bf16_t;
typedef short bf16x8 __attribute__((ext_vector_type(8)));
typedef float f32x4 __attribute__((ext_vector_type(4)));
typedef __bf16 bf2v __attribute__((ext_vector_type(2)));

constexpr int MTOK = 49152;
constexpr int DM = 1024;
constexpr int PW = 9216;
constexpr int QKVW = 2304;
constexpr int RESTW = 1792;
constexpr int SMEM_BYTES = 140 * 1024;
constexpr int NPH = 9;

struct Params {
  const float* xp; const float* xs;
  const float* norm_g; const float* w_in; const float* q_norm_g; const float* k_norm_g;
  const float* pool_w; const float* pool_scale; const float* sg_norm_g; const float* sg_w; const float* sg_b;
  const float* mu_rkv; const float* mu_lat; const float* w0; const float* w_up; const float* a0; const float* a_up;
  const float* k_k; const float* k_a; const float* r_k; const float* ln_g; const float* ln_b;
  const float* w_branch; const float* w_out;
  float* out;
  bf16_t* qkv; bf16_t* rest; bf16_t* ys;
  bf16_t* w1t; bf16_t* wgt; bf16_t* wbrt; bf16_t* woutt;
  float* rstd; float* pg; bf16_t* branch; bf16_t* xb; float* pnum; float* pden;
  int phase_lo, phase_hi;
  int dry, pad_;
};

__device__ __forceinline__ int get_tid() { int t = threadIdx.x; asm volatile("" : "+v"(t)); return t; }
__device__ __forceinline__ float bf2f(bf16_t v) { return __uint_as_float(((unsigned)v) << 16); }
__device__ __forceinline__ bf16_t f2bf(float f) { unsigned u = __float_as_uint(f); u += 0x7fffu + ((u >> 16) & 1u); return (bf16_t)(u >> 16); }
__device__ __forceinline__ unsigned pack2(float a, float b) { return (unsigned)f2bf(a) | ((unsigned)f2bf(b) << 16); }
__device__ __forceinline__ float sigmoidf_(float x) { return __builtin_amdgcn_rcpf(1.f + __expf(-x)); }
__device__ __forceinline__ float dpp_qx1(float v) { return __int_as_float(__builtin_amdgcn_update_dpp(0, __float_as_int(v), 0xB1, 0xF, 0xF, true)); }
__device__ __forceinline__ float dpp_qx2(float v) { return __int_as_float(__builtin_amdgcn_update_dpp(0, __float_as_int(v), 0x4E, 0xF, 0xF, true)); }
__device__ __forceinline__ float dpp_hm(float v) { return __int_as_float(__builtin_amdgcn_update_dpp(0, __float_as_int(v), 0x141, 0xF, 0xF, true)); }
__device__ __forceinline__ float wave_sum(float v) {
  v += __int_as_float(__builtin_amdgcn_update_dpp(0, __float_as_int(v), 0xB1, 0xF, 0xF, true));
  v += __int_as_float(__builtin_amdgcn_update_dpp(0, __float_as_int(v), 0x4E, 0xF, 0xF, true));
  v += __int_as_float(__builtin_amdgcn_update_dpp(0, __float_as_int(v), 0x141, 0xF, 0xF, true));
  v += __int_as_float(__builtin_amdgcn_update_dpp(0, __float_as_int(v), 0x140, 0xF, 0xF, true));
  v += __shfl_xor(v, 16); v += __shfl_xor(v, 32);
  return v;
}
__device__ __forceinline__ const float* xrow_ptr(const Params& p, int layer, int row) {
  if (layer == 0) return row < 16384 ? p.xp + (size_t)row * DM : p.xs + (size_t)(row - 16384) * DM;
  return p.out + (size_t)row * DM;
}
__device__ __forceinline__ void seq_of(int T0, int& sstart, int& slen) {
  if (T0 < 16384) { sstart = T0 & ~8191; slen = 8192; } else { sstart = 16384 + ((T0 - 16384) & ~16383); slen = 16384; }
}

__device__ void phase_prep(const Params& p, int layer) {
  const int tid = get_tid(), lane = tid & 63;
  const int gw = (blockIdx.x * 256 + tid) >> 6, nw = gridDim.x * 4;
  for (int row = gw; row < MTOK; row += nw) {
    const float4* x = (const float4*)xrow_ptr(p, layer, row);
    float ss = 0.f;
#pragma unroll
    for (int i = 0; i < 4; ++i) { float4 v = x[lane + i * 64]; ss += v.x * v.x + v.y * v.y + v.z * v.z + v.w * v.w; }
    ss = wave_sum(ss);
    const float rs = rsqrtf(ss * (1.f / 1024.f) + 1e-6f);
#pragma unroll
    for (int i = 0; i < 4; ++i) { float4 v = x[lane + i * 64]; uint2 o; o.x = pack2(v.x * rs, v.y * rs); o.y = pack2(v.z * rs, v.w * rs); *(uint2*)(p.xb + (size_t)row * 1024 + (lane + i * 64) * 4) = o; }
  }
  const float* w_in = p.w_in + (size_t)layer * DM * PW;
  const float* ng = p.norm_g + layer * DM;
  const long gt = (long)blockIdx.x * 256 + tid, nthr = (long)gridDim.x * 256;
  for (long idx = gt; idx < 5120L * 128; idx += nthr) {
    int n = (int)(idx % 5120), kc = (int)(idx / 5120);
    int col;
    if (n < 2304) col = n; else if (n < 2560) col = 2560 + (n - 2304); else if (n < 3072) col = 3072 + (n - 2560);
    else if (n < 3840) col = 3840 + (n - 3072); else if (n < 4096) col = 4608 + (n - 3840);
    else if (n < 4352) col = 2304 + (n - 4096); else if (n < 4608) col = 2816 + (n - 4352);
    else if (n < 4864) col = 3584 + (n - 4608); else col = 4864 + (n - 4864);
    float v[8];
#pragma unroll
    for (int j = 0; j < 8; ++j) { int k = kc * 8 + j; v[j] = ng[k] * w_in[(size_t)k * PW + col]; }
    uint4 o; o.x = pack2(v[0], v[1]); o.y = pack2(v[2], v[3]); o.z = pack2(v[4], v[5]); o.w = pack2(v[6], v[7]);
    *(uint4*)(p.w1t + (size_t)n * 1024 + kc * 8) = o;
  }
  for (long idx = gt; idx < 4096L * 128; idx += nthr) {
    int n = (int)(idx % 4096), kc = (int)(idx / 4096);
    int tn = n >> 8, c = n & 255, wn = c >> 7, nn = (c >> 4) & 7, dl = c & 15, dg = nn >> 2, b = nn & 3;
    int col = 5120 + b * 1024 + tn * 64 + wn * 32 + dg * 16 + dl;
    float v[8];
#pragma unroll
    for (int j = 0; j < 8; ++j) { int k = kc * 8 + j; v[j] = ng[k] * w_in[(size_t)k * PW + col]; }
    uint4 o; o.x = pack2(v[0], v[1]); o.y = pack2(v[2], v[3]); o.z = pack2(v[4], v[5]); o.w = pack2(v[6], v[7]);
    *(uint4*)(p.wgt + (size_t)n * 1024 + kc * 8) = o;
  }
  const float* wb = p.w_branch + (size_t)layer * 4 * 256 * 1024;
  for (long idx = gt; idx < 4096L * 32; idx += nthr) {
    int n = (int)(idx % 4096), kc = (int)(idx / 4096);
    int b = n >> 10, d = n & 1023;
    float v[8];
#pragma unroll
    for (int j = 0; j < 8; ++j) { int k = kc * 8 + j; v[j] = wb[((size_t)b * 256 + k) * 1024 + d]; }
    uint4 o; o.x = pack2(v[0], v[1]); o.y = pack2(v[2], v[3]); o.z = pack2(v[4], v[5]); o.w = pack2(v[6], v[7]);
    *(uint4*)(p.wbrt + (size_t)n * 256 + kc * 8) = o;
  }
  const float* wo = p.w_out + (size_t)layer * 1024 * 1024;
  for (long idx = gt; idx < 1024L * 128; idx += nthr) {
    int n = (int)(idx % 1024), kc = (int)(idx / 1024);
    float v[8];
#pragma unroll
    for (int j = 0; j < 8; ++j) { int k = kc * 8 + j; v[j] = wo[(size_t)k * 1024 + n]; }
    uint4 o; o.x = pack2(v[0], v[1]); o.y = pack2(v[2], v[3]); o.z = pack2(v[4], v[5]); o.w = pack2(v[6], v[7]);
    *(uint4*)(p.woutt + (size_t)n * 1024 + kc * 8) = o;
  }
}

__device__ __forceinline__ int lds_off(int r, int c) { return r * 128 + ((c ^ ((r >> 1) & 7)) << 4); }

#define GA_LOAD1(i, RA) RA = *(const f32x4*)(Ab + (size_t)(tt * 128) + (voffA + (unsigned)((i) * 32) * lda2));
#define GB_LOAD1(i, RB) RB = *(const f32x4*)(Bb + (size_t)(tt * 128) + (voffB + (unsigned)((i) * 32) * ldb2));
#define LA_WRITE1(i, RA) *(f32x4*)(sa_ + wbase + (i) * 4096) = RA;
#define LB_WRITE1(i, RB) *(f32x4*)(sa_ + 16384 + wbase + (i) * 4096) = RB;
#define G_LOAD_A(T) { const int tt = (T); GA_LOAD1(0, ra0) GA_LOAD1(1, ra1) GA_LOAD1(2, ra2) GA_LOAD1(3, ra3) \
    GB_LOAD1(0, rb0) GB_LOAD1(1, rb1) GB_LOAD1(2, rb2) GB_LOAD1(3, rb3) GB_LOAD1(4, rb4) GB_LOAD1(5, rb5) GB_LOAD1(6, rb6) GB_LOAD1(7, rb7) }
#define L_WRITE_A(P) { unsigned char* sa_ = (P); LA_WRITE1(0, ra0) LA_WRITE1(1, ra1) LA_WRITE1(2, ra2) LA_WRITE1(3, ra3) \
    LB_WRITE1(0, rb0) LB_WRITE1(1, rb1) LB_WRITE1(2, rb2) LB_WRITE1(3, rb3) LB_WRITE1(4, rb4) LB_WRITE1(5, rb5) LB_WRITE1(6, rb6) LB_WRITE1(7, rb7) }
#define G_LOAD_B(T) { const int tt = (T); GA_LOAD1(0, sa0) GA_LOAD1(1, sa1) GA_LOAD1(2, sa2) GA_LOAD1(3, sa3) \
    GB_LOAD1(0, sb0) GB_LOAD1(1, sb1) GB_LOAD1(2, sb2) GB_LOAD1(3, sb3) GB_LOAD1(4, sb4) GB_LOAD1(5, sb5) GB_LOAD1(6, sb6) GB_LOAD1(7, sb7) }
#define L_WRITE_B(P) { unsigned char* sa_ = (P); LA_WRITE1(0, sa0) LA_WRITE1(1, sa1) LA_WRITE1(2, sa2) LA_WRITE1(3, sa3) \
    LB_WRITE1(0, sb0) LB_WRITE1(1, sb1) LB_WRITE1(2, sb2) LB_WRITE1(3, sb3) LB_WRITE1(4, sb4) LB_WRITE1(5, sb5) LB_WRITE1(6, sb6) LB_WRITE1(7, sb7) }
constexpr int GSTAGE = 49152;

__device__ __forceinline__ void gemm_compute(f32x4 (&acc)[4][8], const unsigned char* a_, int aoff, int boff) {
  const unsigned char* b_ = a_ + 16384;
#pragma unroll
  for (int ks = 0; ks < 2; ++ks) {
    bf16x8 af[4], bfr[8];
#pragma unroll
    for (int m = 0; m < 4; ++m) af[m] = *(const bf16x8*)(a_ + (aoff ^ (ks * 64)) + m * 2048);
#pragma unroll
    for (int n = 0; n < 8; ++n) bfr[n] = *(const bf16x8*)(b_ + (boff ^ (ks * 64)) + n * 2048);
#pragma unroll
    for (int m = 0; m < 4; ++m)
#pragma unroll
      for (int n = 0; n < 8; ++n) acc[m][n] = __builtin_amdgcn_mfma_f32_16x16x32_bf16(bfr[n], af[m], acc[m][n], 0, 0, 0);
  }
}

__device__ __forceinline__ void gemm_core(f32x4 (&acc)[4][8], const bf16_t* Aptr, int lda, const bf16_t* Bt, int ldb, int K, unsigned char* smem) {
  const int tid = get_tid(), lane = tid & 63, wave = tid >> 6, wm = wave >> 1, wn = wave & 1;
  const int dl = lane & 15, gq = lane >> 4, swz = (dl >> 1) & 7;
  const int aoff = (wm * 64 + dl) * 128 + ((gq ^ swz) << 4);
  const int boff = (wn * 128 + dl) * 128 + ((gq ^ swz) << 4);
  const int r0 = tid >> 3, c0 = tid & 7;
  const int wbase = lds_off(r0, c0);
  const unsigned lda2 = (unsigned)lda * 2u, ldb2 = (unsigned)ldb * 2u;
  const unsigned voffA = (unsigned)r0 * lda2 + c0 * 16, voffB = (unsigned)r0 * ldb2 + c0 * 16;
  const unsigned char* Ab = (const unsigned char*)Aptr; const unsigned char* Bb = (const unsigned char*)Bt;
  f32x4 ra0, ra1, ra2, ra3, rb0, rb1, rb2, rb3, rb4, rb5, rb6, rb7;
  f32x4 sa0, sa1, sa2, sa3, sb0, sb1, sb2, sb3, sb4, sb5, sb6, sb7;
  const int nt = K >> 6;
  G_LOAD_A(0) G_LOAD_B(1) L_WRITE_A(smem) __syncthreads();
#pragma unroll 1
  for (int t = 0; t < nt; t += 2) {
    if (t + 2 < nt) G_LOAD_A(t + 2)
    gemm_compute(acc, smem, aoff, boff);
    L_WRITE_B(smem + GSTAGE)
    __syncthreads();
    if (t + 3 < nt) G_LOAD_B(t + 3)
    gemm_compute(acc, smem + GSTAGE, aoff, boff);
    if (t + 2 < nt) L_WRITE_A(smem)
    __syncthreads();
  }
}

__device__ __forceinline__ void zero_acc(f32x4 (&acc)[4][8]) {
#pragma unroll
  for (int m = 0; m < 4; ++m)
#pragma unroll
    for (int n = 0; n < 8; ++n) acc[m][n] = (f32x4){0.f, 0.f, 0.f, 0.f};
}

__device__ __forceinline__ bool tile_of(int it, int ntn, int& tm, int& tn) {
  if (gridDim.x == 256) {
    const int xcd = blockIdx.x & 7, s = blockIdx.x >> 3;
    const int gn_cnt = ntn >> 2, g = it * 8 + xcd;
    if (g >= 48 * gn_cnt) return false;
    const int gm = g / gn_cnt, gn = g % gn_cnt;
    tm = gm * 8 + (s & 7); tn = gn * 4 + (s >> 3);
    return true;
  }
  const int tile = blockIdx.x + it * gridDim.x;
  if (tile >= 384 * ntn) return false;
  tm = tile / ntn; tn = tile % ntn; return true;
}

__device__ void phase_g1(const Params& p, int layer, unsigned char* smem) {
  const int lane = get_tid() & 63, wave = get_tid() >> 6, wm = wave >> 1, wn = wave & 1;
  int tm, tn;
  for (int it = 0; tile_of(it, 20, tm, tn); ++it) {
    const int row0 = tm * 128, col0 = tn * 256;
    f32x4 acc[4][8]; zero_acc(acc);
    gemm_core(acc, p.xb + (size_t)row0 * 1024, 1024, p.w1t + (size_t)col0 * 1024, 1024, 1024, smem);
#pragma unroll
    for (int m = 0; m < 4; ++m) {
      const int row = row0 + wm * 64 + m * 16 + (lane & 15);
#pragma unroll
      for (int n = 0; n < 8; ++n) {
        const int col = col0 + wn * 128 + n * 16 + (lane >> 4) * 4;
        float v0 = acc[m][n][0], v1 = acc[m][n][1], v2 = acc[m][n][2], v3 = acc[m][n][3];
        bf16_t* dst;
        if (col < QKVW) dst = p.qkv + (size_t)row * QKVW + col;
        else if (col < 4096) dst = p.rest + (size_t)row * RESTW + (col - QKVW);
        else { dst = p.ys + (size_t)row * 1024 + (col - 4096); v0 *= sigmoidf_(v0); v1 *= sigmoidf_(v1); v2 *= sigmoidf_(v2); v3 *= sigmoidf_(v3); }
        uint2 o; o.x = pack2(v0, v1); o.y = pack2(v2, v3);
        *(uint2*)dst = o;
      }
      asm volatile("" ::: "memory");
    }
  }
}

__device__ void phase_branch(const Params& p, unsigned char* smem) {
  const int lane = get_tid() & 63, wave = get_tid() >> 6, wm = wave >> 1, wn = wave & 1;
  int tm, tn;
  for (int it = 0; tile_of(it, 16, tm, tn); ++it) {
    const int row0 = tm * 128, col0 = tn * 256, b = tn >> 2;
    f32x4 acc[4][8]; zero_acc(acc);
    gemm_core(acc, p.ys + (size_t)row0 * 1024 + b * 256, 1024, p.wbrt + (size_t)col0 * 256, 256, 256, smem);
#pragma unroll
    for (int m = 0; m < 4; ++m) {
      const int row = row0 + wm * 64 + m * 16 + (lane & 15);
#pragma unroll
      for (int n = 0; n < 8; ++n) {
        const int col = col0 + wn * 128 + n * 16 + (lane >> 4) * 4;
        uint2 o; o.x = pack2(acc[m][n][0], acc[m][n][1]); o.y = pack2(acc[m][n][2], acc[m][n][3]);
        *(uint2*)(p.branch + (size_t)row * 4096 + col) = o;
      }
    }
  }
}

__device__ void phase_gate(const Params& p, int layer, unsigned char* smem) {
  const int lane = get_tid() & 63, wave = get_tid() >> 6, wm = wave >> 1, wn = wave & 1;
  int tm, tn;
  for (int it = 0; tile_of(it, 16, tm, tn); ++it) {
    const int row0 = tm * 128;
    f32x4 acc[4][8]; zero_acc(acc);
    gemm_core(acc, p.xb + (size_t)row0 * 1024, 1024, p.wgt + (size_t)tn * 256 * 1024, 1024, 1024, smem);
#pragma unroll
    for (int m = 0; m < 4; ++m) {
      const int row = row0 + wm * 64 + m * 16 + (lane & 15);
#pragma unroll
      for (int dg = 0; dg < 2; ++dg) {
        const int d = tn * 64 + wn * 32 + dg * 16 + (lane >> 4) * 4;
        float s0 = 0.f, s1 = 0.f, s2 = 0.f, s3 = 0.f;
#pragma unroll
        for (int b = 0; b < 4; ++b) {
          uint2 br = *(const uint2*)(p.branch + (size_t)row * 4096 + b * 1024 + d);
          s0 += sigmoidf_(acc[m][dg * 4 + b][0]) * __uint_as_float(br.x << 16);
          s1 += sigmoidf_(acc[m][dg * 4 + b][1]) * __uint_as_float(br.x & 0xffff0000u);
          s2 += sigmoidf_(acc[m][dg * 4 + b][2]) * __uint_as_float(br.y << 16);
          s3 += sigmoidf_(acc[m][dg * 4 + b][3]) * __uint_as_float(br.y & 0xffff0000u);
        }
        uint2 o; o.x = pack2(s0, s1); o.y = pack2(s2, s3);
        *(uint2*)(p.ys + (size_t)row * 1024 + d) = o;
        asm volatile("" ::: "memory");
      }
    }
  }
}

__device__ void phase_out(const Params& p, int layer, unsigned char* smem) {
  const int lane = get_tid() & 63, wave = get_tid() >> 6, wm = wave >> 1, wn = wave & 1;
  int tm, tn;
  for (int it = 0; tile_of(it, 4, tm, tn); ++it) {
    const int row0 = tm * 128, col0 = tn * 256;
    f32x4 acc[4][8]; zero_acc(acc);
    gemm_core(acc, p.ys + (size_t)row0 * 1024, 1024, p.woutt + (size_t)col0 * 1024, 1024, 1024, smem);
#pragma unroll
    for (int m = 0; m < 4; ++m) {
      const int row = row0 + wm * 64 + m * 16 + (lane & 15);
      const float* xr = xrow_ptr(p, layer, row);
#pragma unroll
      for (int n = 0; n < 8; ++n) {
        const int col = col0 + wn * 128 + n * 16 + (lane >> 4) * 4;
        float4 xv = *(const float4*)(xr + col);
        float4 o; o.x = xv.x + acc[m][n][0]; o.y = xv.y + acc[m][n][1]; o.z = xv.z + acc[m][n][2]; o.w = xv.w + acc[m][n][3];
        if (!DRY(p)) *(float4*)(p.out + (size_t)row * 1024 + col) = o;
      }
    }
  }
}

constexpr int QS_STRIDE = 144, KS_STRIDE = 144, VT_STRIDE = 432;
__device__ void attn_item(const Params& p, int layer, int item, unsigned char* smem) {
  const int tid = get_tid(), lane = tid & 63, w = tid >> 6;
  const int n = item % 12, run = item / 12, T0 = run * 64;
  const int g = n >> 2, h = n & 3, d = g == 0 ? 1 : (g == 1 ? 4 : 16);
  int sstart, slen; seq_of(T0, sstart, slen);
  const int rho = (T0 - sstart) >> 6;
  const int r = rho % d, i0 = (rho / d) * 64;
  unsigned char* Qs = smem;
  unsigned char* Ks = smem + 64 * QS_STRIDE;
  unsigned char* Vt = Ks + 208 * KS_STRIDE;
  const float* kg = p.k_norm_g + layer * 64;
  const float* qg = p.q_norm_g + layer * 64;
  const int part = tid & 3;
  {
    const int q = tid >> 2;
    const int pq = d * (i0 + q) + r;
    const bf16_t* base = p.qkv + (size_t)(sstart + pq) * QKVW + n * 64 + part * 16;
    const uint4 a0 = *(const uint4*)base, a1 = *(const uint4*)(base + 8);
    const unsigned ww[8] = {a0.x, a0.y, a0.z, a0.w, a1.x, a1.y, a1.z, a1.w};
    float f[16]; float ss = 0.f;
#pragma unroll
    for (int j = 0; j < 8; ++j) { f[2 * j] = __uint_as_float(ww[j] << 16); f[2 * j + 1] = __uint_as_float(ww[j] & 0xffff0000u); ss += f[2 * j] * f[2 * j] + f[2 * j + 1] * f[2 * j + 1]; }
    ss += dpp_qx1(ss); ss += dpp_qx2(ss);
    const float rs = rsqrtf(ss * (1.f / 64.f) + 1e-6f) * 0.125f;
    unsigned* qd = (unsigned*)(Qs + q * QS_STRIDE + part * 32);
#pragma unroll
    for (int j = 0; j < 8; ++j) qd[j] = pack2(f[2 * j] * rs * qg[part * 16 + 2 * j], f[2 * j + 1] * rs * qg[part * 16 + 2 * j + 1]);
  }
#pragma unroll
  for (int it = 0; it < 4; ++it) {
    const int rr = (tid >> 2) + it * 64;
    const int pos = d * (i0 - 64 + rr) + r;
    const bool ok = rr < 192 && pos >= 0 && pos < slen;
    uint4 k0 = {0, 0, 0, 0}, k1 = {0, 0, 0, 0}, v0 = {0, 0, 0, 0}, v1 = {0, 0, 0, 0};
    if (ok) {
      const bf16_t* base = p.qkv + (size_t)(sstart + pos) * QKVW + n * 64 + part * 16;
      k0 = *(const uint4*)(base + 768); k1 = *(const uint4*)(base + 768 + 8);
      v0 = *(const uint4*)(base + 1536); v1 = *(const uint4*)(base + 1536 + 8);
    }
    const unsigned kw[8] = {k0.x, k0.y, k0.z, k0.w, k1.x, k1.y, k1.z, k1.w};
    float kf[16]; float ss = 0.f;
#pragma unroll
    for (int j = 0; j < 8; ++j) { kf[2 * j] = __uint_as_float(kw[j] << 16); kf[2 * j + 1] = __uint_as_float(kw[j] & 0xffff0000u); ss += kf[2 * j] * kf[2 * j] + kf[2 * j + 1] * kf[2 * j + 1]; }
    ss += dpp_qx1(ss); ss += dpp_qx2(ss);
    const float rs = rsqrtf(ss * (1.f / 64.f) + 1e-6f);
    if (rr < 208) {
      unsigned* kd = (unsigned*)(Ks + rr * KS_STRIDE + part * 32);
#pragma unroll
      for (int j = 0; j < 8; ++j) kd[j] = pack2(kf[2 * j] * rs * kg[part * 16 + 2 * j], kf[2 * j + 1] * rs * kg[part * 16 + 2 * j + 1]);
      const unsigned vw[8] = {v0.x, v0.y, v0.z, v0.w, v1.x, v1.y, v1.z, v1.w};
#pragma unroll
      for (int j = 0; j < 8; ++j) {
        *(bf16_t*)(Vt + (part * 16 + 2 * j) * VT_STRIDE + rr * 2) = (bf16_t)(vw[j] & 0xffffu);
        *(bf16_t*)(Vt + (part * 16 + 2 * j + 1) * VT_STRIDE + rr * 2) = (bf16_t)(vw[j] >> 16);
      }
    }
  }
  __syncthreads();
  const int dl = lane & 15, gq = lane >> 4;
  bf16x8 qf0 = *(const bf16x8*)(Qs + (16 * w + dl) * QS_STRIDE + gq * 16);
  bf16x8 qf1 = *(const bf16x8*)(Qs + (16 * w + dl) * QS_STRIDE + 64 + gq * 16);
  const float slope = exp2f(-8.f * (float)(n + 1) / 12.f) * (float)d;
  float pv[10][4];
  float dsum = 0.f;
#pragma unroll
  for (int t = 0; t < 10; ++t) {
    const unsigned char* kp = Ks + ((w + t) * 16 + dl) * KS_STRIDE + gq * 16;
    f32x4 sacc = {0.f, 0.f, 0.f, 0.f};
    sacc = __builtin_amdgcn_mfma_f32_16x16x32_bf16(*(const bf16x8*)kp, qf0, sacc, 0, 0, 0);
    sacc = __builtin_amdgcn_mfma_f32_16x16x32_bf16(*(const bf16x8*)(kp + 64), qf1, sacc, 0, 0, 0);
#pragma unroll
    for (int j = 0; j < 4; ++j) {
      const int m = 16 * t + 4 * gq + j - dl;
      const int kr = (w + t) * 16 + 4 * gq + j;
      const int pos = d * (i0 - 64 + kr) + r;
      const bool ok = m >= 0 && m <= 128 && pos >= 0 && pos < slen;
      const float e = ok ? __expf(sacc[j] - slope * fabsf((float)(m - 64))) : 0.f;
      pv[t][j] = e; dsum += e;
    }
  }
  f32x4 oacc[4];
#pragma unroll
  for (int dt = 0; dt < 4; ++dt) oacc[dt] = (f32x4){0.f, 0.f, 0.f, 0.f};
#pragma unroll
  for (int u = 0; u < 5; ++u) {
    union { bf16x8 v; unsigned uu[4]; } pb;
    pb.uu[0] = pack2(pv[2 * u][0], pv[2 * u][1]); pb.uu[1] = pack2(pv[2 * u][2], pv[2 * u][3]);
    pb.uu[2] = pack2(pv[2 * u + 1][0], pv[2 * u + 1][1]); pb.uu[3] = pack2(pv[2 * u + 1][2], pv[2 * u + 1][3]);
#pragma unroll
    for (int dt = 0; dt < 4; ++dt) {
      const unsigned char* vp = Vt + (dt * 16 + dl) * VT_STRIDE + ((w + 2 * u) * 16 + 4 * gq) * 2;
      union { bf16x8 v; uint2 h2[2]; } va;
      va.h2[0] = *(const uint2*)vp; va.h2[1] = *(const uint2*)(vp + 32);
      oacc[dt] = __builtin_amdgcn_mfma_f32_16x16x32_bf16(va.v, pb.v, oacc[dt], 0, 0, 0);
    }
  }
  dsum += __shfl_xor(dsum, 16); dsum += __shfl_xor(dsum, 32);
  {
    const int ql = 16 * w + dl;
    const size_t tok = (size_t)(sstart + d * (i0 + ql) + r);
    float* np = p.pnum + (size_t)g * ((size_t)MTOK * 256) + (tok * 4 + h) * 64 + 4 * gq;
#pragma unroll
    for (int dt = 0; dt < 4; ++dt) *(f32x4*)(np + dt * 16) = oacc[dt];
    if (gq == 0) p.pden[(size_t)g * ((size_t)MTOK * 4) + tok * 4 + h] = dsum;
  }
  __syncthreads();
}

__device__ void attn_combine(const Params& p) {
  const size_t nvec = (size_t)MTOK * 64;
  for (size_t i = (size_t)blockIdx.x * 256 + get_tid(); i < nvec; i += (size_t)gridDim.x * 256) {
    const size_t th = i >> 4;
    const int e4 = (int)(i & 15);
    const f32x4 a = *(const f32x4*)(p.pnum + i * 4), b = *(const f32x4*)(p.pnum + (size_t)MTOK * 256 + i * 4), c = *(const f32x4*)(p.pnum + 2 * (size_t)MTOK * 256 + i * 4);
    const float den = p.pden[th] + p.pden[(size_t)MTOK * 4 + th] + p.pden[2 * (size_t)MTOK * 4 + th];
    const float inv = 1.f / den;
    const size_t tok = th >> 2; const int h = (int)(th & 3);
    bf16_t* y = p.ys + tok * 1024 + h * 64 + e4 * 4;
    uint2 yv = *(const uint2*)y;
    float y0 = __uint_as_float(yv.x << 16), y1 = __uint_as_float(yv.x & 0xffff0000u), y2 = __uint_as_float(yv.y << 16), y3 = __uint_as_float(yv.y & 0xffff0000u);
    uint2 o; o.x = pack2(y0 * (a[0] + b[0] + c[0]) * inv, y1 * (a[1] + b[1] + c[1]) * inv); o.y = pack2(y2 * (a[2] + b[2] + c[2]) * inv, y3 * (a[3] + b[3] + c[3]) * inv);
    if (!DRY(p)) *(uint2*)y = o;
  }
}

__device__ void pool_item(const Params& p, int layer, int item, unsigned char* smem) {
  const int tid = get_tid();
  const int g = item & 3, T0 = (item >> 2) * 64;
  int sstart, slen; seq_of(T0, sstart, slen);
  const int P0 = T0 - sstart;
  const int hw = 1 << g;
  float* u = (float*)smem;
  float* dd = u + 80 * 64;
  float* w = dd + 64 * 65;
  for (int i = tid; i < 80 * 64; i += 256) {
    const int rr = i >> 6, c = i & 63, pos = P0 - 8 + rr;
    u[i] = (pos >= 0 && pos < slen) ? bf2f(p.rest[(size_t)(sstart + pos) * RESTW + g * 64 + c]) : 0.f;
  }
  const float* pw = p.pool_w + ((size_t)layer * 4 + g) * 4096;
  for (int i = tid; i < 4096; i += 256) w[i] = pw[i];
  __syncthreads();
  for (int i = tid; i < 64 * 64; i += 256) {
    const int t = i >> 6, c = i & 63, pos = P0 + t;
    float s = 0.f;
    for (int o = -hw; o < hw; ++o) s += u[(t + 8 + o) * 64 + c];
    const int lo = pos - hw > 0 ? pos - hw : 0, hi = pos + hw < slen ? pos + hw : slen;
    dd[t * 65 + c] = s / (float)(hi - lo) - u[(t + 8) * 64 + c];
  }
  __syncthreads();
  {
    const int t = tid >> 2, e0 = (tid & 3) * 16;
    float acc[16];
#pragma unroll
    for (int e = 0; e < 16; ++e) acc[e] = 0.f;
    for (int c = 0; c < 64; ++c) {
      const float dv = dd[t * 65 + c];
#pragma unroll
      for (int e = 0; e < 16; ++e) acc[e] += dv * w[c * 64 + e0 + e];
    }
    const float* sc = p.pool_scale + layer * 256 + g * 64 + e0;
    bf16_t* y = p.ys + (size_t)(T0 + t) * 1024 + 256 + g * 64 + e0;
#pragma unroll
    for (int e = 0; e < 16; ++e) if (!DRY(p)) y[e] = f2bf(bf2f(y[e]) * acc[e] * sc[e]);
  }
  __syncthreads();
}

__device__ void sg_item(const Params& p, int layer, int item, unsigned char* smem) {
  const int tid = get_tid(), lane = tid & 63, wave = tid >> 6;
  const int g = item & 3, T0 = (item >> 2) * 128;
  float* vn = (float*)smem;
  float* sw = vn + 128 * 64;
  for (int s = wave; s < 128; s += 4) {
    const bf16_t* vr = p.rest + (size_t)(T0 + s) * RESTW + 512;
    float ss = 0.f; float mine = 0.f;
#pragma unroll
    for (int j = 0; j < 4; ++j) { float v = bf2f(vr[j * 64 + lane]); ss += v * v; if (j == g) mine = v; }
    ss = wave_sum(ss);
    const float rs = rsqrtf(ss * (1.f / 256.f) + 1e-6f);
    vn[s * 64 + lane] = mine * rs * p.sg_norm_g[layer * 256 + g * 64 + lane];
  }
  const float* gw = p.sg_w + ((size_t)layer * 4 + g) * 128 * 128;
  for (int i = tid; i < 128 * 128; i += 256) sw[(i >> 7) * 129 + (i & 127)] = gw[i];
  __syncthreads();
  {
    const int t = tid >> 1, d0 = (tid & 1) * 32;
    float acc[32];
#pragma unroll
    for (int e = 0; e < 32; ++e) acc[e] = 0.f;
    for (int s = 0; s < 128; ++s) {
      const float wv = sw[t * 129 + s];
      const float4* vp = (const float4*)(vn + s * 64 + d0);
#pragma unroll
      for (int e = 0; e < 8; ++e) { float4 v = vp[e]; acc[4 * e] += wv * v.x; acc[4 * e + 1] += wv * v.y; acc[4 * e + 2] += wv * v.z; acc[4 * e + 3] += wv * v.w; }
    }
    const float bias = p.sg_b[(layer * 4 + g) * 128 + t];
    const bf16_t* ur = p.rest + (size_t)(T0 + t) * RESTW + 256 + g * 64 + d0;
    bf16_t* y = p.ys + (size_t)(T0 + t) * 1024 + 512 + g * 64 + d0;
#pragma unroll
    for (int e = 0; e < 32; ++e) if (!DRY(p)) y[e] = f2bf(bf2f(y[e]) * bf2f(ur[e]) * (acc[e] + bias));
  }
  __syncthreads();
}

__device__ void phase_mix(const Params& p, int layer, unsigned char* smem) {
  const int NA = 9216, NS = 1536, NP = 3072;
  for (int it = blockIdx.x; it < NA + NS + NP; it += gridDim.x) {
    if (it < NA) attn_item(p, layer, it, smem);
    else if (it < NA + NS) sg_item(p, layer, it - NA, smem);
    else pool_item(p, layer, it - NA - NS, smem);
  }
}

struct RwkvLds {
  float wup[64 * 64], aup[64 * 64];
  float tw[32 * 64], ta[32 * 64];
  float R[32 * 64], W[32 * 64], K[32 * 64], V[32 * 64], KK[32 * 64], B[32 * 64];
  float ot[32 * 64];
  float yt[128 * 64];
};

__device__ __forceinline__ float red8(float v) { v += dpp_qx1(v); v += dpp_qx2(v); v += dpp_hm(v); return v; }

struct ScanOps { f32x4 w0, w1, b0, b1, kk0, kk1, k0, k1, r0, r1; float2 v; };
template <bool PASS_C>
__device__ __forceinline__ ScanOps load_ops(const RwkvLds& L, int tk, int j0, int row0) {
  ScanOps o;
  o.w0 = *(const f32x4*)(L.W + tk * 64 + j0); o.w1 = *(const f32x4*)(L.W + tk * 64 + j0 + 4);
  o.b0 = *(const f32x4*)(L.B + tk * 64 + j0); o.b1 = *(const f32x4*)(L.B + tk * 64 + j0 + 4);
  o.kk0 = *(const f32x4*)(L.KK + tk * 64 + j0); o.kk1 = *(const f32x4*)(L.KK + tk * 64 + j0 + 4);
  o.k0 = *(const f32x4*)(L.K + tk * 64 + j0); o.k1 = *(const f32x4*)(L.K + tk * 64 + j0 + 4);
  if (PASS_C) { o.r0 = *(const f32x4*)(L.R + tk * 64 + j0); o.r1 = *(const f32x4*)(L.R + tk * 64 + j0 + 4); }
  else { o.r0 = o.w0; o.r1 = o.w1; }
  o.v = *(const float2*)(L.V + tk * 64 + row0);
  return o;
}
template <bool PASS_C>
__device__ void rwkv_job(const Params& p, int layer, int job, unsigned char* smem) {
  RwkvLds& L = *(RwkvLds*)smem;
  const int tid = get_tid(), lane = tid & 63, wave = tid >> 6;
  const int hd = job & 3, cp = job >> 2, t0 = cp * 128;
  int sstart, slen; seq_of(t0, sstart, slen);
  const int send = sstart + slen;
  const int rp = tid >> 3, jg = tid & 7, row0 = rp * 2, j0 = jg * 8;
  if (PASS_C) { for (int i = tid; i < 128 * 64; i += 256) L.yt[i] = 0.f; }
#pragma unroll 1
  for (int dir = 0; dir < 2; ++dir) {
    const int ld = layer * 2 + dir;
    float* slot = p.pg + ((size_t)cp * 8 + dir * 4 + hd) * 8192;
    __syncthreads();
    for (int i = tid; i < 4096; i += 256) {
      const int m = i >> 6, j = i & 63;
      L.wup[i] = p.w_up[((size_t)ld * 64 + m) * 256 + hd * 64 + j];
      L.aup[i] = p.a_up[((size_t)ld * 64 + m) * 256 + hd * 64 + j];
    }
    float S[2][8], Pst[2][8];
#pragma unroll
    for (int rr = 0; rr < 2; ++rr)
#pragma unroll
      for (int j = 0; j < 8; ++j) {
        if (PASS_C) { S[rr][j] = slot[4096 + (row0 + rr) * 64 + j0 + j]; Pst[rr][j] = 0.f; }
        else { S[rr][j] = 0.f; Pst[rr][j] = (row0 + rr == j0 + j) ? 1.f : 0.f; }
      }
    const int cidx = hd * 64 + lane;
    const float mu_r = p.mu_rkv[ld * 768 + cidx], mu_k = p.mu_rkv[ld * 768 + 256 + cidx], mu_v = p.mu_rkv[ld * 768 + 512 + cidx];
    const float mu_w = p.mu_lat[ld * 128 + lane], mu_a = p.mu_lat[ld * 128 + 64 + lane];
    const float w0v = p.w0[ld * 256 + cidx], a0v = p.a0[ld * 256 + cidx];
    const float kkv = p.k_k[ld * 256 + cidx], kav = p.k_a[ld * 256 + cidx], rkv_ = p.r_k[ld * 256 + cidx];
    bf16_t raw[8][10];
#pragma unroll
    for (int i = 0; i < 8; ++i) {
      const int tau = wave * 8 + i;
      const int t = dir ? (t0 + 127 - tau) : (t0 + tau);
      const int tp = dir ? t + 1 : t - 1;
      const bool pv = tp >= sstart && tp < send;
      const bf16_t* cr = p.rest + (size_t)t * RESTW;
      const bf16_t* pr = p.rest + (size_t)(pv ? tp : t) * RESTW;
      raw[i][0] = cr[768 + cidx]; raw[i][1] = cr[1024 + cidx]; raw[i][2] = cr[1280 + cidx]; raw[i][3] = cr[1536 + dir * 128 + lane]; raw[i][4] = cr[1536 + dir * 128 + 64 + lane];
      raw[i][5] = pv ? pr[768 + cidx] : (bf16_t)0; raw[i][6] = pv ? pr[1024 + cidx] : (bf16_t)0; raw[i][7] = pv ? pr[1280 + cidx] : (bf16_t)0;
      raw[i][8] = pv ? pr[1536 + dir * 128 + lane] : (bf16_t)0; raw[i][9] = pv ? pr[1536 + dir * 128 + 64 + lane] : (bf16_t)0;
    }
#pragma unroll 1
    for (int sb = 0; sb < 4; ++sb) {
      __syncthreads();
#pragma unroll
      for (int i = 0; i < 8; ++i) {
        const int tk = wave * 8 + i;
        const float cr_r = bf2f(raw[i][0]), cr_k = bf2f(raw[i][1]), cr_v = bf2f(raw[i][2]), cr_w = bf2f(raw[i][3]), cr_a = bf2f(raw[i][4]);
        const float pr_r = bf2f(raw[i][5]), pr_k = bf2f(raw[i][6]), pr_v = bf2f(raw[i][7]), pr_w = bf2f(raw[i][8]), pr_a = bf2f(raw[i][9]);
        L.R[tk * 64 + lane] = cr_r + (pr_r - cr_r) * mu_r;
        L.K[tk * 64 + lane] = cr_k + (pr_k - cr_k) * mu_k;
        L.V[tk * 64 + lane] = cr_v + (pr_v - cr_v) * mu_v;
        { const float xw = cr_w + (pr_w - cr_w) * mu_w; L.tw[tk * 64 + lane] = 1.f - 2.f * __builtin_amdgcn_rcpf(1.f + __expf(2.f * xw)); }
        L.ta[tk * 64 + lane] = cr_a + (pr_a - cr_a) * mu_a;
      }
      if (sb + 1 < 4) {
#pragma unroll
        for (int i = 0; i < 8; ++i) {
          const int tau = (sb + 1) * 32 + wave * 8 + i;
          const int t = dir ? (t0 + 127 - tau) : (t0 + tau);
          const int tp = dir ? t + 1 : t - 1;
          const bool pv = tp >= sstart && tp < send;
          const bf16_t* cr = p.rest + (size_t)t * RESTW;
          const bf16_t* pr = p.rest + (size_t)(pv ? tp : t) * RESTW;
          raw[i][0] = cr[768 + cidx]; raw[i][1] = cr[1024 + cidx]; raw[i][2] = cr[1280 + cidx]; raw[i][3] = cr[1536 + dir * 128 + lane]; raw[i][4] = cr[1536 + dir * 128 + 64 + lane];
          raw[i][5] = pv ? pr[768 + cidx] : (bf16_t)0; raw[i][6] = pv ? pr[1024 + cidx] : (bf16_t)0; raw[i][7] = pv ? pr[1280 + cidx] : (bf16_t)0;
          raw[i][8] = pv ? pr[1536 + dir * 128 + lane] : (bf16_t)0; raw[i][9] = pv ? pr[1536 + dir * 128 + 64 + lane] : (bf16_t)0;
        }
      }
      __syncthreads();
      float accw[8], acca[8];
#pragma unroll
      for (int i = 0; i < 8; ++i) { accw[i] = 0.f; acca[i] = 0.f; }
#pragma unroll 1
      for (int m4 = 0; m4 < 16; ++m4) {
        float wu[4], au[4];
#pragma unroll
        for (int e = 0; e < 4; ++e) { wu[e] = L.wup[(m4 * 4 + e) * 64 + lane]; au[e] = L.aup[(m4 * 4 + e) * 64 + lane]; }
#pragma unroll
        for (int i = 0; i < 8; ++i) {
          const float4 tw4 = *(const float4*)(L.tw + (wave * 8 + i) * 64 + m4 * 4);
          const float4 ta4 = *(const float4*)(L.ta + (wave * 8 + i) * 64 + m4 * 4);
          accw[i] += tw4.x * wu[0] + tw4.y * wu[1] + tw4.z * wu[2] + tw4.w * wu[3];
          acca[i] += ta4.x * au[0] + ta4.y * au[1] + ta4.z * au[2] + ta4.w * au[3];
        }
      }
#pragma unroll
      for (int i = 0; i < 8; ++i) {
        const int tk = wave * 8 + i, tau = sb * 32 + tk;
        const int tl = dir ? (127 - tau) : tau;
        const float wpre = w0v + accw[i];
        const float nx = -wpre;
        const float sp = fmaxf(nx, 0.f) + __logf(1.f + __expf(-fabsf(nx)));
        const float wlog = -sp - 0.5f;
        const float decay = __expf(-__expf(wlog));
        const float a = sigmoidf_(a0v + acca[i]);
        const float k = L.K[tk * 64 + lane], r = L.R[tk * 64 + lane], v = L.V[tk * 64 + lane];
        float kk = k * kkv;
        const float ss = wave_sum(kk * kk);
        kk *= rsqrtf(ss + 1e-12f);
        const float k2 = k * (1.f + (a - 1.f) * kav);
        const float bs = wave_sum(r * k2 * rkv_);
        L.W[tk * 64 + lane] = decay; L.K[tk * 64 + lane] = k2; L.KK[tk * 64 + lane] = kk; L.B[tk * 64 + lane] = kk * a;
        if (PASS_C) L.yt[tl * 64 + lane] += bs * v;
      }
      __syncthreads();
      ScanOps cur = load_ops<PASS_C>(L, 0, j0, row0);
#pragma unroll 4
      for (int tk = 0; tk < 32; ++tk) {
        const ScanOps nx = load_ops<PASS_C>(L, (tk + 1) & 31, j0, row0);
        float w[8], b[8], kkr[8], k[8];
#pragma unroll
        for (int j = 0; j < 4; ++j) { w[j] = cur.w0[j]; w[j + 4] = cur.w1[j]; b[j] = cur.b0[j]; b[j + 4] = cur.b1[j]; kkr[j] = cur.kk0[j]; kkr[j + 4] = cur.kk1[j]; k[j] = cur.k0[j]; k[j + 4] = cur.k1[j]; }
        const float vr[2] = {cur.v.x, cur.v.y};
        float sa[2], sp[2] = {0.f, 0.f};
#pragma unroll
        for (int rr = 0; rr < 2; ++rr) {
          float a0 = S[rr][0] * kkr[0], a1 = S[rr][1] * kkr[1];
#pragma unroll
          for (int j = 2; j < 8; j += 2) { a0 += S[rr][j] * kkr[j]; a1 += S[rr][j + 1] * kkr[j + 1]; }
          sa[rr] = a0 + a1;
          if (!PASS_C) {
            float p0 = Pst[rr][0] * kkr[0], p1 = Pst[rr][1] * kkr[1];
#pragma unroll
            for (int j = 2; j < 8; j += 2) { p0 += Pst[rr][j] * kkr[j]; p1 += Pst[rr][j + 1] * kkr[j + 1]; }
            sp[rr] = p0 + p1;
          }
        }
        sa[0] = red8(sa[0]); sa[1] = red8(sa[1]);
        if (!PASS_C) { sp[0] = red8(sp[0]); sp[1] = red8(sp[1]); }
#pragma unroll
        for (int rr = 0; rr < 2; ++rr)
#pragma unroll
          for (int j = 0; j < 8; ++j) {
            S[rr][j] = S[rr][j] * w[j] + (vr[rr] * k[j] - sa[rr] * b[j]);
            if (!PASS_C) Pst[rr][j] = Pst[rr][j] * w[j] - sp[rr] * b[j];
          }
        if (PASS_C) {
          float o0 = 0.f, o1 = 0.f;
#pragma unroll
          for (int j = 0; j < 4; ++j) { o0 += S[0][j] * cur.r0[j] + S[0][j + 4] * cur.r1[j]; o1 += S[1][j] * cur.r0[j] + S[1][j + 4] * cur.r1[j]; }
          o0 = red8(o0); o1 = red8(o1);
          if (jg == 0) { L.ot[tk * 64 + row0] = o0; L.ot[tk * 64 + row0 + 1] = o1; }
        }
        cur = nx;
      }
      if (PASS_C) {
        __syncthreads();
        const int tk = tid >> 3, part = tid & 7, tau = sb * 32 + tk;
        const int tl = dir ? (127 - tau) : tau;
        float o[8]; float s1 = 0.f;
#pragma unroll
        for (int e = 0; e < 8; ++e) { o[e] = L.ot[tk * 64 + part * 8 + e]; s1 += o[e]; }
        s1 = red8(s1);
        const float mu = s1 * (1.f / 64.f);
        float s2 = 0.f;
#pragma unroll
        for (int e = 0; e < 8; ++e) { o[e] -= mu; s2 += o[e] * o[e]; }
        s2 = red8(s2);
        const float rs = rsqrtf(s2 * (1.f / 64.f) + 64e-5f);
#pragma unroll
        for (int e = 0; e < 8; ++e) {
          const int ch = hd * 64 + part * 8 + e;
          L.yt[tl * 64 + part * 8 + e] += o[e] * rs * p.ln_g[layer * 256 + ch] + p.ln_b[layer * 256 + ch];
        }
      }
    }
    if (!PASS_C) {
#pragma unroll
      for (int rr = 0; rr < 2; ++rr)
#pragma unroll
        for (int j = 0; j < 8; ++j) { slot[(row0 + rr) * 64 + j0 + j] = Pst[rr][j]; slot[4096 + (row0 + rr) * 64 + j0 + j] = S[rr][j]; }
    }
  }
  if (PASS_C) {
    __syncthreads();
    for (int i = tid; i < 128 * 64; i += 256) {
      const int tl = i >> 6, e = i & 63;
      bf16_t* y = p.ys + (size_t)(t0 + tl) * 1024 + 768 + hd * 64 + e;
      if (!DRY(p)) *y = f2bf(bf2f(*y) * L.yt[i]);
    }
  }
  __syncthreads();
}

__device__ void rwkv_passB(const Params& p, unsigned char* smem) {
  float* Pl = (float*)smem;
  float* Sl = Pl + 4096;
  const int tid = get_tid();
  for (int wk = blockIdx.x; wk < 128; wk += gridDim.x) {
    const int rg = wk & 3, hd = (wk >> 2) & 3, dir = (wk >> 4) & 1, seq = wk >> 5;
    const int cbase = seq == 0 ? 0 : seq == 1 ? 64 : seq == 2 ? 128 : 256;
    const int nch = seq < 2 ? 64 : 128;
    const int row = tid >> 4, jq = tid & 15;
    __syncthreads();
    for (int i = tid; i < 16 * 64; i += 256) Sl[i] = 0.f;
    __syncthreads();
    float4 pf0, pf1, pf2, pf3, gf;
    {
      const int c = dir ? nch - 1 : 0;
      const float* slot = p.pg + ((size_t)(cbase + c) * 8 + dir * 4 + hd) * 8192;
      pf0 = ((const float4*)slot)[tid]; pf1 = ((const float4*)slot)[tid + 256]; pf2 = ((const float4*)slot)[tid + 512]; pf3 = ((const float4*)slot)[tid + 768];
      gf = *(const float4*)(slot + 4096 + (rg * 16 + row) * 64 + jq * 4);
    }
#pragma unroll 1
    for (int ci = 0; ci < nch; ++ci) {
      const int c = dir ? nch - 1 - ci : ci;
      float* slot = p.pg + ((size_t)(cbase + c) * 8 + dir * 4 + hd) * 8192;
      ((float4*)Pl)[tid] = pf0; ((float4*)Pl)[tid + 256] = pf1; ((float4*)Pl)[tid + 512] = pf2; ((float4*)Pl)[tid + 768] = pf3;
      float* gp = slot + 4096 + (rg * 16 + row) * 64 + jq * 4;
      float4 acc = gf;
      if (ci + 1 < nch) {
        const int c2 = dir ? nch - 2 - ci : ci + 1;
        const float* s2 = p.pg + ((size_t)(cbase + c2) * 8 + dir * 4 + hd) * 8192;
        pf0 = ((const float4*)s2)[tid]; pf1 = ((const float4*)s2)[tid + 256]; pf2 = ((const float4*)s2)[tid + 512]; pf3 = ((const float4*)s2)[tid + 768];
        gf = *(const float4*)(s2 + 4096 + (rg * 16 + row) * 64 + jq * 4);
      }
      __syncthreads();
      float4 sold = *(const float4*)(Sl + row * 64 + jq * 4);
#pragma unroll 4
      for (int m4 = 0; m4 < 16; ++m4) {
        const float4 s4 = *(const float4*)(Sl + row * 64 + m4 * 4);
        const float sv[4] = {s4.x, s4.y, s4.z, s4.w};
#pragma unroll
        for (int e = 0; e < 4; ++e) {
          const float4 pv = *(const float4*)(Pl + (m4 * 4 + e) * 64 + jq * 4);
          acc.x += sv[e] * pv.x; acc.y += sv[e] * pv.y; acc.z += sv[e] * pv.z; acc.w += sv[e] * pv.w;
        }
      }
      if (!DRY(p)) *(float4*)gp = sold;
      __syncthreads();
      *(float4*)(Sl + row * 64 + jq * 4) = acc;
      __syncthreads();
    }
  }
}

__device__ __forceinline__ void run_phase(const Params& p, int layer, int sub, unsigned char* smem) {
  switch (sub) {
    case 0: phase_prep(p, layer); break;
    case 1: phase_g1(p, layer, smem); break;
    case 2: phase_mix(p, layer, smem); break;
    case 3: for (int j = blockIdx.x; j < 1536; j += gridDim.x) rwkv_job<false>(p, layer, j, smem); attn_combine(p); break;
    case 4: rwkv_passB(p, smem); break;
    case 5: for (int j = blockIdx.x; j < 1536; j += gridDim.x) rwkv_job<true>(p, layer, j, smem); break;
    case 6: phase_branch(p, smem); break;
    case 7: phase_gate(p, layer, smem); break;
    case 8: phase_out(p, layer, smem); break;
  }
}
__global__ void __launch_bounds__(256) mega(Params p) {
  extern __shared__ __attribute__((aligned(16))) unsigned char smem[];
  cg::grid_group grid = cg::this_grid();
  for (int ph = p.phase_lo; ph < p.phase_hi; ++ph) {
    const int layer = ph / NPH, sub = ph % NPH;
#if PROBE_MASK
    for (int rep = (PROBE_MASK >> sub) & 1; rep >= 0; --rep) {
      __syncthreads(); if (get_tid() == 0) s_dry = rep; __syncthreads();
      run_phase(p, layer, sub, smem);
      if (rep) grid.sync();
    }
#else
    run_phase(p, layer, sub, smem);
#endif
    if (ph + 1 < p.phase_hi) grid.sync();
  }
}

extern "C" void kernel_launch(void* const* d_in, const int* in_sizes, int n_in, void* d_out, int out_size, void* d_ws, size_t ws_size, hipStream_t stream) {
  static int grid_blocks = 0;
  if (!grid_blocks) {
    hipFuncSetAttribute((const void*)mega, hipFuncAttributeMaxDynamicSharedMemorySize, SMEM_BYTES);
    int dev = 0, cus = 0, per_cu = 0;
    hipGetDevice(&dev);
    hipDeviceGetAttribute(&cus, hipDeviceAttributeMultiprocessorCount, dev);
    hipOccupancyMaxActiveBlocksPerMultiprocessor(&per_cu, mega, 256, SMEM_BYTES);
    if (per_cu < 1) per_cu = 1;
    grid_blocks = cus * per_cu;
  }
  Params p{};
  p.xp = (const float*)d_in[0]; p.xs = (const float*)d_in[1];
  p.norm_g = (const float*)d_in[2]; p.w_in = (const float*)d_in[3]; p.q_norm_g = (const float*)d_in[4]; p.k_norm_g = (const float*)d_in[5];
  p.pool_w = (const float*)d_in[6]; p.pool_scale = (const float*)d_in[7]; p.sg_norm_g = (const float*)d_in[8]; p.sg_w = (const float*)d_in[9]; p.sg_b = (const float*)d_in[10];
  p.mu_rkv = (const float*)d_in[11]; p.mu_lat = (const float*)d_in[12]; p.w0 = (const float*)d_in[13]; p.w_up = (const float*)d_in[14]; p.a0 = (const float*)d_in[15]; p.a_up = (const float*)d_in[16];
  p.k_k = (const float*)d_in[17]; p.k_a = (const float*)d_in[18]; p.r_k = (const float*)d_in[19]; p.ln_g = (const float*)d_in[20]; p.ln_b = (const float*)d_in[21];
  p.w_branch = (const float*)d_in[22]; p.w_out = (const float*)d_in[23];
  p.out = (float*)d_out;
  unsigned char* ws = (unsigned char*)d_ws;
  size_t off = 0;
  p.qkv = (bf16_t*)(ws + off); off += (size_t)MTOK * QKVW * 2;
  p.rest = (bf16_t*)(ws + off); off += (size_t)MTOK * RESTW * 2;
  p.ys = (bf16_t*)(ws + off); off += (size_t)MTOK * 1024 * 2;
  p.w1t = (bf16_t*)(ws + off); off += (size_t)5120 * 1024 * 2;
  p.wgt = (bf16_t*)(ws + off); off += (size_t)4096 * 1024 * 2;
  p.wbrt = (bf16_t*)(ws + off); off += (size_t)4096 * 256 * 2;
  p.woutt = (bf16_t*)(ws + off); off += (size_t)1024 * 1024 * 2;
  p.rstd = (float*)(ws + off); off += (size_t)MTOK * 4;
  p.xb = (bf16_t*)(ws + off); off += (size_t)MTOK * 1024 * 2;
  p.pnum = (float*)(ws + off); off += (size_t)3 * MTOK * 256 * 4;
  p.pden = (float*)(ws + off); off += (size_t)3 * MTOK * 4 * 4;
  p.pg = (float*)p.qkv;
  p.branch = p.qkv;
  if (off > ws_size) { fprintf(stderr, "workspace too small: need %zu have %zu\n", off, ws_size); return; }
#if MULTI_LAUNCH
  for (int ph = 0; ph < 2 * NPH; ++ph) {
    p.phase_lo = ph; p.phase_hi = ph + 1;
    hipLaunchKernelGGL(mega, dim3(grid_blocks), dim3(256), SMEM_BYTES, stream, p);
  }
#else
  p.phase_lo = 0; p.phase_hi = 2 * NPH;
  void* args[] = {&p};
  hipError_t e = hipLaunchCooperativeKernel((void*)mega, dim3(grid_blocks), dim3(256), args, SMEM_BYTES, stream);
  if (e != hipSuccess) fprintf(stderr, "cooperative launch failed: %s (grid %d)\n", hipGetErrorString(e), grid_blocks);
#endif
}
```

```cpp
#include <hip/hip_runtime.h>
#include <hip/hip_cooperative_groups.h>
#include <cstdio>
namespace cg = cooperative_groups;

#ifndef PROBE_MASK
#define PROBE_MASK 0
#endif
#if PROBE_MASK
__shared__ int s_dry;
#define DRY(p) (s_dry)
#else
#define DRY(p) 0
#endif
#ifndef MULTI_LAUNCH
#define MULTI_LAUNCH 0
#endif

typedef unsigned short bf16_t;
typedef short bf16x8 __attribute__((ext_vector_type(8)));
typedef float f32x4 __attribute__((ext_vector_type(4)));
typedef __bf16 bf2v __attribute__((ext_vector_type(2)));

constexpr int MTOK = 49152;
constexpr int DM = 1024;
constexpr int PW = 9216;
constexpr int QKVW = 2304;
constexpr int RESTW = 1792;
constexpr int SMEM_BYTES = 73728;
constexpr int NPH = 9;

struct Params {
  const float* xp; const float* xs;
  const float* norm_g; const float* w_in; const float* q_norm_g; const float* k_norm_g;
  const float* pool_w; const float* pool_scale; const float* sg_norm_g; const float* sg_w; const float* sg_b;
  const float* mu_rkv; const float* mu_lat; const float* w0; const float* w_up; const float* a0; const float* a_up;
  const float* k_k; const float* k_a; const float* r_k; const float* ln_g; const float* ln_b;
  const float* w_branch; const float* w_out;
  float* out;
  bf16_t* qkv; bf16_t* rest; bf16_t* ys;
  bf16_t* w1t; bf16_t* wgt; bf16_t* wbrt; bf16_t* woutt;
  float* rstd; float* pg; bf16_t* branch; bf16_t* xb; float* pnum; float* pden;
  int phase_lo, phase_hi;
  int dry, pad_;
};

__device__ __forceinline__ int get_tid() { int t = threadIdx.x; asm volatile("" : "+v"(t)); return t; }
__device__ __forceinline__ float bf2f(bf16_t v) { return __uint_as_float(((unsigned)v) << 16); }
__device__ __forceinline__ bf16_t f2bf(float f) { unsigned u = __float_as_uint(f); u += 0x7fffu + ((u >> 16) & 1u); return (bf16_t)(u >> 16); }
__device__ __forceinline__ unsigned pack2(float a, float b) { return (unsigned)f2bf(a) | ((unsigned)f2bf(b) << 16); }
__device__ __forceinline__ float sigmoidf_(float x) { return __builtin_amdgcn_rcpf(1.f + __expf(-x)); }
__device__ __forceinline__ float dpp_qx1(float v) { return __int_as_float(__builtin_amdgcn_update_dpp(0, __float_as_int(v), 0xB1, 0xF, 0xF, true)); }
__device__ __forceinline__ float dpp_qx2(float v) { return __int_as_float(__builtin_amdgcn_update_dpp(0, __float_as_int(v), 0x4E, 0xF, 0xF, true)); }
__device__ __forceinline__ float dpp_hm(float v) { return __int_as_float(__builtin_amdgcn_update_dpp(0, __float_as_int(v), 0x141, 0xF, 0xF, true)); }
__device__ __forceinline__ float wave_sum(float v) {
  v += __int_as_float(__builtin_amdgcn_update_dpp(0, __float_as_int(v), 0xB1, 0xF, 0xF, true));
  v += __int_as_float(__builtin_amdgcn_update_dpp(0, __float_as_int(v), 0x4E, 0xF, 0xF, true));
  v += __int_as_float(__builtin_amdgcn_update_dpp(0, __float_as_int(v), 0x141, 0xF, 0xF, true));
  v += __int_as_float(__builtin_amdgcn_update_dpp(0, __float_as_int(v), 0x140, 0xF, 0xF, true));
  v += __shfl_xor(v, 16); v += __shfl_xor(v, 32);
  return v;
}
__device__ __forceinline__ const float* xrow_ptr(const Params& p, int layer, int row) {
  if (layer == 0) return row < 16384 ? p.xp + (size_t)row * DM : p.xs + (size_t)(row - 16384) * DM;
  return p.out + (size_t)row * DM;
}
__device__ __forceinline__ void seq_of(int T0, int& sstart, int& slen) {
  if (T0 < 16384) { sstart = T0 & ~8191; slen = 8192; } else { sstart = 16384 + ((T0 - 16384) & ~16383); slen = 16384; }
}

__device__ void phase_prep(const Params& p, int layer) {
  const int tid = get_tid(), lane = tid & 63;
  const int gw = (blockIdx.x * 256 + tid) >> 6, nw = gridDim.x * 4;
  for (int row = gw; row < MTOK; row += nw) {
    const float4* x = (const float4*)xrow_ptr(p, layer, row);
    float ss = 0.f;
#pragma unroll
    for (int i = 0; i < 4; ++i) { float4 v = x[lane + i * 64]; ss += v.x * v.x + v.y * v.y + v.z * v.z + v.w * v.w; }
    ss = wave_sum(ss);
    const float rs = rsqrtf(ss * (1.f / 1024.f) + 1e-6f);
#pragma unroll
    for (int i = 0; i < 4; ++i) { float4 v = x[lane + i * 64]; uint2 o; o.x = pack2(v.x * rs, v.y * rs); o.y = pack2(v.z * rs, v.w * rs); *(uint2*)(p.xb + (size_t)row * 1024 + (lane + i * 64) * 4) = o; }
  }
  const float* w_in = p.w_in + (size_t)layer * DM * PW;
  const float* ng = p.norm_g + layer * DM;
  const long gt = (long)blockIdx.x * 256 + tid, nthr = (long)gridDim.x * 256;
  for (long idx = gt; idx < 5120L * 128; idx += nthr) {
    int n = (int)(idx % 5120), kc = (int)(idx / 5120);
    int col;
    if (n < 2304) col = n; else if (n < 2560) col = 2560 + (n - 2304); else if (n < 3072) col = 3072 + (n - 2560);
    else if (n < 3840) col = 3840 + (n - 3072); else if (n < 4096) col = 4608 + (n - 3840);
    else if (n < 4352) col = 2304 + (n - 4096); else if (n < 4608) col = 2816 + (n - 4352);
    else if (n < 4864) col = 3584 + (n - 4608); else col = 4864 + (n - 4864);
    float v[8];
#pragma unroll
    for (int j = 0; j < 8; ++j) { int k = kc * 8 + j; v[j] = ng[k] * w_in[(size_t)k * PW + col]; }
    uint4 o; o.x = pack2(v[0], v[1]); o.y = pack2(v[2], v[3]); o.z = pack2(v[4], v[5]); o.w = pack2(v[6], v[7]);
    *(uint4*)(p.w1t + (size_t)n * 1024 + kc * 8) = o;
  }
  for (long idx = gt; idx < 4096L * 128; idx += nthr) {
    int n = (int)(idx % 4096), kc = (int)(idx / 4096);
    int tn = n >> 8, c = n & 255, wn = c >> 7, nn = (c >> 4) & 7, dl = c & 15, dg = nn >> 2, b = nn & 3;
    int col = 5120 + b * 1024 + tn * 64 + wn * 32 + dg * 16 + dl;
    float v[8];
#pragma unroll
    for (int j = 0; j < 8; ++j) { int k = kc * 8 + j; v[j] = ng[k] * w_in[(size_t)k * PW + col]; }
    uint4 o; o.x = pack2(v[0], v[1]); o.y = pack2(v[2], v[3]); o.z = pack2(v[4], v[5]); o.w = pack2(v[6], v[7]);
    *(uint4*)(p.wgt + (size_t)n * 1024 + kc * 8) = o;
  }
  const float* wb = p.w_branch + (size_t)layer * 4 * 256 * 1024;
  for (long idx = gt; idx < 4096L * 32; idx += nthr) {
    int n = (int)(idx % 4096), kc = (int)(idx / 4096);
    int b = n >> 10, d = n & 1023;
    float v[8];
#pragma unroll
    for (int j = 0; j < 8; ++j) { int k = kc * 8 + j; v[j] = wb[((size_t)b * 256 + k) * 1024 + d]; }
    uint4 o; o.x = pack2(v[0], v[1]); o.y = pack2(v[2], v[3]); o.z = pack2(v[4], v[5]); o.w = pack2(v[6], v[7]);
    *(uint4*)(p.wbrt + (size_t)n * 256 + kc * 8) = o;
  }
  const float* wo = p.w_out + (size_t)layer * 1024 * 1024;
  for (long idx = gt; idx < 1024L * 128; idx += nthr) {
    int n = (int)(idx % 1024), kc = (int)(idx / 1024);
    float v[8];
#pragma unroll
    for (int j = 0; j < 8; ++j) { int k = kc * 8 + j; v[j] = wo[(size_t)k * 1024 + n]; }
    uint4 o; o.x = pack2(v[0], v[1]); o.y = pack2(v[2], v[3]); o.z = pack2(v[4], v[5]); o.w = pack2(v[6], v[7]);
    *(uint4*)(p.woutt + (size_t)n * 1024 + kc * 8) = o;
  }
}

__device__ __forceinline__ int lds_off(int r, int c) { return r * 128 + ((c ^ ((r >> 1) & 7)) << 4); }

#define GA_LOAD1(i, RA) RA = *(const f32x4*)(Ab + (size_t)(tt * 64) + (voffA + (unsigned)((i) * 64) * lda2));
#define GB_LOAD1(i, RB) RB = *(const f32x4*)(Bb + (size_t)(tt * 64) + (voffB + (unsigned)((i) * 64) * ldb2));
#define LA_WRITE1(i, RA) *(f32x4*)(sa_ + wbase + (i) * 4096) = RA;
#define LB_WRITE1(i, RB) *(f32x4*)(sa_ + 8192 + wbase + (i) * 4096) = RB;
#define G_LOAD_A(T) { const int tt = (T); GA_LOAD1(0, ra0) GA_LOAD1(1, ra1) GB_LOAD1(0, rb0) GB_LOAD1(1, rb1) GB_LOAD1(2, rb2) GB_LOAD1(3, rb3) }
#define L_WRITE_A(P) { unsigned char* sa_ = (P); LA_WRITE1(0, ra0) LA_WRITE1(1, ra1) LB_WRITE1(0, rb0) LB_WRITE1(1, rb1) LB_WRITE1(2, rb2) LB_WRITE1(3, rb3) }
#define G_LOAD_B(T) { const int tt = (T); GA_LOAD1(0, sa0) GA_LOAD1(1, sa1) GB_LOAD1(0, sb0) GB_LOAD1(1, sb1) GB_LOAD1(2, sb2) GB_LOAD1(3, sb3) }
#define L_WRITE_B(P) { unsigned char* sa_ = (P); LA_WRITE1(0, sa0) LA_WRITE1(1, sa1) LB_WRITE1(0, sb0) LB_WRITE1(1, sb1) LB_WRITE1(2, sb2) LB_WRITE1(3, sb3) }
constexpr int GSTAGE = 24576;

__device__ __forceinline__ int lds_off32(int r, int c) { return r * 64 + ((c ^ (((r >> 3) & 1) * 3)) << 4); }

__device__ __forceinline__ void gemm_compute(f32x4 (&acc)[4][8], const unsigned char* a_, int aoff, int boff) {
  const unsigned char* b_ = a_ + 8192;
  bf16x8 af[4], bfr[8];
#pragma unroll
  for (int m = 0; m < 4; ++m) af[m] = *(const bf16x8*)(a_ + aoff + m * 1024);
#pragma unroll
  for (int n = 0; n < 8; ++n) bfr[n] = *(const bf16x8*)(b_ + boff + n * 1024);
#pragma unroll
  for (int m = 0; m < 4; ++m)
#pragma unroll
    for (int n = 0; n < 8; ++n) acc[m][n] = __builtin_amdgcn_mfma_f32_16x16x32_bf16(bfr[n], af[m], acc[m][n], 0, 0, 0);
}

__device__ __forceinline__ void gemm_core(f32x4 (&acc)[4][8], const bf16_t* Aptr, int lda, const bf16_t* Bt, int ldb, int K, unsigned char* smem) {
  const int tid = get_tid(), lane = tid & 63, wave = tid >> 6, wm = wave >> 1, wn = wave & 1;
  const int dl = lane & 15, gq = lane >> 4, swz = ((dl >> 3) & 1) * 3;
  const int aoff = (wm * 64 + dl) * 64 + ((gq ^ swz) << 4);
  const int boff = (wn * 128 + dl) * 64 + ((gq ^ swz) << 4);
  const int r0 = tid >> 2, c0 = tid & 3;
  const int wbase = lds_off32(r0, c0);
  const unsigned lda2 = (unsigned)lda * 2u, ldb2 = (unsigned)ldb * 2u;
  const unsigned voffA = (unsigned)r0 * lda2 + c0 * 16, voffB = (unsigned)r0 * ldb2 + c0 * 16;
  const unsigned char* Ab = (const unsigned char*)Aptr; const unsigned char* Bb = (const unsigned char*)Bt;
  f32x4 ra0, ra1, rb0, rb1, rb2, rb3;
  f32x4 sa0, sa1, sb0, sb1, sb2, sb3;
  const int nt = K >> 5;
  G_LOAD_A(0) G_LOAD_B(1) L_WRITE_A(smem) __syncthreads();
#pragma unroll 1
  for (int t = 0; t < nt; t += 2) {
    if (t + 2 < nt) G_LOAD_A(t + 2)
    gemm_compute(acc, smem, aoff, boff);
    L_WRITE_B(smem + GSTAGE)
    __syncthreads();
    if (t + 3 < nt) G_LOAD_B(t + 3)
    gemm_compute(acc, smem + GSTAGE, aoff, boff);
    if (t + 2 < nt) L_WRITE_A(smem)
    __syncthreads();
  }
}

__device__ __forceinline__ void zero_acc(f32x4 (&acc)[4][8]) {
#pragma unroll
  for (int m = 0; m < 4; ++m)
#pragma unroll
    for (int n = 0; n < 8; ++n) acc[m][n] = (f32x4){0.f, 0.f, 0.f, 0.f};
}

__device__ __forceinline__ bool tile_of(int it, int ntn, int& tm, int& tn) {
  if (gridDim.x == 256 || gridDim.x == 512) {
    const int xcd = blockIdx.x & 7, s = blockIdx.x >> 3;
    const int gmh = gridDim.x == 512 ? 16 : 8;
    const int gn_cnt = ntn >> 2, g = it * 8 + xcd;
    if (g >= (384 / gmh) * gn_cnt) return false;
    const int gm = g / gn_cnt, gn = g % gn_cnt;
    tm = gm * gmh + (s & (gmh - 1)); tn = gn * 4 + s / gmh;
    return true;
  }
  const int tile = blockIdx.x + it * gridDim.x;
  if (tile >= 384 * ntn) return false;
  tm = tile / ntn; tn = tile % ntn; return true;
}

__device__ void phase_g1(const Params& p, int layer, unsigned char* smem) {
  const int lane = get_tid() & 63, wave = get_tid() >> 6, wm = wave >> 1, wn = wave & 1;
  int tm, tn;
  for (int it = 0; tile_of(it, 20, tm, tn); ++it) {
    const int row0 = tm * 128, col0 = tn * 256;
    f32x4 acc[4][8]; zero_acc(acc);
    gemm_core(acc, p.xb + (size_t)row0 * 1024, 1024, p.w1t + (size_t)col0 * 1024, 1024, 1024, smem);
#pragma unroll
    for (int m = 0; m < 4; ++m) {
      const int row = row0 + wm * 64 + m * 16 + (lane & 15);
#pragma unroll
      for (int n = 0; n < 8; ++n) {
        const int col = col0 + wn * 128 + n * 16 + (lane >> 4) * 4;
        float v0 = acc[m][n][0], v1 = acc[m][n][1], v2 = acc[m][n][2], v3 = acc[m][n][3];
        bf16_t* dst;
        if (col < QKVW) dst = p.qkv + (size_t)row * QKVW + col;
        else if (col < 4096) dst = p.rest + (size_t)row * RESTW + (col - QKVW);
        else { dst = p.ys + (size_t)row * 1024 + (col - 4096); v0 *= sigmoidf_(v0); v1 *= sigmoidf_(v1); v2 *= sigmoidf_(v2); v3 *= sigmoidf_(v3); }
        uint2 o; o.x = pack2(v0, v1); o.y = pack2(v2, v3);
        *(uint2*)dst = o;
      }
      asm volatile("" ::: "memory");
    }
  }
}

__device__ void phase_branch(const Params& p, unsigned char* smem) {
  const int lane = get_tid() & 63, wave = get_tid() >> 6, wm = wave >> 1, wn = wave & 1;
  int tm, tn;
  for (int it = 0; tile_of(it, 16, tm, tn); ++it) {
    const int row0 = tm * 128, col0 = tn * 256, b = tn >> 2;
    f32x4 acc[4][8]; zero_acc(acc);
    gemm_core(acc, p.ys + (size_t)row0 * 1024 + b * 256, 1024, p.wbrt + (size_t)col0 * 256, 256, 256, smem);
#pragma unroll
    for (int m = 0; m < 4; ++m) {
      const int row = row0 + wm * 64 + m * 16 + (lane & 15);
#pragma unroll
      for (int n = 0; n < 8; ++n) {
        const int col = col0 + wn * 128 + n * 16 + (lane >> 4) * 4;
        uint2 o; o.x = pack2(acc[m][n][0], acc[m][n][1]); o.y = pack2(acc[m][n][2], acc[m][n][3]);
        *(uint2*)(p.branch + (size_t)row * 4096 + col) = o;
      }
    }
  }
}

__device__ void phase_gate(const Params& p, int layer, unsigned char* smem) {
  const int lane = get_tid() & 63, wave = get_tid() >> 6, wm = wave >> 1, wn = wave & 1;
  int tm, tn;
  for (int it = 0; tile_of(it, 16, tm, tn); ++it) {
    const int row0 = tm * 128;
    f32x4 acc[4][8]; zero_acc(acc);
    gemm_core(acc, p.xb + (size_t)row0 * 1024, 1024, p.wgt + (size_t)tn * 256 * 1024, 1024, 1024, smem);
#pragma unroll
    for (int m = 0; m < 4; ++m) {
      const int row = row0 + wm * 64 + m * 16 + (lane & 15);
#pragma unroll
      for (int dg = 0; dg < 2; ++dg) {
        const int d = tn * 64 + wn * 32 + dg * 16 + (lane >> 4) * 4;
        float s0 = 0.f, s1 = 0.f, s2 = 0.f, s3 = 0.f;
#pragma unroll
        for (int b = 0; b < 4; ++b) {
          uint2 br = *(const uint2*)(p.branch + (size_t)row * 4096 + b * 1024 + d);
          s0 += sigmoidf_(acc[m][dg * 4 + b][0]) * __uint_as_float(br.x << 16);
          s1 += sigmoidf_(acc[m][dg * 4 + b][1]) * __uint_as_float(br.x & 0xffff0000u);
          s2 += sigmoidf_(acc[m][dg * 4 + b][2]) * __uint_as_float(br.y << 16);
          s3 += sigmoidf_(acc[m][dg * 4 + b][3]) * __uint_as_float(br.y & 0xffff0000u);
        }
        uint2 o; o.x = pack2(s0, s1); o.y = pack2(s2, s3);
        *(uint2*)(p.ys + (size_t)row * 1024 + d) = o;
        asm volatile("" ::: "memory");
      }
    }
  }
}

__device__ void phase_out(const Params& p, int layer, unsigned char* smem) {
  const int lane = get_tid() & 63, wave = get_tid() >> 6, wm = wave >> 1, wn = wave & 1;
  int tm, tn;
  for (int it = 0; tile_of(it, 4, tm, tn); ++it) {
    const int row0 = tm * 128, col0 = tn * 256;
    f32x4 acc[4][8]; zero_acc(acc);
    gemm_core(acc, p.ys + (size_t)row0 * 1024, 1024, p.woutt + (size_t)col0 * 1024, 1024, 1024, smem);
#pragma unroll
    for (int m = 0; m < 4; ++m) {
      const int row = row0 + wm * 64 + m * 16 + (lane & 15);
      const float* xr = xrow_ptr(p, layer, row);
#pragma unroll
      for (int n = 0; n < 8; ++n) {
        const int col = col0 + wn * 128 + n * 16 + (lane >> 4) * 4;
        float4 xv = *(const float4*)(xr + col);
        float4 o; o.x = xv.x + acc[m][n][0]; o.y = xv.y + acc[m][n][1]; o.z = xv.z + acc[m][n][2]; o.w = xv.w + acc[m][n][3];
        if (!DRY(p)) *(float4*)(p.out + (size_t)row * 1024 + col) = o;
      }
    }
  }
}

constexpr int QS_STRIDE = 144, KS_STRIDE = 144, VT_STRIDE = 432;
__device__ void attn_item(const Params& p, int layer, int item, unsigned char* smem) {
  const int tid = get_tid(), lane = tid & 63, w = tid >> 6;
  const int n = item % 12, run = item / 12, T0 = run * 64;
  const int g = n >> 2, h = n & 3, d = g == 0 ? 1 : (g == 1 ? 4 : 16);
  int sstart, slen; seq_of(T0, sstart, slen);
  const int rho = (T0 - sstart) >> 6;
  const int r = rho % d, i0 = (rho / d) * 64;
  unsigned char* Qs = smem;
  unsigned char* Ks = smem + 64 * QS_STRIDE;
  unsigned char* Vt = Ks + 208 * KS_STRIDE;
  const float* kg = p.k_norm_g + layer * 64;
  const float* qg = p.q_norm_g + layer * 64;
  const int part = tid & 3;
  {
    const int q = tid >> 2;
    const int pq = d * (i0 + q) + r;
    const bf16_t* base = p.qkv + (size_t)(sstart + pq) * QKVW + n * 64 + part * 16;
    const uint4 a0 = *(const uint4*)base, a1 = *(const uint4*)(base + 8);
    const unsigned ww[8] = {a0.x, a0.y, a0.z, a0.w, a1.x, a1.y, a1.z, a1.w};
    float f[16]; float ss = 0.f;
#pragma unroll
    for (int j = 0; j < 8; ++j) { f[2 * j] = __uint_as_float(ww[j] << 16); f[2 * j + 1] = __uint_as_float(ww[j] & 0xffff0000u); ss += f[2 * j] * f[2 * j] + f[2 * j + 1] * f[2 * j + 1]; }
    ss += dpp_qx1(ss); ss += dpp_qx2(ss);
    const float rs = rsqrtf(ss * (1.f / 64.f) + 1e-6f) * 0.125f;
    unsigned* qd = (unsigned*)(Qs + q * QS_STRIDE + part * 32);
#pragma unroll
    for (int j = 0; j < 8; ++j) qd[j] = pack2(f[2 * j] * rs * qg[part * 16 + 2 * j], f[2 * j + 1] * rs * qg[part * 16 + 2 * j + 1]);
  }
#pragma unroll
  for (int it = 0; it < 4; ++it) {
    const int rr = (tid >> 2) + it * 64;
    const int pos = d * (i0 - 64 + rr) + r;
    const bool ok = rr < 192 && pos >= 0 && pos < slen;
    uint4 k0 = {0, 0, 0, 0}, k1 = {0, 0, 0, 0}, v0 = {0, 0, 0, 0}, v1 = {0, 0, 0, 0};
    if (ok) {
      const bf16_t* base = p.qkv + (size_t)(sstart + pos) * QKVW + n * 64 + part * 16;
      k0 = *(const uint4*)(base + 768); k1 = *(const uint4*)(base + 768 + 8);
      v0 = *(const uint4*)(base + 1536); v1 = *(const uint4*)(base + 1536 + 8);
    }
    const unsigned kw[8] = {k0.x, k0.y, k0.z, k0.w, k1.x, k1.y, k1.z, k1.w};
    float kf[16]; float ss = 0.f;
#pragma unroll
    for (int j = 0; j < 8; ++j) { kf[2 * j] = __uint_as_float(kw[j] << 16); kf[2 * j + 1] = __uint_as_float(kw[j] & 0xffff0000u); ss += kf[2 * j] * kf[2 * j] + kf[2 * j + 1] * kf[2 * j + 1]; }
    ss += dpp_qx1(ss); ss += dpp_qx2(ss);
    const float rs = rsqrtf(ss * (1.f / 64.f) + 1e-6f);
    if (rr < 208) {
      unsigned* kd = (unsigned*)(Ks + rr * KS_STRIDE + part * 32);
#pragma unroll
      for (int j = 0; j < 8; ++j) kd[j] = pack2(kf[2 * j] * rs * kg[part * 16 + 2 * j], kf[2 * j + 1] * rs * kg[part * 16 + 2 * j + 1]);
      const unsigned vw[8] = {v0.x, v0.y, v0.z, v0.w, v1.x, v1.y, v1.z, v1.w};
#pragma unroll
      for (int j = 0; j < 8; ++j) {
        *(bf16_t*)(Vt + (part * 16 + 2 * j) * VT_STRIDE + rr * 2) = (bf16_t)(vw[j] & 0xffffu);
        *(bf16_t*)(Vt + (part * 16 + 2 * j + 1) * VT_STRIDE + rr * 2) = (bf16_t)(vw[j] >> 16);
      }
    }
  }
  __syncthreads();
  const int dl = lane & 15, gq = lane >> 4;
  bf16x8 qf0 = *(const bf16x8*)(Qs + (16 * w + dl) * QS_STRIDE + gq * 16);
  bf16x8 qf1 = *(const bf16x8*)(Qs + (16 * w + dl) * QS_STRIDE + 64 + gq * 16);
  const float slope = exp2f(-8.f * (float)(n + 1) / 12.f) * (float)d;
  float pv[10][4];
  float dsum = 0.f;
#pragma unroll
  for (int t = 0; t < 10; ++t) {
    const unsigned char* kp = Ks + ((w + t) * 16 + dl) * KS_STRIDE + gq * 16;
    f32x4 sacc = {0.f, 0.f, 0.f, 0.f};
    sacc = __builtin_amdgcn_mfma_f32_16x16x32_bf16(*(const bf16x8*)kp, qf0, sacc, 0, 0, 0);
    sacc = __builtin_amdgcn_mfma_f32_16x16x32_bf16(*(const bf16x8*)(kp + 64), qf1, sacc, 0, 0, 0);
#pragma unroll
    for (int j = 0; j < 4; ++j) {
      const int m = 16 * t + 4 * gq + j - dl;
      const int kr = (w + t) * 16 + 4 * gq + j;
      const int pos = d * (i0 - 64 + kr) + r;
      const bool ok = m >= 0 && m <= 128 && pos >= 0 && pos < slen;
      const float e = ok ? __expf(sacc[j] - slope * fabsf((float)(m - 64))) : 0.f;
      pv[t][j] = e; dsum += e;
    }
  }
  f32x4 oacc[4];
#pragma unroll
  for (int dt = 0; dt < 4; ++dt) oacc[dt] = (f32x4){0.f, 0.f, 0.f, 0.f};
#pragma unroll
  for (int u = 0; u < 5; ++u) {
    union { bf16x8 v; unsigned uu[4]; } pb;
    pb.uu[0] = pack2(pv[2 * u][0], pv[2 * u][1]); pb.uu[1] = pack2(pv[2 * u][2], pv[2 * u][3]);
    pb.uu[2] = pack2(pv[2 * u + 1][0], pv[2 * u + 1][1]); pb.uu[3] = pack2(pv[2 * u + 1][2], pv[2 * u + 1][3]);
#pragma unroll
    for (int dt = 0; dt < 4; ++dt) {
      const unsigned char* vp = Vt + (dt * 16 + dl) * VT_STRIDE + ((w + 2 * u) * 16 + 4 * gq) * 2;
      union { bf16x8 v; uint2 h2[2]; } va;
      va.h2[0] = *(const uint2*)vp; va.h2[1] = *(const uint2*)(vp + 32);
      oacc[dt] = __builtin_amdgcn_mfma_f32_16x16x32_bf16(va.v, pb.v, oacc[dt], 0, 0, 0);
    }
  }
  dsum += __shfl_xor(dsum, 16); dsum += __shfl_xor(dsum, 32);
  {
    const int ql = 16 * w + dl;
    const size_t tok = (size_t)(sstart + d * (i0 + ql) + r);
    float* np = p.pnum + (size_t)g * ((size_t)MTOK * 256) + (tok * 4 + h) * 64 + 4 * gq;
#pragma unroll
    for (int dt = 0; dt < 4; ++dt) *(f32x4*)(np + dt * 16) = oacc[dt];
    if (gq == 0) p.pden[(size_t)g * ((size_t)MTOK * 4) + tok * 4 + h] = dsum;
  }
  __syncthreads();
}

__device__ void attn_combine(const Params& p) {
  const size_t nvec = (size_t)MTOK * 64;
  for (size_t i = (size_t)blockIdx.x * 256 + get_tid(); i < nvec; i += (size_t)gridDim.x * 256) {
    const size_t th = i >> 4;
    const int e4 = (int)(i & 15);
    const f32x4 a = *(const f32x4*)(p.pnum + i * 4), b = *(const f32x4*)(p.pnum + (size_t)MTOK * 256 + i * 4), c = *(const f32x4*)(p.pnum + 2 * (size_t)MTOK * 256 + i * 4);
    const float den = p.pden[th] + p.pden[(size_t)MTOK * 4 + th] + p.pden[2 * (size_t)MTOK * 4 + th];
    const float inv = 1.f / den;
    const size_t tok = th >> 2; const int h = (int)(th & 3);
    bf16_t* y = p.ys + tok * 1024 + h * 64 + e4 * 4;
    uint2 yv = *(const uint2*)y;
    float y0 = __uint_as_float(yv.x << 16), y1 = __uint_as_float(yv.x & 0xffff0000u), y2 = __uint_as_float(yv.y << 16), y3 = __uint_as_float(yv.y & 0xffff0000u);
    uint2 o; o.x = pack2(y0 * (a[0] + b[0] + c[0]) * inv, y1 * (a[1] + b[1] + c[1]) * inv); o.y = pack2(y2 * (a[2] + b[2] + c[2]) * inv, y3 * (a[3] + b[3] + c[3]) * inv);
    if (!DRY(p)) *(uint2*)y = o;
  }
}

__device__ void pool_item(const Params& p, int layer, int item, unsigned char* smem) {
  const int tid = get_tid();
  const int g = item & 3, T0 = (item >> 2) * 64;
  int sstart, slen; seq_of(T0, sstart, slen);
  const int P0 = T0 - sstart;
  const int hw = 1 << g;
  float* u = (float*)smem;
  float* dd = u + 80 * 64;
  float* w = dd + 64 * 65;
  for (int i = tid; i < 80 * 64; i += 256) {
    const int rr = i >> 6, c = i & 63, pos = P0 - 8 + rr;
    u[i] = (pos >= 0 && pos < slen) ? bf2f(p.rest[(size_t)(sstart + pos) * RESTW + g * 64 + c]) : 0.f;
  }
  const float* pw = p.pool_w + ((size_t)layer * 4 + g) * 4096;
  for (int i = tid; i < 4096; i += 256) w[i] = pw[i];
  __syncthreads();
  for (int i = tid; i < 64 * 64; i += 256) {
    const int t = i >> 6, c = i & 63, pos = P0 + t;
    float s = 0.f;
    for (int o = -hw; o < hw; ++o) s += u[(t + 8 + o) * 64 + c];
    const int lo = pos - hw > 0 ? pos - hw : 0, hi = pos + hw < slen ? pos + hw : slen;
    dd[t * 65 + c] = s / (float)(hi - lo) - u[(t + 8) * 64 + c];
  }
  __syncthreads();
  {
    const int t = tid >> 2, e0 = (tid & 3) * 16;
    float acc[16];
#pragma unroll
    for (int e = 0; e < 16; ++e) acc[e] = 0.f;
    for (int c = 0; c < 64; ++c) {
      const float dv = dd[t * 65 + c];
#pragma unroll
      for (int e = 0; e < 16; ++e) acc[e] += dv * w[c * 64 + e0 + e];
    }
    const float* sc = p.pool_scale + layer * 256 + g * 64 + e0;
    bf16_t* y = p.ys + (size_t)(T0 + t) * 1024 + 256 + g * 64 + e0;
#pragma unroll
    for (int e = 0; e < 16; ++e) if (!DRY(p)) y[e] = f2bf(bf2f(y[e]) * acc[e] * sc[e]);
  }
  __syncthreads();
}

__device__ void sg_item(const Params& p, int layer, int item, unsigned char* smem) {
  const int tid = get_tid(), lane = tid & 63, wave = tid >> 6;
  const int g = item & 3, T0 = (item >> 2) * 128;
  float* vn = (float*)smem;
  float* sw = vn + 128 * 64;
  for (int s_ = wave; s_ < 128; s_ += 4) {
    const bf16_t* vr = p.rest + (size_t)(T0 + s_) * RESTW + 512;
    float ss = 0.f; float mine = 0.f;
#pragma unroll
    for (int j = 0; j < 4; ++j) { float v = bf2f(vr[j * 64 + lane]); ss += v * v; if (j == g) mine = v; }
    ss = wave_sum(ss);
    const float rs = rsqrtf(ss * (1.f / 256.f) + 1e-6f);
    vn[s_ * 64 + lane] = mine * rs * p.sg_norm_g[layer * 256 + g * 64 + lane];
  }
  const float* gw = p.sg_w + ((size_t)layer * 4 + g) * 128 * 128;
#pragma unroll 1
  for (int hh = 0; hh < 2; ++hh) {
    __syncthreads();
    for (int i = tid; i < 64 * 128; i += 256) sw[(i >> 7) * 129 + (i & 127)] = gw[hh * 64 * 128 + i];
    __syncthreads();
    const int tl = tid >> 2, t = hh * 64 + tl, d0 = (tid & 3) * 16;
    float acc[16];
#pragma unroll
    for (int e = 0; e < 16; ++e) acc[e] = 0.f;
#pragma unroll 2
    for (int s_ = 0; s_ < 128; ++s_) {
      const float wv = sw[tl * 129 + s_];
      const float4* vp = (const float4*)(vn + s_ * 64 + d0);
#pragma unroll
      for (int e = 0; e < 4; ++e) { float4 v = vp[e]; acc[4 * e] += wv * v.x; acc[4 * e + 1] += wv * v.y; acc[4 * e + 2] += wv * v.z; acc[4 * e + 3] += wv * v.w; }
    }
    const float bias = p.sg_b[(layer * 4 + g) * 128 + t];
    const bf16_t* ur = p.rest + (size_t)(T0 + t) * RESTW + 256 + g * 64 + d0;
    bf16_t* y = p.ys + (size_t)(T0 + t) * 1024 + 512 + g * 64 + d0;
#pragma unroll
    for (int e = 0; e < 16; ++e) if (!DRY(p)) y[e] = f2bf(bf2f(y[e]) * bf2f(ur[e]) * (acc[e] + bias));
  }
  __syncthreads();
}

__device__ void phase_mix(const Params& p, int layer, unsigned char* smem) {
  const int NA = 9216, NS = 1536, NP = 3072;
  for (int it = blockIdx.x; it < NA + NS + NP; it += gridDim.x) {
    if (it < NA) attn_item(p, layer, it, smem);
    else if (it < NA + NS) sg_item(p, layer, it - NA, smem);
    else pool_item(p, layer, it - NA - NS, smem);
  }
}

constexpr int SBT = 16;
struct RwkvLds {
  float wup[64 * 64], aup[64 * 64];
  float tw[SBT * 64], ta[SBT * 64];
  float R[SBT * 64], W[SBT * 64], K[SBT * 64], V[SBT * 64], KK[SBT * 64], B[SBT * 64];
  float ot[SBT * 64];
  float bon[SBT * 64];
};

__device__ __forceinline__ float red8(float v) { v += dpp_qx1(v); v += dpp_qx2(v); v += dpp_hm(v); return v; }
__device__ __forceinline__ float red16(float v) { v = red8(v); v += __int_as_float(__builtin_amdgcn_update_dpp(0, __float_as_int(v), 0x140, 0xF, 0xF, true)); return v; }

struct ScanOps { f32x4 w0, w1, b0, b1, kk0, kk1, k0, k1, r0, r1; float2 v; };
template <bool PASS_C>
__device__ __forceinline__ ScanOps load_ops(const RwkvLds& L, int tk, int j0, int row0) {
  ScanOps o;
  o.w0 = *(const f32x4*)(L.W + tk * 64 + j0); o.w1 = *(const f32x4*)(L.W + tk * 64 + j0 + 4);
  o.b0 = *(const f32x4*)(L.B + tk * 64 + j0); o.b1 = *(const f32x4*)(L.B + tk * 64 + j0 + 4);
  o.kk0 = *(const f32x4*)(L.KK + tk * 64 + j0); o.kk1 = *(const f32x4*)(L.KK + tk * 64 + j0 + 4);
  o.k0 = *(const f32x4*)(L.K + tk * 64 + j0); o.k1 = *(const f32x4*)(L.K + tk * 64 + j0 + 4);
  if (PASS_C) { o.r0 = *(const f32x4*)(L.R + tk * 64 + j0); o.r1 = *(const f32x4*)(L.R + tk * 64 + j0 + 4); }
  else { o.r0 = o.w0; o.r1 = o.w1; }
  o.v = *(const float2*)(L.V + tk * 64 + row0);
  return o;
}

#define RAW_LOAD(SBI) { _Pragma("unroll") for (int i = 0; i < 4; ++i) { \
      const int tau = (SBI) * SBT + wave * 4 + i; \
      const int t = dir ? (t0 + 127 - tau) : (t0 + tau); \
      const int tp = dir ? t + 1 : t - 1; \
      const bool pv = tp >= sstart && tp < send; \
      const bf16_t* cr = p.rest + (size_t)t * RESTW; \
      const bf16_t* pr = p.rest + (size_t)(pv ? tp : t) * RESTW; \
      raw[i][0] = cr[768 + cidx]; raw[i][1] = cr[1024 + cidx]; raw[i][2] = cr[1280 + cidx]; raw[i][3] = cr[1536 + dir * 128 + lane]; raw[i][4] = cr[1536 + dir * 128 + 64 + lane]; \
      raw[i][5] = pv ? pr[768 + cidx] : (bf16_t)0; raw[i][6] = pv ? pr[1024 + cidx] : (bf16_t)0; raw[i][7] = pv ? pr[1280 + cidx] : (bf16_t)0; \
      raw[i][8] = pv ? pr[1536 + dir * 128 + lane] : (bf16_t)0; raw[i][9] = pv ? pr[1536 + dir * 128 + 64 + lane] : (bf16_t)0; } }

template <bool PASS_C>
__device__ void rwkv_job(const Params& p, int layer, int job, unsigned char* smem) {
  RwkvLds& L = *(RwkvLds*)smem;
  const int tid = get_tid(), lane = tid & 63, wave = tid >> 6;
  const int hd = job & 3, cp = job >> 2, t0 = cp * 128;
  int sstart, slen; seq_of(t0, sstart, slen);
  const int send = sstart + slen;
  const int rp = tid >> 3, jg = tid & 7, row0 = rp * 2, j0 = jg * 8;
  float* ytg0 = p.pg + ((size_t)cp * 8 + hd) * 8192;
  float* ytg1 = p.pg + ((size_t)cp * 8 + 4 + hd) * 8192;
#pragma unroll 1
  for (int dir = 0; dir < 2; ++dir) {
    const int ld = layer * 2 + dir;
    float* slot = p.pg + ((size_t)cp * 8 + dir * 4 + hd) * 8192;
    __syncthreads();
    for (int i = tid; i < 4096; i += 256) {
      const int m = i >> 6, j = i & 63;
      L.wup[i] = p.w_up[((size_t)ld * 64 + m) * 256 + hd * 64 + j];
      L.aup[i] = p.a_up[((size_t)ld * 64 + m) * 256 + hd * 64 + j];
    }
    float S[2][8], Pst[2][8];
#pragma unroll
    for (int rr = 0; rr < 2; ++rr)
#pragma unroll
      for (int j = 0; j < 8; ++j) {
        if (PASS_C) { S[rr][j] = slot[4096 + (row0 + rr) * 64 + j0 + j]; Pst[rr][j] = 0.f; }
        else { S[rr][j] = 0.f; Pst[rr][j] = (row0 + rr == j0 + j) ? 1.f : 0.f; }
      }
    const int cidx = hd * 64 + lane;
    const float mu_r = p.mu_rkv[ld * 768 + cidx], mu_k = p.mu_rkv[ld * 768 + 256 + cidx], mu_v = p.mu_rkv[ld * 768 + 512 + cidx];
    const float mu_w = p.mu_lat[ld * 128 + lane], mu_a = p.mu_lat[ld * 128 + 64 + lane];
    const float w0v = p.w0[ld * 256 + cidx], a0v = p.a0[ld * 256 + cidx];
    const float kkv = p.k_k[ld * 256 + cidx], kav = p.k_a[ld * 256 + cidx], rkv_ = p.r_k[ld * 256 + cidx];
    bf16_t raw[4][10];
    RAW_LOAD(0)
#pragma unroll 1
    for (int sb = 0; sb < 128 / SBT; ++sb) {
      __syncthreads();
#pragma unroll
      for (int i = 0; i < 4; ++i) {
        const int tk = wave * 4 + i;
        const float cr_r = bf2f(raw[i][0]), cr_k = bf2f(raw[i][1]), cr_v = bf2f(raw[i][2]), cr_w = bf2f(raw[i][3]), cr_a = bf2f(raw[i][4]);
        const float pr_r = bf2f(raw[i][5]), pr_k = bf2f(raw[i][6]), pr_v = bf2f(raw[i][7]), pr_w = bf2f(raw[i][8]), pr_a = bf2f(raw[i][9]);
        L.R[tk * 64 + lane] = cr_r + (pr_r - cr_r) * mu_r;
        L.K[tk * 64 + lane] = cr_k + (pr_k - cr_k) * mu_k;
        L.V[tk * 64 + lane] = cr_v + (pr_v - cr_v) * mu_v;
        { const float xw = cr_w + (pr_w - cr_w) * mu_w; L.tw[tk * 64 + lane] = 1.f - 2.f * __builtin_amdgcn_rcpf(1.f + __expf(2.f * xw)); }
        L.ta[tk * 64 + lane] = cr_a + (pr_a - cr_a) * mu_a;
      }
      if (sb + 1 < 128 / SBT) RAW_LOAD(sb + 1)
      __syncthreads();
      float accw[4], acca[4];
#pragma unroll
      for (int i = 0; i < 4; ++i) { accw[i] = 0.f; acca[i] = 0.f; }
#pragma unroll 4
      for (int m4 = 0; m4 < 16; ++m4) {
        float wu[4], au[4];
#pragma unroll
        for (int e = 0; e < 4; ++e) { wu[e] = L.wup[(m4 * 4 + e) * 64 + lane]; au[e] = L.aup[(m4 * 4 + e) * 64 + lane]; }
#pragma unroll
        for (int i = 0; i < 4; ++i) {
          const float4 tw4 = *(const float4*)(L.tw + (wave * 4 + i) * 64 + m4 * 4);
          const float4 ta4 = *(const float4*)(L.ta + (wave * 4 + i) * 64 + m4 * 4);
          accw[i] += tw4.x * wu[0] + tw4.y * wu[1] + tw4.z * wu[2] + tw4.w * wu[3];
          acca[i] += ta4.x * au[0] + ta4.y * au[1] + ta4.z * au[2] + ta4.w * au[3];
        }
      }
#pragma unroll
      for (int i = 0; i < 4; ++i) {
        const int tk = wave * 4 + i;
        const float wpre = w0v + accw[i];
        const float nx = -wpre;
        const float sp = fmaxf(nx, 0.f) + __logf(1.f + __expf(-fabsf(nx)));
        const float wlog = -sp - 0.5f;
        const float decay = __expf(-__expf(wlog));
        const float a = sigmoidf_(a0v + acca[i]);
        const float k = L.K[tk * 64 + lane], r = L.R[tk * 64 + lane], v = L.V[tk * 64 + lane];
        float kk = k * kkv;
        const float ss = wave_sum(kk * kk);
        kk *= rsqrtf(ss + 1e-12f);
        const float k2 = k * (1.f + (a - 1.f) * kav);
        L.W[tk * 64 + lane] = decay; L.K[tk * 64 + lane] = k2; L.KK[tk * 64 + lane] = kk; L.B[tk * 64 + lane] = kk * a;
        if (PASS_C) { const float bs = wave_sum(r * k2 * rkv_); L.bon[tk * 64 + lane] = bs * v; }
      }
      __syncthreads();
      ScanOps cur = load_ops<PASS_C>(L, 0, j0, row0);
#pragma unroll 4
      for (int tk = 0; tk < SBT; ++tk) {
        const ScanOps nx = load_ops<PASS_C>(L, (tk + 1) & (SBT - 1), j0, row0);
        float w[8], b[8], kkr[8], k[8];
#pragma unroll
        for (int j = 0; j < 4; ++j) { w[j] = cur.w0[j]; w[j + 4] = cur.w1[j]; b[j] = cur.b0[j]; b[j + 4] = cur.b1[j]; kkr[j] = cur.kk0[j]; kkr[j + 4] = cur.kk1[j]; k[j] = cur.k0[j]; k[j + 4] = cur.k1[j]; }
        const float vr[2] = {cur.v.x, cur.v.y};
        float sa[2], sp[2] = {0.f, 0.f};
#pragma unroll
        for (int rr = 0; rr < 2; ++rr) {
          float a0 = S[rr][0] * kkr[0], a1 = S[rr][1] * kkr[1];
#pragma unroll
          for (int j = 2; j < 8; j += 2) { a0 += S[rr][j] * kkr[j]; a1 += S[rr][j + 1] * kkr[j + 1]; }
          sa[rr] = a0 + a1;
          if (!PASS_C) {
            float p0 = Pst[rr][0] * kkr[0], p1 = Pst[rr][1] * kkr[1];
#pragma unroll
            for (int j = 2; j < 8; j += 2) { p0 += Pst[rr][j] * kkr[j]; p1 += Pst[rr][j + 1] * kkr[j + 1]; }
            sp[rr] = p0 + p1;
          }
        }
        sa[0] = red8(sa[0]); sa[1] = red8(sa[1]);
        if (!PASS_C) { sp[0] = red8(sp[0]); sp[1] = red8(sp[1]); }
#pragma unroll
        for (int rr = 0; rr < 2; ++rr)
#pragma unroll
          for (int j = 0; j < 8; ++j) {
            S[rr][j] = S[rr][j] * w[j] + (vr[rr] * k[j] - sa[rr] * b[j]);
            if (!PASS_C) Pst[rr][j] = Pst[rr][j] * w[j] - sp[rr] * b[j];
          }
        if (PASS_C) {
          float o0 = 0.f, o1 = 0.f;
#pragma unroll
          for (int j = 0; j < 4; ++j) { o0 += S[0][j] * cur.r0[j] + S[0][j + 4] * cur.r1[j]; o1 += S[1][j] * cur.r0[j] + S[1][j + 4] * cur.r1[j]; }
          o0 = red8(o0); o1 = red8(o1);
          if (jg == 0) { L.ot[tk * 64 + row0] = o0; L.ot[tk * 64 + row0 + 1] = o1; }
        }
        cur = nx;
      }
      if (PASS_C) {
        __syncthreads();
        const int x = tid >> 4, part = tid & 15;
        const int tk = dir ? (SBT - 1 - x) : x, tau = sb * SBT + tk;
        const int tl = dir ? (127 - tau) : tau;
        const f32x4 ov = *(const f32x4*)(L.ot + tk * 64 + part * 4);
        float o[4] = {ov[0], ov[1], ov[2], ov[3]};
        float s1 = red16(o[0] + o[1] + o[2] + o[3]);
        const float mu = s1 * (1.f / 64.f);
        float s2 = 0.f;
#pragma unroll
        for (int e = 0; e < 4; ++e) { o[e] -= mu; s2 += o[e] * o[e]; }
        s2 = red16(s2);
        const float rs = rsqrtf(s2 * (1.f / 64.f) + 64e-5f);
        const int ch = hd * 64 + part * 4;
        const f32x4 lg = *(const f32x4*)(p.ln_g + layer * 256 + ch), lb = *(const f32x4*)(p.ln_b + layer * 256 + ch);
        const f32x4 bo = *(const f32x4*)(L.bon + tk * 64 + part * 4);
        f32x4 y;
#pragma unroll
        for (int e = 0; e < 4; ++e) y[e] = o[e] * rs * lg[e] + lb[e] + bo[e];
        float* yg = (tl < 64 ? ytg0 + tl * 64 : ytg1 + (tl - 64) * 64) + part * 4;
        if (dir == 0) *(f32x4*)yg = y;
        else {
          const f32x4 y0 = *(const f32x4*)yg;
          bf16_t* yp = p.ys + (size_t)(t0 + tl) * 1024 + 768 + ch;
          const uint2 yv = *(const uint2*)yp;
          uint2 ov2;
          ov2.x = pack2(__uint_as_float(yv.x << 16) * (y[0] + y0[0]), __uint_as_float(yv.x & 0xffff0000u) * (y[1] + y0[1]));
          ov2.y = pack2(__uint_as_float(yv.y << 16) * (y[2] + y0[2]), __uint_as_float(yv.y & 0xffff0000u) * (y[3] + y0[3]));
          if (!DRY(p)) *(uint2*)yp = ov2;
        }
      }
    }
    if (!PASS_C) {
#pragma unroll
      for (int rr = 0; rr < 2; ++rr)
#pragma unroll
        for (int j = 0; j < 8; ++j) { slot[(row0 + rr) * 64 + j0 + j] = Pst[rr][j]; slot[4096 + (row0 + rr) * 64 + j0 + j] = S[rr][j]; }
    }
  }
  __syncthreads();
}

__device__ void rwkv_passB(const Params& p, unsigned char* smem) {
  float* Pl = (float*)smem;
  float* Sl = Pl + 4096;
  const int tid = get_tid();
  for (int wk = blockIdx.x; wk < 128; wk += gridDim.x) {
    const int rg = wk & 3, hd = (wk >> 2) & 3, dir = (wk >> 4) & 1, seq = wk >> 5;
    const int cbase = seq == 0 ? 0 : seq == 1 ? 64 : seq == 2 ? 128 : 256;
    const int nch = seq < 2 ? 64 : 128;
    const int row = tid >> 4, jq = tid & 15;
    __syncthreads();
    for (int i = tid; i < 16 * 64; i += 256) Sl[i] = 0.f;
    __syncthreads();
    float4 pf0, pf1, pf2, pf3, gf;
    {
      const int c = dir ? nch - 1 : 0;
      const float* slot = p.pg + ((size_t)(cbase + c) * 8 + dir * 4 + hd) * 8192;
      pf0 = ((const float4*)slot)[tid]; pf1 = ((const float4*)slot)[tid + 256]; pf2 = ((const float4*)slot)[tid + 512]; pf3 = ((const float4*)slot)[tid + 768];
      gf = *(const float4*)(slot + 4096 + (rg * 16 + row) * 64 + jq * 4);
    }
#pragma unroll 1
    for (int ci = 0; ci < nch; ++ci) {
      const int c = dir ? nch - 1 - ci : ci;
      float* slot = p.pg + ((size_t)(cbase + c) * 8 + dir * 4 + hd) * 8192;
      ((float4*)Pl)[tid] = pf0; ((float4*)Pl)[tid + 256] = pf1; ((float4*)Pl)[tid + 512] = pf2; ((float4*)Pl)[tid + 768] = pf3;
      float* gp = slot + 4096 + (rg * 16 + row) * 64 + jq * 4;
      float4 acc = gf;
      if (ci + 1 < nch) {
        const int c2 = dir ? nch - 2 - ci : ci + 1;
        const float* s2 = p.pg + ((size_t)(cbase + c2) * 8 + dir * 4 + hd) * 8192;
        pf0 = ((const float4*)s2)[tid]; pf1 = ((const float4*)s2)[tid + 256]; pf2 = ((const float4*)s2)[tid + 512]; pf3 = ((const float4*)s2)[tid + 768];
        gf = *(const float4*)(s2 + 4096 + (rg * 16 + row) * 64 + jq * 4);
      }
      __syncthreads();
      float4 sold = *(const float4*)(Sl + row * 64 + jq * 4);
#pragma unroll 4
      for (int m4 = 0; m4 < 16; ++m4) {
        const float4 s4 = *(const float4*)(Sl + row * 64 + m4 * 4);
        const float sv[4] = {s4.x, s4.y, s4.z, s4.w};
#pragma unroll
        for (int e = 0; e < 4; ++e) {
          const float4 pv = *(const float4*)(Pl + (m4 * 4 + e) * 64 + jq * 4);
          acc.x += sv[e] * pv.x; acc.y += sv[e] * pv.y; acc.z += sv[e] * pv.z; acc.w += sv[e] * pv.w;
        }
      }
      if (!DRY(p)) *(float4*)gp = sold;
      __syncthreads();
      *(float4*)(Sl + row * 64 + jq * 4) = acc;
      __syncthreads();
    }
  }
}

__device__ __forceinline__ void run_phase(const Params& p, int layer, int sub, unsigned char* smem) {
  switch (sub) {
    case 0: phase_prep(p, layer); break;
    case 1: phase_g1(p, layer, smem); break;
    case 2: phase_mix(p, layer, smem); break;
    case 3: for (int j = blockIdx.x; j < 1536; j += gridDim.x) rwkv_job<false>(p, layer, j, smem); attn_combine(p); break;
    case 4: rwkv_passB(p, smem); break;
    case 5: for (int j = blockIdx.x; j < 1536; j += gridDim.x) rwkv_job<true>(p, layer, j, smem); break;
    case 6: phase_branch(p, smem); break;
    case 7: phase_gate(p, layer, smem); break;
    case 8: phase_out(p, layer, smem); break;
  }
}
__global__ void __launch_bounds__(256, 2) mega(Params p) {
  extern __shared__ __attribute__((aligned(16))) unsigned char smem[];
  cg::grid_group grid = cg::this_grid();
  for (int ph = p.phase_lo; ph < p.phase_hi; ++ph) {
    const int layer = ph / NPH, sub = ph % NPH;
#if PROBE_MASK
    for (int rep = (PROBE_MASK >> sub) & 1; rep >= 0; --rep) {
      __syncthreads(); if (get_tid() == 0) s_dry = rep; __syncthreads();
      run_phase(p, layer, sub, smem);
      if (rep) grid.sync();
    }
#else
    run_phase(p, layer, sub, smem);
#endif
    if (ph + 1 < p.phase_hi) grid.sync();
  }
}

extern "C" void kernel_launch(void* const* d_in, const int* in_sizes, int n_in, void* d_out, int out_size, void* d_ws, size_t ws_size, hipStream_t stream) {
  static int grid_blocks = 0;
  if (!grid_blocks) {
    hipFuncSetAttribute((const void*)mega, hipFuncAttributeMaxDynamicSharedMemorySize, SMEM_BYTES);
    int dev = 0, cus = 0, per_cu = 0;
    hipGetDevice(&dev);
    hipDeviceGetAttribute(&cus, hipDeviceAttributeMultiprocessorCount, dev);
    hipOccupancyMaxActiveBlocksPerMultiprocessor(&per_cu, mega, 256, SMEM_BYTES);
    if (per_cu < 1) per_cu = 1;
    grid_blocks = cus * per_cu;
  }
  Params p{};
  p.xp = (const float*)d_in[0]; p.xs = (const float*)d_in[1];
  p.norm_g = (const float*)d_in[2]; p.w_in = (const float*)d_in[3]; p.q_norm_g = (const float*)d_in[4]; p.k_norm_g = (const float*)d_in[5];
  p.pool_w = (const float*)d_in[6]; p.pool_scale = (const float*)d_in[7]; p.sg_norm_g = (const float*)d_in[8]; p.sg_w = (const float*)d_in[9]; p.sg_b = (const float*)d_in[10];
  p.mu_rkv = (const float*)d_in[11]; p.mu_lat = (const float*)d_in[12]; p.w0 = (const float*)d_in[13]; p.w_up = (const float*)d_in[14]; p.a0 = (const float*)d_in[15]; p.a_up = (const float*)d_in[16];
  p.k_k = (const float*)d_in[17]; p.k_a = (const float*)d_in[18]; p.r_k = (const float*)d_in[19]; p.ln_g = (const float*)d_in[20]; p.ln_b = (const float*)d_in[21];
  p.w_branch = (const float*)d_in[22]; p.w_out = (const float*)d_in[23];
  p.out = (float*)d_out;
  unsigned char* ws = (unsigned char*)d_ws;
  size_t off = 0;
  p.qkv = (bf16_t*)(ws + off); off += (size_t)MTOK * QKVW * 2;
  p.rest = (bf16_t*)(ws + off); off += (size_t)MTOK * RESTW * 2;
  p.ys = (bf16_t*)(ws + off); off += (size_t)MTOK * 1024 * 2;
  p.w1t = (bf16_t*)(ws + off); off += (size_t)5120 * 1024 * 2;
  p.wgt = (bf16_t*)(ws + off); off += (size_t)4096 * 1024 * 2;
  p.wbrt = (bf16_t*)(ws + off); off += (size_t)4096 * 256 * 2;
  p.woutt = (bf16_t*)(ws + off); off += (size_t)1024 * 1024 * 2;
  p.rstd = (float*)(ws + off); off += (size_t)MTOK * 4;
  p.xb = (bf16_t*)(ws + off); off += (size_t)MTOK * 1024 * 2;
  p.pnum = (float*)(ws + off); off += (size_t)3 * MTOK * 256 * 4;
  p.pden = (float*)(ws + off); off += (size_t)3 * MTOK * 4 * 4;
  p.pg = (float*)p.qkv;
  p.branch = p.qkv;
  if (off > ws_size) { fprintf(stderr, "workspace too small: need %zu have %zu\n", off, ws_size); return; }
#if MULTI_LAUNCH
  for (int ph = 0; ph < 2 * NPH; ++ph) {
    p.phase_lo = ph; p.phase_hi = ph + 1;
    hipLaunchKernelGGL(mega, dim3(grid_blocks), dim3(256), SMEM_BYTES, stream, p);
  }
#else
  p.phase_lo = 0; p.phase_hi = 2 * NPH;
  void* args[] = {&p};
  hipError_t e = hipLaunchCooperativeKernel((void*)mega, dim3(grid_blocks), dim3(256), args, SMEM_BYTES, stream);
  if (e != hipSuccess) fprintf(stderr, "cooperative launch failed: %s (grid %d)\n", hipGetErrorString(e), grid_blocks);
#endif
}
```

```cpp
#include <hip/hip_runtime.h>
#include <hip/hip_cooperative_groups.h>
#include <cstdio>
namespace cg = cooperative_groups;

#ifndef PROBE_MASK
#define PROBE_MASK 0
#endif
#if PROBE_MASK
__shared__ int s_dry;
#define DRY(p) (s_dry)
#else
#define DRY(p) 0
#endif
#ifndef MULTI_LAUNCH
#define MULTI_LAUNCH 0
#endif

typedef unsigned short bf16_t;
typedef short bf16x8 __attribute__((ext_vector_type(8)));
typedef float f32x4 __attribute__((ext_vector_type(4)));
typedef __bf16 bf2v __attribute__((ext_vector_type(2)));

constexpr int MTOK = 49152;
constexpr int DM = 1024;
constexpr int PW = 9216;
constexpr int QKVW = 2304;
constexpr int RESTW = 1792;
constexpr int SMEM_BYTES = 73728;
constexpr int NPH = 9;

struct Params {
  const float* xp; const float* xs;
  const float* norm_g; const float* w_in; const float* q_norm_g; const float* k_norm_g;
  const float* pool_w; const float* pool_scale; const float* sg_norm_g; const float* sg_w; const float* sg_b;
  const float* mu_rkv; const float* mu_lat; const float* w0; const float* w_up; const float* a0; const float* a_up;
  const float* k_k; const float* k_a; const float* r_k; const float* ln_g; const float* ln_b;
  const float* w_branch; const float* w_out;
  float* out;
  bf16_t* qkv; bf16_t* rest; bf16_t* ys;
  bf16_t* w1t; bf16_t* wgt; bf16_t* wbrt; bf16_t* woutt;
  float* rstd; float* pg; bf16_t* branch; bf16_t* xb; float* pnum; float* pden;
  int phase_lo, phase_hi;
  int dry, pad_;
};

__device__ __forceinline__ int get_tid() { int t = threadIdx.x; asm volatile("" : "+v"(t)); return t; }
__device__ __forceinline__ float bf2f(bf16_t v) { return __uint_as_float(((unsigned)v) << 16); }
__device__ __forceinline__ bf16_t f2bf(float f) { unsigned u = __float_as_uint(f); u += 0x7fffu + ((u >> 16) & 1u); return (bf16_t)(u >> 16); }
__device__ __forceinline__ unsigned pack2(float a, float b) { return (unsigned)f2bf(a) | ((unsigned)f2bf(b) << 16); }
__device__ __forceinline__ float sigmoidf_(float x) { return __builtin_amdgcn_rcpf(1.f + __expf(-x)); }
__device__ __forceinline__ float dpp_qx1(float v) { return __int_as_float(__builtin_amdgcn_update_dpp(0, __float_as_int(v), 0xB1, 0xF, 0xF, true)); }
__device__ __forceinline__ float dpp_qx2(float v) { return __int_as_float(__builtin_amdgcn_update_dpp(0, __float_as_int(v), 0x4E, 0xF, 0xF, true)); }
__device__ __forceinline__ float dpp_hm(float v) { return __int_as_float(__builtin_amdgcn_update_dpp(0, __float_as_int(v), 0x141, 0xF, 0xF, true)); }
__device__ __forceinline__ float wave_sum(float v) {
  v += __int_as_float(__builtin_amdgcn_update_dpp(0, __float_as_int(v), 0xB1, 0xF, 0xF, true));
  v += __int_as_float(__builtin_amdgcn_update_dpp(0, __float_as_int(v), 0x4E, 0xF, 0xF, true));
  v += __int_as_float(__builtin_amdgcn_update_dpp(0, __float_as_int(v), 0x141, 0xF, 0xF, true));
  v += __int_as_float(__builtin_amdgcn_update_dpp(0, __float_as_int(v), 0x140, 0xF, 0xF, true));
  v += __shfl_xor(v, 16); v += __shfl_xor(v, 32);
  return v;
}
__device__ __forceinline__ const float* xrow_ptr(const Params& p, int layer, int row) {
  if (layer == 0) return row < 16384 ? p.xp + (size_t)row * DM : p.xs + (size_t)(row - 16384) * DM;
  return p.out + (size_t)row * DM;
}
__device__ __forceinline__ void seq_of(int T0, int& sstart, int& slen) {
  if (T0 < 16384) { sstart = T0 & ~8191; slen = 8192; } else { sstart = 16384 + ((T0 - 16384) & ~16383); slen = 16384; }
}

__device__ void phase_prep(const Params& p, int layer) {
  const int tid = get_tid(), lane = tid & 63;
  const int gw = (blockIdx.x * 256 + tid) >> 6, nw = gridDim.x * 4;
  for (int row = gw; row < MTOK; row += nw) {
    const float4* x = (const float4*)xrow_ptr(p, layer, row);
    float ss = 0.f;
#pragma unroll
    for (int i = 0; i < 4; ++i) { float4 v = x[lane + i * 64]; ss += v.x * v.x + v.y * v.y + v.z * v.z + v.w * v.w; }
    ss = wave_sum(ss);
    const float rs = rsqrtf(ss * (1.f / 1024.f) + 1e-6f);
#pragma unroll
    for (int i = 0; i < 4; ++i) { float4 v = x[lane + i * 64]; uint2 o; o.x = pack2(v.x * rs, v.y * rs); o.y = pack2(v.z * rs, v.w * rs); *(uint2*)(p.xb + (size_t)row * 1024 + (lane + i * 64) * 4) = o; }
  }
  const float* w_in = p.w_in + (size_t)layer * DM * PW;
  const float* ng = p.norm_g + layer * DM;
  const long gt = (long)blockIdx.x * 256 + tid, nthr = (long)gridDim.x * 256;
  for (long idx = gt; idx < 5120L * 128; idx += nthr) {
    int n = (int)(idx % 5120), kc = (int)(idx / 5120);
    int col;
    if (n < 2304) col = n; else if (n < 2560) col = 2560 + (n - 2304); else if (n < 3072) col = 3072 + (n - 2560);
    else if (n < 3840) col = 3840 + (n - 3072); else if (n < 4096) col = 4608 + (n - 3840);
    else if (n < 4352) col = 2304 + (n - 4096); else if (n < 4608) col = 2816 + (n - 4352);
    else if (n < 4864) col = 3584 + (n - 4608); else col = 4864 + (n - 4864);
    float v[8];
#pragma unroll
    for (int j = 0; j < 8; ++j) { int k = kc * 8 + j; v[j] = ng[k] * w_in[(size_t)k * PW + col]; }
    uint4 o; o.x = pack2(v[0], v[1]); o.y = pack2(v[2], v[3]); o.z = pack2(v[4], v[5]); o.w = pack2(v[6], v[7]);
    *(uint4*)(p.w1t + (size_t)n * 1024 + kc * 8) = o;
  }
  for (long idx = gt; idx < 4096L * 128; idx += nthr) {
    int n = (int)(idx % 4096), kc = (int)(idx / 4096);
    int tn = n >> 8, c = n & 255, wn = c >> 7, nn = (c >> 4) & 7, dl = c & 15, dg = nn >> 2, b = nn & 3;
    int col = 5120 + b * 1024 + tn * 64 + wn * 32 + dg * 16 + dl;
    float v[8];
#pragma unroll
    for (int j = 0; j < 8; ++j) { int k = kc * 8 + j; v[j] = ng[k] * w_in[(size_t)k * PW + col]; }
    uint4 o; o.x = pack2(v[0], v[1]); o.y = pack2(v[2], v[3]); o.z = pack2(v[4], v[5]); o.w = pack2(v[6], v[7]);
    *(uint4*)(p.wgt + (size_t)n * 1024 + kc * 8) = o;
  }
  const float* wb = p.w_branch + (size_t)layer * 4 * 256 * 1024;
  for (long idx = gt; idx < 4096L * 32; idx += nthr) {
    int n = (int)(idx % 4096), kc = (int)(idx / 4096);
    int b = n >> 10, d = n & 1023;
    float v[8];
#pragma unroll
    for (int j = 0; j < 8; ++j) { int k = kc * 8 + j; v[j] = wb[((size_t)b * 256 + k) * 1024 + d]; }
    uint4 o; o.x = pack2(v[0], v[1]); o.y = pack2(v[2], v[3]); o.z = pack2(v[4], v[5]); o.w = pack2(v[6], v[7]);
    *(uint4*)(p.wbrt + (size_t)n * 256 + kc * 8) = o;
  }
  const float* wo = p.w_out + (size_t)layer * 1024 * 1024;
  for (long idx = gt; idx < 1024L * 128; idx += nthr) {
    int n = (int)(idx % 1024), kc = (int)(idx / 1024);
    float v[8];
#pragma unroll
    for (int j = 0; j < 8; ++j) { int k = kc * 8 + j; v[j] = wo[(size_t)k * 1024 + n]; }
    uint4 o; o.x = pack2(v[0], v[1]); o.y = pack2(v[2], v[3]); o.z = pack2(v[4], v[5]); o.w = pack2(v[6], v[7]);
    *(uint4*)(p.woutt + (size_t)n * 1024 + kc * 8) = o;
  }
}

__device__ __forceinline__ int lds_off(int r, int c) { return r * 128 + ((c ^ ((r >> 1) & 7)) << 4); }

#define GA_LOAD1(i, RA) RA = *(const f32x4*)(Ab + (size_t)(tt * 64) + (voffA + (unsigned)((i) * 64) * lda2));
#define GB_LOAD1(i, RB) RB = *(const f32x4*)(Bb + (size_t)(tt * 64) + (voffB + (unsigned)((i) * 64) * ldb2));
#define LA_WRITE1(i, RA) *(f32x4*)(sa_ + wbase + (i) * 4096) = RA;
#define LB_WRITE1(i, RB) *(f32x4*)(sa_ + 8192 + wbase + (i) * 4096) = RB;
#define G_LOAD_A(T) { const int tt = (T); GA_LOAD1(0, ra0) GA_LOAD1(1, ra1) GB_LOAD1(0, rb0) GB_LOAD1(1, rb1) GB_LOAD1(2, rb2) GB_LOAD1(3, rb3) }
#define L_WRITE_A(P) { unsigned char* sa_ = (P); LA_WRITE1(0, ra0) LA_WRITE1(1, ra1) LB_WRITE1(0, rb0) LB_WRITE1(1, rb1) LB_WRITE1(2, rb2) LB_WRITE1(3, rb3) }
#define G_LOAD_B(T) { const int tt = (T); GA_LOAD1(0, sa0) GA_LOAD1(1, sa1) GB_LOAD1(0, sb0) GB_LOAD1(1, sb1) GB_LOAD1(2, sb2) GB_LOAD1(3, sb3) }
#define L_WRITE_B(P) { unsigned char* sa_ = (P); LA_WRITE1(0, sa0) LA_WRITE1(1, sa1) LB_WRITE1(0, sb0) LB_WRITE1(1, sb1) LB_WRITE1(2, sb2) LB_WRITE1(3, sb3) }
constexpr int GSTAGE = 24576;

__device__ __forceinline__ int lds_off32(int r, int c) { return r * 64 + ((c ^ (((r >> 3) & 1) * 3)) << 4); }

__device__ __forceinline__ void gemm_compute(f32x4 (&acc)[4][8], const unsigned char* a_, int aoff, int boff) {
  const unsigned char* b_ = a_ + 8192;
  bf16x8 af[4], bfr[8];
#pragma unroll
  for (int m = 0; m < 4; ++m) af[m] = *(const bf16x8*)(a_ + aoff + m * 1024);
#pragma unroll
  for (int n = 0; n < 8; ++n) bfr[n] = *(const bf16x8*)(b_ + boff + n * 1024);
#pragma unroll
  for (int m = 0; m < 4; ++m)
#pragma unroll
    for (int n = 0; n < 8; ++n) acc[m][n] = __builtin_amdgcn_mfma_f32_16x16x32_bf16(bfr[n], af[m], acc[m][n], 0, 0, 0);
}

__device__ __forceinline__ void gemm_core(f32x4 (&acc)[4][8], const bf16_t* Aptr, int lda, const bf16_t* Bt, int ldb, int K, unsigned char* smem) {
  const int tid = get_tid(), lane = tid & 63, wave = tid >> 6, wm = wave >> 1, wn = wave & 1;
  const int dl = lane & 15, gq = lane >> 4, swz = ((dl >> 3) & 1) * 3;
  const int aoff = (wm * 64 + dl) * 64 + ((gq ^ swz) << 4);
  const int boff = (wn * 128 + dl) * 64 + ((gq ^ swz) << 4);
  const int r0 = tid >> 2, c0 = tid & 3;
  const int wbase = lds_off32(r0, c0);
  const unsigned lda2 = (unsigned)lda * 2u, ldb2 = (unsigned)ldb * 2u;
  const unsigned voffA = (unsigned)r0 * lda2 + c0 * 16, voffB = (unsigned)r0 * ldb2 + c0 * 16;
  const unsigned char* Ab = (const unsigned char*)Aptr; const unsigned char* Bb = (const unsigned char*)Bt;
  f32x4 ra0, ra1, rb0, rb1, rb2, rb3;
  f32x4 sa0, sa1, sb0, sb1, sb2, sb3;
  const int nt = K >> 5;
  G_LOAD_A(0) G_LOAD_B(1) L_WRITE_A(smem) __syncthreads();
#pragma unroll 1
  for (int t = 0; t < nt; t += 2) {
    if (t + 2 < nt) G_LOAD_A(t + 2)
    gemm_compute(acc, smem, aoff, boff);
    L_WRITE_B(smem + GSTAGE)
    __syncthreads();
    if (t + 3 < nt) G_LOAD_B(t + 3)
    gemm_compute(acc, smem + GSTAGE, aoff, boff);
    if (t + 2 < nt) L_WRITE_A(smem)
    __syncthreads();
  }
}

__device__ __forceinline__ void zero_acc(f32x4 (&acc)[4][8]) {
#pragma unroll
  for (int m = 0; m < 4; ++m)
#pragma unroll
    for (int n = 0; n < 8; ++n) acc[m][n] = (f32x4){0.f, 0.f, 0.f, 0.f};
}

__device__ __forceinline__ bool tile_of(int it, int ntn, int& tm, int& tn) {
  if (gridDim.x == 256 || gridDim.x == 512) {
    const int xcd = blockIdx.x & 7, s = blockIdx.x >> 3;
    const int gmh = gridDim.x == 512 ? 16 : 8;
    const int gn_cnt = ntn >> 2, g = it * 8 + xcd;
    if (g >= (384 / gmh) * gn_cnt) return false;
    const int gm = g / gn_cnt, gn = g % gn_cnt;
    tm = gm * gmh + (s & (gmh - 1)); tn = gn * 4 + s / gmh;
    return true;
  }
  const int tile = blockIdx.x + it * gridDim.x;
  if (tile >= 384 * ntn) return false;
  tm = tile / ntn; tn = tile % ntn; return true;
}

__device__ void phase_g1(const Params& p, int layer, unsigned char* smem) {
  const int lane = get_tid() & 63, wave = get_tid() >> 6, wm = wave >> 1, wn = wave & 1;
  int tm, tn;
  for (int it = 0; tile_of(it, 20, tm, tn); ++it) {
    const int row0 = tm * 128, col0 = tn * 256;
    f32x4 acc[4][8]; zero_acc(acc);
    gemm_core(acc, p.xb + (size_t)row0 * 1024, 1024, p.w1t + (size_t)col0 * 1024, 1024, 1024, smem);
#pragma unroll
    for (int m = 0; m < 4; ++m) {
      const int row = row0 + wm * 64 + m * 16 + (lane & 15);
#pragma unroll
      for (int n = 0; n < 8; ++n) {
        const int col = col0 + wn * 128 + n * 16 + (lane >> 4) * 4;
        float v0 = acc[m][n][0], v1 = acc[m][n][1], v2 = acc[m][n][2], v3 = acc[m][n][3];
        bf16_t* dst;
        if (col < QKVW) dst = p.qkv + (size_t)row * QKVW + col;
        else if (col < 4096) dst = p.rest + (size_t)row * RESTW + (col - QKVW);
        else { dst = p.ys + (size_t)row * 1024 + (col - 4096); v0 *= sigmoidf_(v0); v1 *= sigmoidf_(v1); v2 *= sigmoidf_(v2); v3 *= sigmoidf_(v3); }
        uint2 o; o.x = pack2(v0, v1); o.y = pack2(v2, v3);
        *(uint2*)dst = o;
      }
      asm volatile("" ::: "memory");
    }
  }
}

__device__ void phase_branch(const Params& p, unsigned char* smem) {
  const int lane = get_tid() & 63, wave = get_tid() >> 6, wm = wave >> 1, wn = wave & 1;
  int tm, tn;
  for (int it = 0; tile_of(it, 16, tm, tn); ++it) {
    const int row0 = tm * 128, col0 = tn * 256, b = tn >> 2;
    f32x4 acc[4][8]; zero_acc(acc);
    gemm_core(acc, p.ys + (size_t)row0 * 1024 + b * 256, 1024, p.wbrt + (size_t)col0 * 256, 256, 256, smem);
#pragma unroll
    for (int m = 0; m < 4; ++m) {
      const int row = row0 + wm * 64 + m * 16 + (lane & 15);
#pragma unroll
      for (int n = 0; n < 8; ++n) {
        const int col = col0 + wn * 128 + n * 16 + (lane >> 4) * 4;
        uint2 o; o.x = pack2(acc[m][n][0], acc[m][n][1]); o.y = pack2(acc[m][n][2], acc[m][n][3]);
        *(uint2*)(p.branch + (size_t)row * 4096 + col) = o;
      }
    }
  }
}

__device__ void phase_gate(const Params& p, int layer, unsigned char* smem) {
  const int lane = get_tid() & 63, wave = get_tid() >> 6, wm = wave >> 1, wn = wave & 1;
  int tm, tn;
  for (int it = 0; tile_of(it, 16, tm, tn); ++it) {
    const int row0 = tm * 128;
    f32x4 acc[4][8]; zero_acc(acc);
    gemm_core(acc, p.xb + (size_t)row0 * 1024, 1024, p.wgt + (size_t)tn * 256 * 1024, 1024, 1024, smem);
#pragma unroll
    for (int m = 0; m < 4; ++m) {
      const int row = row0 + wm * 64 + m * 16 + (lane & 15);
#pragma unroll
      for (int dg = 0; dg < 2; ++dg) {
        const int d = tn * 64 + wn * 32 + dg * 16 + (lane >> 4) * 4;
        float s0 = 0.f, s1 = 0.f, s2 = 0.f, s3 = 0.f;
#pragma unroll
        for (int b = 0; b < 4; ++b) {
          uint2 br = *(const uint2*)(p.branch + (size_t)row * 4096 + b * 1024 + d);
          s0 += sigmoidf_(acc[m][dg * 4 + b][0]) * __uint_as_float(br.x << 16);
          s1 += sigmoidf_(acc[m][dg * 4 + b][1]) * __uint_as_float(br.x & 0xffff0000u);
          s2 += sigmoidf_(acc[m][dg * 4 + b][2]) * __uint_as_float(br.y << 16);
          s3 += sigmoidf_(acc[m][dg * 4 + b][3]) * __uint_as_float(br.y & 0xffff0000u);
        }
        uint2 o; o.x = pack2(s0, s1); o.y = pack2(s2, s3);
        *(uint2*)(p.ys + (size_t)row * 1024 + d) = o;
        asm volatile("" ::: "memory");
      }
    }
  }
}

__device__ void phase_out(const Params& p, int layer, unsigned char* smem) {
  const int lane = get_tid() & 63, wave = get_tid() >> 6, wm = wave >> 1, wn = wave & 1;
  int tm, tn;
  for (int it = 0; tile_of(it, 4, tm, tn); ++it) {
    const int row0 = tm * 128, col0 = tn * 256;
    f32x4 acc[4][8]; zero_acc(acc);
    gemm_core(acc, p.ys + (size_t)row0 * 1024, 1024, p.woutt + (size_t)col0 * 1024, 1024, 1024, smem);
#pragma unroll
    for (int m = 0; m < 4; ++m) {
      const int row = row0 + wm * 64 + m * 16 + (lane & 15);
      const float* xr = xrow_ptr(p, layer, row);
#pragma unroll
      for (int n = 0; n < 8; ++n) {
        const int col = col0 + wn * 128 + n * 16 + (lane >> 4) * 4;
        float4 xv = *(const float4*)(xr + col);
        float4 o; o.x = xv.x + acc[m][n][0]; o.y = xv.y + acc[m][n][1]; o.z = xv.z + acc[m][n][2]; o.w = xv.w + acc[m][n][3];
        if (!DRY(p)) *(float4*)(p.out + (size_t)row * 1024 + col) = o;
      }
    }
  }
}

constexpr int QS_STRIDE = 144, KS_STRIDE = 144, VT_STRIDE = 432;
__device__ void attn_item(const Params& p, int layer, int item, unsigned char* smem) {
  const int tid = get_tid(), lane = tid & 63, w = tid >> 6;
  const int n = item % 12, run = item / 12, T0 = run * 64;
  const int g = n >> 2, h = n & 3, d = g == 0 ? 1 : (g == 1 ? 4 : 16);
  int sstart, slen; seq_of(T0, sstart, slen);
  const int rho = (T0 - sstart) >> 6;
  const int r = rho % d, i0 = (rho / d) * 64;
  unsigned char* Qs = smem;
  unsigned char* Ks = smem + 64 * QS_STRIDE;
  unsigned char* Vt = Ks + 208 * KS_STRIDE;
  const float* kg = p.k_norm_g + layer * 64;
  const float* qg = p.q_norm_g + layer * 64;
  const int part = tid & 3;
  {
    const int q = tid >> 2;
    const int pq = d * (i0 + q) + r;
    const bf16_t* base = p.qkv + (size_t)(sstart + pq) * QKVW + n * 64 + part * 16;
    const uint4 a0 = *(const uint4*)base, a1 = *(const uint4*)(base + 8);
    const unsigned ww[8] = {a0.x, a0.y, a0.z, a0.w, a1.x, a1.y, a1.z, a1.w};
    float f[16]; float ss = 0.f;
#pragma unroll
    for (int j = 0; j < 8; ++j) { f[2 * j] = __uint_as_float(ww[j] << 16); f[2 * j + 1] = __uint_as_float(ww[j] & 0xffff0000u); ss += f[2 * j] * f[2 * j] + f[2 * j + 1] * f[2 * j + 1]; }
    ss += dpp_qx1(ss); ss += dpp_qx2(ss);
    const float rs = rsqrtf(ss * (1.f / 64.f) + 1e-6f) * 0.125f;
    unsigned* qd = (unsigned*)(Qs + q * QS_STRIDE + part * 32);
#pragma unroll
    for (int j = 0; j < 8; ++j) qd[j] = pack2(f[2 * j] * rs * qg[part * 16 + 2 * j], f[2 * j + 1] * rs * qg[part * 16 + 2 * j + 1]);
  }
#pragma unroll
  for (int it = 0; it < 4; ++it) {
    const int rr = (tid >> 2) + it * 64;
    const int pos = d * (i0 - 64 + rr) + r;
    const bool ok = rr < 192 && pos >= 0 && pos < slen;
    uint4 k0 = {0, 0, 0, 0}, k1 = {0, 0, 0, 0}, v0 = {0, 0, 0, 0}, v1 = {0, 0, 0, 0};
    if (ok) {
      const bf16_t* base = p.qkv + (size_t)(sstart + pos) * QKVW + n * 64 + part * 16;
      k0 = *(const uint4*)(base + 768); k1 = *(const uint4*)(base + 768 + 8);
      v0 = *(const uint4*)(base + 1536); v1 = *(const uint4*)(base + 1536 + 8);
    }
    const unsigned kw[8] = {k0.x, k0.y, k0.z, k0.w, k1.x, k1.y, k1.z, k1.w};
    float kf[16]; float ss = 0.f;
#pragma unroll
    for (int j = 0; j < 8; ++j) { kf[2 * j] = __uint_as_float(kw[j] << 16); kf[2 * j + 1] = __uint_as_float(kw[j] & 0xffff0000u); ss += kf[2 * j] * kf[2 * j] + kf[2 * j + 1] * kf[2 * j + 1]; }
    ss += dpp_qx1(ss); ss += dpp_qx2(ss);
    const float rs = rsqrtf(ss * (1.f / 64.f) + 1e-6f);
    if (rr < 208) {
      unsigned* kd = (unsigned*)(Ks + rr * KS_STRIDE + part * 32);
#pragma unroll
      for (int j = 0; j < 8; ++j) kd[j] = pack2(kf[2 * j] * rs * kg[part * 16 + 2 * j], kf[2 * j + 1] * rs * kg[part * 16 + 2 * j + 1]);
      const unsigned vw[8] = {v0.x, v0.y, v0.z, v0.w, v1.x, v1.y, v1.z, v1.w};
#pragma unroll
      for (int j = 0; j < 8; ++j) {
        *(bf16_t*)(Vt + (part * 16 + 2 * j) * VT_STRIDE + rr * 2) = (bf16_t)(vw[j] & 0xffffu);
        *(bf16_t*)(Vt + (part * 16 + 2 * j + 1) * VT_STRIDE + rr * 2) = (bf16_t)(vw[j] >> 16);
      }
    }
  }
  __syncthreads();
  const int dl = lane & 15, gq = lane >> 4;
  bf16x8 qf0 = *(const bf16x8*)(Qs + (16 * w + dl) * QS_STRIDE + gq * 16);
  bf16x8 qf1 = *(const bf16x8*)(Qs + (16 * w + dl) * QS_STRIDE + 64 + gq * 16);
  const float slope = exp2f(-8.f * (float)(n + 1) / 12.f) * (float)d;
  float pv[10][4];
  float dsum = 0.f;
#pragma unroll
  for (int t = 0; t < 10; ++t) {
    const unsigned char* kp = Ks + ((w + t) * 16 + dl) * KS_STRIDE + gq * 16;
    f32x4 sacc = {0.f, 0.f, 0.f, 0.f};
    sacc = __builtin_amdgcn_mfma_f32_16x16x32_bf16(*(const bf16x8*)kp, qf0, sacc, 0, 0, 0);
    sacc = __builtin_amdgcn_mfma_f32_16x16x32_bf16(*(const bf16x8*)(kp + 64), qf1, sacc, 0, 0, 0);
#pragma unroll
    for (int j = 0; j < 4; ++j) {
      const int m = 16 * t + 4 * gq + j - dl;
      const int kr = (w + t) * 16 + 4 * gq + j;
      const int pos = d * (i0 - 64 + kr) + r;
      const bool ok = m >= 0 && m <= 128 && pos >= 0 && pos < slen;
      const float e = ok ? __expf(sacc[j] - slope * fabsf((float)(m - 64))) : 0.f;
      pv[t][j] = e; dsum += e;
    }
  }
  f32x4 oacc[4];
#pragma unroll
  for (int dt = 0; dt < 4; ++dt) oacc[dt] = (f32x4){0.f, 0.f, 0.f, 0.f};
#pragma unroll
  for (int u = 0; u < 5; ++u) {
    union { bf16x8 v; unsigned uu[4]; } pb;
    pb.uu[0] = pack2(pv[2 * u][0], pv[2 * u][1]); pb.uu[1] = pack2(pv[2 * u][2], pv[2 * u][3]);
    pb.uu[2] = pack2(pv[2 * u + 1][0], pv[2 * u + 1][1]); pb.uu[3] = pack2(pv[2 * u + 1][2], pv[2 * u + 1][3]);
#pragma unroll
    for (int dt = 0; dt < 4; ++dt) {
      const unsigned char* vp = Vt + (dt * 16 + dl) * VT_STRIDE + ((w + 2 * u) * 16 + 4 * gq) * 2;
      union { bf16x8 v; uint2 h2[2]; } va;
      va.h2[0] = *(const uint2*)vp; va.h2[1] = *(const uint2*)(vp + 32);
      oacc[dt] = __builtin_amdgcn_mfma_f32_16x16x32_bf16(va.v, pb.v, oacc[dt], 0, 0, 0);
    }
  }
  dsum += __shfl_xor(dsum, 16); dsum += __shfl_xor(dsum, 32);
  {
    const int ql = 16 * w + dl;
    const size_t tok = (size_t)(sstart + d * (i0 + ql) + r);
    float* np = p.pnum + (size_t)g * ((size_t)MTOK * 256) + (tok * 4 + h) * 64 + 4 * gq;
#pragma unroll
    for (int dt = 0; dt < 4; ++dt) *(f32x4*)(np + dt * 16) = oacc[dt];
    if (gq == 0) p.pden[(size_t)g * ((size_t)MTOK * 4) + tok * 4 + h] = dsum;
  }
  __syncthreads();
}

__device__ void attn_combine(const Params& p) {
  const size_t nvec = (size_t)MTOK * 64;
  for (size_t i = (size_t)blockIdx.x * 256 + get_tid(); i < nvec; i += (size_t)gridDim.x * 256) {
    const size_t th = i >> 4;
    const int e4 = (int)(i & 15);
    const f32x4 a = *(const f32x4*)(p.pnum + i * 4), b = *(const f32x4*)(p.pnum + (size_t)MTOK * 256 + i * 4), c = *(const f32x4*)(p.pnum + 2 * (size_t)MTOK * 256 + i * 4);
    const float den = p.pden[th] + p.pden[(size_t)MTOK * 4 + th] + p.pden[2 * (size_t)MTOK * 4 + th];
    const float inv = 1.f / den;
    const size_t tok = th >> 2; const int h = (int)(th & 3);
    bf16_t* y = p.ys + tok * 1024 + h * 64 + e4 * 4;
    uint2 yv = *(const uint2*)y;
    float y0 = __uint_as_float(yv.x << 16), y1 = __uint_as_float(yv.x & 0xffff0000u), y2 = __uint_as_float(yv.y << 16), y3 = __uint_as_float(yv.y & 0xffff0000u);
    uint2 o; o.x = pack2(y0 * (a[0] + b[0] + c[0]) * inv, y1 * (a[1] + b[1] + c[1]) * inv); o.y = pack2(y2 * (a[2] + b[2] + c[2]) * inv, y3 * (a[3] + b[3] + c[3]) * inv);
    if (!DRY(p)) *(uint2*)y = o;
  }
}

__device__ void pool_item(const Params& p, int layer, int item, unsigned char* smem) {
  const int tid = get_tid();
  const int g = item & 3, T0 = (item >> 2) * 64;
  int sstart, slen; seq_of(T0, sstart, slen);
  const int P0 = T0 - sstart;
  const int hw = 1 << g;
  float* u = (float*)smem;
  float* dd = u + 80 * 64;
  float* w = dd + 64 * 65;
  for (int i = tid; i < 80 * 64; i += 256) {
    const int rr = i >> 6, c = i & 63, pos = P0 - 8 + rr;
    u[i] = (pos >= 0 && pos < slen) ? bf2f(p.rest[(size_t)(sstart + pos) * RESTW + g * 64 + c]) : 0.f;
  }
  const float* pw = p.pool_w + ((size_t)layer * 4 + g) * 4096;
  for (int i = tid; i < 4096; i += 256) w[i] = pw[i];
  __syncthreads();
  for (int i = tid; i < 64 * 64; i += 256) {
    const int t = i >> 6, c = i & 63, pos = P0 + t;
    float s = 0.f;
    for (int o = -hw; o < hw; ++o) s += u[(t + 8 + o) * 64 + c];
    const int lo = pos - hw > 0 ? pos - hw : 0, hi = pos + hw < slen ? pos + hw : slen;
    dd[t * 65 + c] = s / (float)(hi - lo) - u[(t + 8) * 64 + c];
  }
  __syncthreads();
  {
    const int t = tid >> 2, e0 = (tid & 3) * 16;
    float acc[16];
#pragma unroll
    for (int e = 0; e < 16; ++e) acc[e] = 0.f;
    for (int c = 0; c < 64; ++c) {
      const float dv = dd[t * 65 + c];
#pragma unroll
      for (int e = 0; e < 16; ++e) acc[e] += dv * w[c * 64 + e0 + e];
    }
    const float* sc = p.pool_scale + layer * 256 + g * 64 + e0;
    bf16_t* y = p.ys + (size_t)(T0 + t) * 1024 + 256 + g * 64 + e0;
#pragma unroll
    for (int e = 0; e < 16; ++e) if (!DRY(p)) y[e] = f2bf(bf2f(y[e]) * acc[e] * sc[e]);
  }
  __syncthreads();
}

__device__ void sg_item(const Params& p, int layer, int item, unsigned char* smem) {
  const int tid = get_tid(), lane = tid & 63, wave = tid >> 6;
  const int g = item & 3, T0 = (item >> 2) * 128;
  float* vn = (float*)smem;
  float* sw = vn + 128 * 64;
  for (int s_ = wave; s_ < 128; s_ += 4) {
    const bf16_t* vr = p.rest + (size_t)(T0 + s_) * RESTW + 512;
    float ss = 0.f; float mine = 0.f;
#pragma unroll
    for (int j = 0; j < 4; ++j) { float v = bf2f(vr[j * 64 + lane]); ss += v * v; if (j == g) mine = v; }
    ss = wave_sum(ss);
    const float rs = rsqrtf(ss * (1.f / 256.f) + 1e-6f);
    vn[s_ * 64 + lane] = mine * rs * p.sg_norm_g[layer * 256 + g * 64 + lane];
  }
  const float* gw = p.sg_w + ((size_t)layer * 4 + g) * 128 * 128;
#pragma unroll 1
  for (int hh = 0; hh < 2; ++hh) {
    __syncthreads();
    for (int i = tid; i < 64 * 128; i += 256) sw[(i >> 7) * 129 + (i & 127)] = gw[hh * 64 * 128 + i];
    __syncthreads();
    const int tl = tid >> 2, t = hh * 64 + tl, d0 = (tid & 3) * 16;
    float acc[16];
#pragma unroll
    for (int e = 0; e < 16; ++e) acc[e] = 0.f;
#pragma unroll 2
    for (int s_ = 0; s_ < 128; ++s_) {
      const float wv = sw[tl * 129 + s_];
      const float4* vp = (const float4*)(vn + s_ * 64 + d0);
#pragma unroll
      for (int e = 0; e < 4; ++e) { float4 v = vp[e]; acc[4 * e] += wv * v.x; acc[4 * e + 1] += wv * v.y; acc[4 * e + 2] += wv * v.z; acc[4 * e + 3] += wv * v.w; }
    }
    const float bias = p.sg_b[(layer * 4 + g) * 128 + t];
    const bf16_t* ur = p.rest + (size_t)(T0 + t) * RESTW + 256 + g * 64 + d0;
    bf16_t* y = p.ys + (size_t)(T0 + t) * 1024 + 512 + g * 64 + d0;
#pragma unroll
    for (int e = 0; e < 16; ++e) if (!DRY(p)) y[e] = f2bf(bf2f(y[e]) * bf2f(ur[e]) * (acc[e] + bias));
  }
  __syncthreads();
}

__device__ void phase_mix(const Params& p, int layer, unsigned char* smem) {
  const int NA = 9216, NS = 1536, NP = 3072;
  for (int it = blockIdx.x; it < NA + NS + NP; it += gridDim.x) {
    if (it < NA) attn_item(p, layer, it, smem);
    else if (it < NA + NS) sg_item(p, layer, it - NA, smem);
    else pool_item(p, layer, it - NA - NS, smem);
  }
}

constexpr int SBT = 16;
struct RwkvLds {
  bf16_t twb[SBT * 72], tab[SBT * 72];
  float accw[SBT * 64], acca[SBT * 64];
  float R[SBT * 64], W[SBT * 64], K[SBT * 64], V[SBT * 64], KK[SBT * 64], B[SBT * 64];
  float ot[SBT * 64];
  float bon[SBT * 64];
};

__device__ __forceinline__ float red8(float v) { v += dpp_qx1(v); v += dpp_qx2(v); v += dpp_hm(v); return v; }
__device__ __forceinline__ float red16(float v) { v = red8(v); v += __int_as_float(__builtin_amdgcn_update_dpp(0, __float_as_int(v), 0x140, 0xF, 0xF, true)); return v; }

struct ScanOps { f32x4 w0, w1, b0, b1, kk0, kk1, k0, k1, r0, r1; float2 v; };
template <bool PASS_C>
__device__ __forceinline__ ScanOps load_ops(const RwkvLds& L, int tk, int j0, int row0) {
  ScanOps o;
  o.w0 = *(const f32x4*)(L.W + tk * 64 + j0); o.w1 = *(const f32x4*)(L.W + tk * 64 + j0 + 4);
  o.b0 = *(const f32x4*)(L.B + tk * 64 + j0); o.b1 = *(const f32x4*)(L.B + tk * 64 + j0 + 4);
  o.kk0 = *(const f32x4*)(L.KK + tk * 64 + j0); o.kk1 = *(const f32x4*)(L.KK + tk * 64 + j0 + 4);
  o.k0 = *(const f32x4*)(L.K + tk * 64 + j0); o.k1 = *(const f32x4*)(L.K + tk * 64 + j0 + 4);
  if (PASS_C) { o.r0 = *(const f32x4*)(L.R + tk * 64 + j0); o.r1 = *(const f32x4*)(L.R + tk * 64 + j0 + 4); }
  else { o.r0 = o.w0; o.r1 = o.w1; }
  o.v = *(const float2*)(L.V + tk * 64 + row0);
  return o;
}

#define RAW_LOAD(SBI) { _Pragma("unroll") for (int i = 0; i < 4; ++i) { \
      const int tau = (SBI) * SBT + wave * 4 + i; \
      const int t = dir ? (t0 + 127 - tau) : (t0 + tau); \
      const int tp = dir ? t + 1 : t - 1; \
      const bool pv = tp >= sstart && tp < send; \
      const bf16_t* cr = p.rest + (size_t)t * RESTW; \
      const bf16_t* pr = p.rest + (size_t)(pv ? tp : t) * RESTW; \
      raw[i][0] = cr[768 + cidx]; raw[i][1] = cr[1024 + cidx]; raw[i][2] = cr[1280 + cidx]; raw[i][3] = cr[1536 + dir * 128 + lane]; raw[i][4] = cr[1536 + dir * 128 + 64 + lane]; \
      raw[i][5] = pv ? pr[768 + cidx] : (bf16_t)0; raw[i][6] = pv ? pr[1024 + cidx] : (bf16_t)0; raw[i][7] = pv ? pr[1280 + cidx] : (bf16_t)0; \
      raw[i][8] = pv ? pr[1536 + dir * 128 + lane] : (bf16_t)0; raw[i][9] = pv ? pr[1536 + dir * 128 + 64 + lane] : (bf16_t)0; } }

template <bool PASS_C>
__device__ void rwkv_job(const Params& p, int layer, int job, unsigned char* smem) {
  RwkvLds& L = *(RwkvLds*)smem;
  const int tid = get_tid(), lane = tid & 63, wave = tid >> 6;
  const int hd = job & 3, cp = job >> 2, t0 = cp * 128;
  int sstart, slen; seq_of(t0, sstart, slen);
  const int send = sstart + slen;
  const int rp = tid >> 3, jg = tid & 7, row0 = rp * 2, j0 = jg * 8;
  float* ytg0 = p.pg + ((size_t)cp * 8 + hd) * 8192;
  float* ytg1 = p.pg + ((size_t)cp * 8 + 4 + hd) * 8192;
#pragma unroll 1
  for (int dir = 0; dir < 2; ++dir) {
    const int ld = layer * 2 + dir;
    float* slot = p.pg + ((size_t)cp * 8 + dir * 4 + hd) * 8192;
    __syncthreads();
    bf16x8 wfr[2], afr[2];
    {
      const int dl_ = lane & 15, gq_ = lane >> 4;
      const float* wsrc = p.w_up + (size_t)ld * 64 * 256 + hd * 64 + 16 * wave + dl_;
      const float* asrc = p.a_up + (size_t)ld * 64 * 256 + hd * 64 + 16 * wave + dl_;
#pragma unroll
      for (int ks = 0; ks < 2; ++ks) {
        union { bf16x8 v; unsigned u[4]; } fw, fa;
#pragma unroll
        for (int e = 0; e < 4; ++e) {
          const int m = ks * 32 + gq_ * 8 + 2 * e;
          fw.u[e] = pack2(wsrc[(size_t)m * 256], wsrc[(size_t)(m + 1) * 256]);
          fa.u[e] = pack2(asrc[(size_t)m * 256], asrc[(size_t)(m + 1) * 256]);
        }
        wfr[ks] = fw.v; afr[ks] = fa.v;
      }
    }
    float S[2][8], Pst[2][8];
#pragma unroll
    for (int rr = 0; rr < 2; ++rr)
#pragma unroll
      for (int j = 0; j < 8; ++j) {
        if (PASS_C) { S[rr][j] = slot[4096 + (row0 + rr) * 64 + j0 + j]; Pst[rr][j] = 0.f; }
        else { S[rr][j] = 0.f; Pst[rr][j] = (row0 + rr == j0 + j) ? 1.f : 0.f; }
      }
    const int cidx = hd * 64 + lane;
    const float mu_r = p.mu_rkv[ld * 768 + cidx], mu_k = p.mu_rkv[ld * 768 + 256 + cidx], mu_v = p.mu_rkv[ld * 768 + 512 + cidx];
    const float mu_w = p.mu_lat[ld * 128 + lane], mu_a = p.mu_lat[ld * 128 + 64 + lane];
    const float w0v = p.w0[ld * 256 + cidx], a0v = p.a0[ld * 256 + cidx];
    const float kkv = p.k_k[ld * 256 + cidx], kav = p.k_a[ld * 256 + cidx], rkv_ = p.r_k[ld * 256 + cidx];
    bf16_t raw[4][10];
    RAW_LOAD(0)
#pragma unroll 1
    for (int sb = 0; sb < 128 / SBT; ++sb) {
      __syncthreads();
#pragma unroll
      for (int i = 0; i < 4; ++i) {
        const int tk = wave * 4 + i;
        const float cr_r = bf2f(raw[i][0]), cr_k = bf2f(raw[i][1]), cr_v = bf2f(raw[i][2]), cr_w = bf2f(raw[i][3]), cr_a = bf2f(raw[i][4]);
        const float pr_r = bf2f(raw[i][5]), pr_k = bf2f(raw[i][6]), pr_v = bf2f(raw[i][7]), pr_w = bf2f(raw[i][8]), pr_a = bf2f(raw[i][9]);
        L.R[tk * 64 + lane] = cr_r + (pr_r - cr_r) * mu_r;
        L.K[tk * 64 + lane] = cr_k + (pr_k - cr_k) * mu_k;
        L.V[tk * 64 + lane] = cr_v + (pr_v - cr_v) * mu_v;
        { const float xw = cr_w + (pr_w - cr_w) * mu_w; L.twb[tk * 72 + lane] = f2bf(1.f - 2.f * __builtin_amdgcn_rcpf(1.f + __expf(2.f * xw))); }
        L.tab[tk * 72 + lane] = f2bf(cr_a + (pr_a - cr_a) * mu_a);
      }
      if (sb + 1 < 128 / SBT) RAW_LOAD(sb + 1)
      __syncthreads();
      {
        const int dl_ = lane & 15, gq_ = lane >> 4;
        f32x4 dw = {0.f, 0.f, 0.f, 0.f}, da = {0.f, 0.f, 0.f, 0.f};
#pragma unroll
        for (int ks = 0; ks < 2; ++ks) {
          const bf16x8 bw = *(const bf16x8*)(L.twb + dl_ * 72 + ks * 32 + gq_ * 8);
          const bf16x8 ba = *(const bf16x8*)(L.tab + dl_ * 72 + ks * 32 + gq_ * 8);
          dw = __builtin_amdgcn_mfma_f32_16x16x32_bf16(wfr[ks], bw, dw, 0, 0, 0);
          da = __builtin_amdgcn_mfma_f32_16x16x32_bf16(afr[ks], ba, da, 0, 0, 0);
        }
        *(f32x4*)(L.accw + dl_ * 64 + 16 * wave + 4 * gq_) = dw;
        *(f32x4*)(L.acca + dl_ * 64 + 16 * wave + 4 * gq_) = da;
      }
      __syncthreads();
      float accw[4], acca[4];
#pragma unroll
      for (int i = 0; i < 4; ++i) { accw[i] = L.accw[(wave * 4 + i) * 64 + lane]; acca[i] = L.acca[(wave * 4 + i) * 64 + lane]; }
#pragma unroll
      for (int i = 0; i < 4; ++i) {
        const int tk = wave * 4 + i;
        const float wpre = w0v + accw[i];
        const float nx = -wpre;
        const float sp = fmaxf(nx, 0.f) + __logf(1.f + __expf(-fabsf(nx)));
        const float wlog = -sp - 0.5f;
        const float decay = __expf(-__expf(wlog));
        const float a = sigmoidf_(a0v + acca[i]);
        const float k = L.K[tk * 64 + lane], r = L.R[tk * 64 + lane], v = L.V[tk * 64 + lane];
        float kk = k * kkv;
        const float ss = wave_sum(kk * kk);
        kk *= rsqrtf(ss + 1e-12f);
        const float k2 = k * (1.f + (a - 1.f) * kav);
        L.W[tk * 64 + lane] = decay; L.K[tk * 64 + lane] = k2; L.KK[tk * 64 + lane] = kk; L.B[tk * 64 + lane] = kk * a;
        if (PASS_C) { const float bs = wave_sum(r * k2 * rkv_); L.bon[tk * 64 + lane] = bs * v; }
      }
      __syncthreads();
      ScanOps cur = load_ops<PASS_C>(L, 0, j0, row0);
#pragma unroll 4
      for (int tk = 0; tk < SBT; ++tk) {
        const ScanOps nx = load_ops<PASS_C>(L, (tk + 1) & (SBT - 1), j0, row0);
        float w[8], b[8], kkr[8], k[8];
#pragma unroll
        for (int j = 0; j < 4; ++j) { w[j] = cur.w0[j]; w[j + 4] = cur.w1[j]; b[j] = cur.b0[j]; b[j + 4] = cur.b1[j]; kkr[j] = cur.kk0[j]; kkr[j + 4] = cur.kk1[j]; k[j] = cur.k0[j]; k[j + 4] = cur.k1[j]; }
        const float vr[2] = {cur.v.x, cur.v.y};
        float sa[2], sp[2] = {0.f, 0.f};
#pragma unroll
        for (int rr = 0; rr < 2; ++rr) {
          float a0 = S[rr][0] * kkr[0], a1 = S[rr][1] * kkr[1];
#pragma unroll
          for (int j = 2; j < 8; j += 2) { a0 += S[rr][j] * kkr[j]; a1 += S[rr][j + 1] * kkr[j + 1]; }
          sa[rr] = a0 + a1;
          if (!PASS_C) {
            float p0 = Pst[rr][0] * kkr[0], p1 = Pst[rr][1] * kkr[1];
#pragma unroll
            for (int j = 2; j < 8; j += 2) { p0 += Pst[rr][j] * kkr[j]; p1 += Pst[rr][j + 1] * kkr[j + 1]; }
            sp[rr] = p0 + p1;
          }
        }
        sa[0] = red8(sa[0]); sa[1] = red8(sa[1]);
        if (!PASS_C) { sp[0] = red8(sp[0]); sp[1] = red8(sp[1]); }
#pragma unroll
        for (int rr = 0; rr < 2; ++rr)
#pragma unroll
          for (int j = 0; j < 8; ++j) {
            S[rr][j] = S[rr][j] * w[j] + (vr[rr] * k[j] - sa[rr] * b[j]);
            if (!PASS_C) Pst[rr][j] = Pst[rr][j] * w[j] - sp[rr] * b[j];
          }
        if (PASS_C) {
          float o0 = 0.f, o1 = 0.f;
#pragma unroll
          for (int j = 0; j < 4; ++j) { o0 += S[0][j] * cur.r0[j] + S[0][j + 4] * cur.r1[j]; o1 += S[1][j] * cur.r0[j] + S[1][j + 4] * cur.r1[j]; }
          o0 = red8(o0); o1 = red8(o1);
          if (jg == 0) { L.ot[tk * 64 + row0] = o0; L.ot[tk * 64 + row0 + 1] = o1; }
        }
        cur = nx;
      }
      if (PASS_C) {
        __syncthreads();
        const int x = tid >> 4, part = tid & 15;
        const int tk = dir ? (SBT - 1 - x) : x, tau = sb * SBT + tk;
        const int tl = dir ? (127 - tau) : tau;
        const f32x4 ov = *(const f32x4*)(L.ot + tk * 64 + part * 4);
        float o[4] = {ov[0], ov[1], ov[2], ov[3]};
        float s1 = red16(o[0] + o[1] + o[2] + o[3]);
        const float mu = s1 * (1.f / 64.f);
        float s2 = 0.f;
#pragma unroll
        for (int e = 0; e < 4; ++e) { o[e] -= mu; s2 += o[e] * o[e]; }
        s2 = red16(s2);
        const float rs = rsqrtf(s2 * (1.f / 64.f) + 64e-5f);
        const int ch = hd * 64 + part * 4;
        const f32x4 lg = *(const f32x4*)(p.ln_g + layer * 256 + ch), lb = *(const f32x4*)(p.ln_b + layer * 256 + ch);
        const f32x4 bo = *(const f32x4*)(L.bon + tk * 64 + part * 4);
        f32x4 y;
#pragma unroll
        for (int e = 0; e < 4; ++e) y[e] = o[e] * rs * lg[e] + lb[e] + bo[e];
        float* yg = (tl < 64 ? ytg0 + tl * 64 : ytg1 + (tl - 64) * 64) + part * 4;
        if (dir == 0) *(f32x4*)yg = y;
        else {
          const f32x4 y0 = *(const f32x4*)yg;
          bf16_t* yp = p.ys + (size_t)(t0 + tl) * 1024 + 768 + ch;
          const uint2 yv = *(const uint2*)yp;
          uint2 ov2;
          ov2.x = pack2(__uint_as_float(yv.x << 16) * (y[0] + y0[0]), __uint_as_float(yv.x & 0xffff0000u) * (y[1] + y0[1]));
          ov2.y = pack2(__uint_as_float(yv.y << 16) * (y[2] + y0[2]), __uint_as_float(yv.y & 0xffff0000u) * (y[3] + y0[3]));
          if (!DRY(p)) *(uint2*)yp = ov2;
        }
      }
    }
    if (!PASS_C) {
#pragma unroll
      for (int rr = 0; rr < 2; ++rr)
#pragma unroll
        for (int j = 0; j < 8; ++j) { slot[(row0 + rr) * 64 + j0 + j] = Pst[rr][j]; slot[4096 + (row0 + rr) * 64 + j0 + j] = S[rr][j]; }
    }
  }
  __syncthreads();
}

__device__ void rwkv_passB(const Params& p, unsigned char* smem) {
  float* Pl = (float*)smem;
  float* Sl = Pl + 4096;
  const int tid = get_tid();
  for (int wk = blockIdx.x; wk < 128; wk += gridDim.x) {
    const int rg = wk & 3, hd = (wk >> 2) & 3, dir = (wk >> 4) & 1, seq = wk >> 5;
    const int cbase = seq == 0 ? 0 : seq == 1 ? 64 : seq == 2 ? 128 : 256;
    const int nch = seq < 2 ? 64 : 128;
    const int row = tid >> 4, jq = tid & 15;
    __syncthreads();
    for (int i = tid; i < 16 * 64; i += 256) Sl[i] = 0.f;
    __syncthreads();
    float4 pf0, pf1, pf2, pf3, gf;
    {
      const int c = dir ? nch - 1 : 0;
      const float* slot = p.pg + ((size_t)(cbase + c) * 8 + dir * 4 + hd) * 8192;
      pf0 = ((const float4*)slot)[tid]; pf1 = ((const float4*)slot)[tid + 256]; pf2 = ((const float4*)slot)[tid + 512]; pf3 = ((const float4*)slot)[tid + 768];
      gf = *(const float4*)(slot + 4096 + (rg * 16 + row) * 64 + jq * 4);
    }
#pragma unroll 1
    for (int ci = 0; ci < nch; ++ci) {
      const int c = dir ? nch - 1 - ci : ci;
      float* slot = p.pg + ((size_t)(cbase + c) * 8 + dir * 4 + hd) * 8192;
      ((float4*)Pl)[tid] = pf0; ((float4*)Pl)[tid + 256] = pf1; ((float4*)Pl)[tid + 512] = pf2; ((float4*)Pl)[tid + 768] = pf3;
      float* gp = slot + 4096 + (rg * 16 + row) * 64 + jq * 4;
      float4 acc = gf;
      if (ci + 1 < nch) {
        const int c2 = dir ? nch - 2 - ci : ci + 1;
        const float* s2 = p.pg + ((size_t)(cbase + c2) * 8 + dir * 4 + hd) * 8192;
        pf0 = ((const float4*)s2)[tid]; pf1 = ((const float4*)s2)[tid + 256]; pf2 = ((const float4*)s2)[tid + 512]; pf3 = ((const float4*)s2)[tid + 768];
        gf = *(const float4*)(s2 + 4096 + (rg * 16 + row) * 64 + jq * 4);
      }
      __syncthreads();
      float4 sold = *(const float4*)(Sl + row * 64 + jq * 4);
#pragma unroll 4
      for (int m4 = 0; m4 < 16; ++m4) {
        const float4 s4 = *(const float4*)(Sl + row * 64 + m4 * 4);
        const float sv[4] = {s4.x, s4.y, s4.z, s4.w};
#pragma unroll
        for (int e = 0; e < 4; ++e) {
          const float4 pv = *(const float4*)(Pl + (m4 * 4 + e) * 64 + jq * 4);
          acc.x += sv[e] * pv.x; acc.y += sv[e] * pv.y; acc.z += sv[e] * pv.z; acc.w += sv[e] * pv.w;
        }
      }
      if (!DRY(p)) *(float4*)gp = sold;
      __syncthreads();
      *(float4*)(Sl + row * 64 + jq * 4) = acc;
      __syncthreads();
    }
  }
}

__device__ __forceinline__ void run_phase(const Params& p, int layer, int sub, unsigned char* smem) {
  switch (sub) {
    case 0: phase_prep(p, layer); break;
    case 1: phase_g1(p, layer, smem); break;
    case 2: phase_mix(p, layer, smem); break;
    case 3: for (int j = blockIdx.x; j < 1536; j += gridDim.x) rwkv_job<false>(p, layer, j, smem); attn_combine(p); break;
    case 4: rwkv_passB(p, smem); break;
    case 5: for (int j = blockIdx.x; j < 1536; j += gridDim.x) rwkv_job<true>(p, layer, j, smem); break;
    case 6: phase_branch(p, smem); break;
    case 7: phase_gate(p, layer, smem); break;
    case 8: phase_out(p, layer, smem); break;
  }
}
__global__ void __launch_bounds__(256, 2) mega(Params p) {
  extern __shared__ __attribute__((aligned(16))) unsigned char smem[];
  cg::grid_group grid = cg::this_grid();
  for (int ph = p.phase_lo; ph < p.phase_hi; ++ph) {
    const int layer = ph / NPH, sub = ph % NPH;
#if PROBE_MASK
    for (int rep = (PROBE_MASK >> sub) & 1; rep >= 0; --rep) {
      __syncthreads(); if (get_tid() == 0) s_dry = rep; __syncthreads();
      run_phase(p, layer, sub, smem);
      if (rep) grid.sync();
    }
#else
    run_phase(p, layer, sub, smem);
#endif
    if (ph + 1 < p.phase_hi) grid.sync();
  }
}

extern "C" void kernel_launch(void* const* d_in, const int* in_sizes, int n_in, void* d_out, int out_size, void* d_ws, size_t ws_size, hipStream_t stream) {
  static int grid_blocks = 0;
  if (!grid_blocks) {
    hipFuncSetAttribute((const void*)mega, hipFuncAttributeMaxDynamicSharedMemorySize, SMEM_BYTES);
    int dev = 0, cus = 0, per_cu = 0;
    hipGetDevice(&dev);
    hipDeviceGetAttribute(&cus, hipDeviceAttributeMultiprocessorCount, dev);
    hipOccupancyMaxActiveBlocksPerMultiprocessor(&per_cu, mega, 256, SMEM_BYTES);
    if (per_cu < 1) per_cu = 1;
    grid_blocks = cus * per_cu;
  }
  Params p{};
  p.xp = (const float*)d_in[0]; p.xs = (const float*)d_in[1];
  p.norm_g = (const float*)d_in[2]; p.w_in = (const float*)d_in[3]; p.q_norm_g = (const float*)d_in[4]; p.k_norm_g = (const float*)d_in[5];
  p.pool_w = (const float*)d_in[6]; p.pool_scale = (const float*)d_in[7]; p.sg_norm_g = (const float*)d_in[8]; p.sg_w = (const float*)d_in[9]; p.sg_b = (const float*)d_in[10];
  p.mu_rkv = (const float*)d_in[11]; p.mu_lat = (const float*)d_in[12]; p.w0 = (const float*)d_in[13]; p.w_up = (const float*)d_in[14]; p.a0 = (const float*)d_in[15]; p.a_up = (const float*)d_in[16];
  p.k_k = (const float*)d_in[17]; p.k_a = (const float*)d_in[18]; p.r_k = (const float*)d_in[19]; p.ln_g = (const float*)d_in[20]; p.ln_b = (const float*)d_in[21];
  p.w_branch = (const float*)d_in[22]; p.w_out = (const float*)d_in[23];
  p.out = (float*)d_out;
  unsigned char* ws = (unsigned char*)d_ws;
  size_t off = 0;
  p.qkv = (bf16_t*)(ws + off); off += (size_t)MTOK * QKVW * 2;
  p.rest = (bf16_t*)(ws + off); off += (size_t)MTOK * RESTW * 2;
  p.ys = (bf16_t*)(ws + off); off += (size_t)MTOK * 1024 * 2;
  p.w1t = (bf16_t*)(ws + off); off += (size_t)5120 * 1024 * 2;
  p.wgt = (bf16_t*)(ws + off); off += (size_t)4096 * 1024 * 2;
  p.wbrt = (bf16_t*)(ws + off); off += (size_t)4096 * 256 * 2;
  p.woutt = (bf16_t*)(ws + off); off += (size_t)1024 * 1024 * 2;
  p.rstd = (float*)(ws + off); off += (size_t)MTOK * 4;
  p.xb = (bf16_t*)(ws + off); off += (size_t)MTOK * 1024 * 2;
  p.pnum = (float*)(ws + off); off += (size_t)3 * MTOK * 256 * 4;
  p.pden = (float*)(ws + off); off += (size_t)3 * MTOK * 4 * 4;
  p.pg = (float*)p.qkv;
  p.branch = p.qkv;
  if (off > ws_size) { fprintf(stderr, "workspace too small: need %zu have %zu\n", off, ws_size); return; }
#if MULTI_LAUNCH
  for (int ph = 0; ph < 2 * NPH; ++ph) {
    p.phase_lo = ph; p.phase_hi = ph + 1;
    hipLaunchKernelGGL(mega, dim3(grid_blocks), dim3(256), SMEM_BYTES, stream, p);
  }
#else
  p.phase_lo = 0; p.phase_hi = 2 * NPH;
  void* args[] = {&p};
  hipError_t e = hipLaunchCooperativeKernel((void*)mega, dim3(grid_blocks), dim3(256), args, SMEM_BYTES, stream);
  if (e != hipSuccess) fprintf(stderr, "cooperative launch failed: %s (grid %d)\n", hipGetErrorString(e), grid_blocks);
#endif
}
```

```cpp
#include <hip/hip_runtime.h>
#include <hip/hip_cooperative_groups.h>
#include <cstdio>
namespace cg = cooperative_groups;

#ifndef PROBE_MASK
#define PROBE_MASK 0
#endif
#ifndef PROBE_NOGL
#define PROBE_NOGL 0
#endif
#if PROBE_MASK
__shared__ int s_dry;
#define DRY(p) (s_dry)
#define NOGL (PROBE_NOGL && s_dry)
#else
#define DRY(p) 0
#define NOGL 0
#endif
#ifndef MULTI_LAUNCH
#define MULTI_LAUNCH 0
#endif

typedef unsigned short bf16_t;
typedef short bf16x8 __attribute__((ext_vector_type(8)));
typedef float f32x4 __attribute__((ext_vector_type(4)));
typedef unsigned u32x4 __attribute__((ext_vector_type(4)));
typedef float f32x2 __attribute__((ext_vector_type(2)));
typedef __bf16 bf2v __attribute__((ext_vector_type(2)));

constexpr int MTOK = 49152;
constexpr int DM = 1024;
constexpr int PW = 9216;
constexpr int QKVW = 2304;
constexpr int RESTW = 1792;
constexpr int SMEM_BYTES = 73728 + 16;
constexpr int NPH = 8;

struct Params {
  const float* xp; const float* xs;
  const float* norm_g; const float* w_in; const float* q_norm_g; const float* k_norm_g;
  const float* pool_w; const float* pool_scale; const float* sg_norm_g; const float* sg_w; const float* sg_b;
  const float* mu_rkv; const float* mu_lat; const float* w0; const float* w_up; const float* a0; const float* a_up;
  const float* k_k; const float* k_a; const float* r_k; const float* ln_g; const float* ln_b;
  const float* w_branch; const float* w_out;
  float* out;
  bf16_t* qkv; bf16_t* rest; bf16_t* ys;
  bf16_t* w1t; bf16_t* wgt; bf16_t* wbrt; bf16_t* woutt;
  float* rstd; float* pg; bf16_t* branch; bf16_t* xb; bf16_t* pnum; float* pden; unsigned* bar;
  int phase_lo, phase_hi;
  int dry, pad_;
};

__device__ __forceinline__ int get_tid() { int t = threadIdx.x; asm volatile("" : "+v"(t)); return t; }
__device__ __forceinline__ float bf2f(bf16_t v) { return __uint_as_float(((unsigned)v) << 16); }
__device__ __forceinline__ bf16_t f2bf(float f) { unsigned u = __float_as_uint(f); u += 0x7fffu + ((u >> 16) & 1u); return (bf16_t)(u >> 16); }
__device__ __forceinline__ unsigned pack2(float a, float b) { return (unsigned)f2bf(a) | ((unsigned)f2bf(b) << 16); }
__device__ __forceinline__ float sigmoidf_(float x) { return __builtin_amdgcn_rcpf(1.f + __expf(-x)); }
__device__ __forceinline__ float dpp_qx1(float v) { return __int_as_float(__builtin_amdgcn_update_dpp(0, __float_as_int(v), 0xB1, 0xF, 0xF, true)); }
__device__ __forceinline__ float dpp_qx2(float v) { return __int_as_float(__builtin_amdgcn_update_dpp(0, __float_as_int(v), 0x4E, 0xF, 0xF, true)); }
__device__ __forceinline__ float dpp_hm(float v) { return __int_as_float(__builtin_amdgcn_update_dpp(0, __float_as_int(v), 0x141, 0xF, 0xF, true)); }
__device__ __forceinline__ float wave_sum(float v) {
  v += __int_as_float(__builtin_amdgcn_update_dpp(0, __float_as_int(v), 0xB1, 0xF, 0xF, true));
  v += __int_as_float(__builtin_amdgcn_update_dpp(0, __float_as_int(v), 0x4E, 0xF, 0xF, true));
  v += __int_as_float(__builtin_amdgcn_update_dpp(0, __float_as_int(v), 0x141, 0xF, 0xF, true));
  v += __int_as_float(__builtin_amdgcn_update_dpp(0, __float_as_int(v), 0x140, 0xF, 0xF, true));
  v += __shfl_xor(v, 16); v += __shfl_xor(v, 32);
  return v;
}
__device__ __forceinline__ const float* xrow_ptr(const Params& p, int layer, int row) {
  if (layer == 0) return row < 16384 ? p.xp + (size_t)row * DM : p.xs + (size_t)(row - 16384) * DM;
  return p.out + (size_t)row * DM;
}
__device__ __forceinline__ void seq_of(int T0, int& sstart, int& slen) {
  if (T0 < 16384) { sstart = T0 & ~8191; slen = 8192; } else { sstart = 16384 + ((T0 - 16384) & ~16383); slen = 16384; }
}

__device__ void prep_xb(const Params& p, int layer) {
  const int tid = get_tid(), lane = tid & 63;
  const int gw = (blockIdx.x * 256 + tid) >> 6, nw = gridDim.x * 4;
  for (int row = gw; row < MTOK; row += nw) {
    const float4* x = (const float4*)xrow_ptr(p, layer, row);
    float ss = 0.f;
#pragma unroll
    for (int i = 0; i < 4; ++i) { float4 v = x[lane + i * 64]; ss += v.x * v.x + v.y * v.y + v.z * v.z + v.w * v.w; }
    ss = wave_sum(ss);
    const float rs = rsqrtf(ss * (1.f / 1024.f) + 1e-6f);
#pragma unroll
    for (int i = 0; i < 4; ++i) { float4 v = x[lane + i * 64]; uint2 o; o.x = pack2(v.x * rs, v.y * rs); o.y = pack2(v.z * rs, v.w * rs); *(uint2*)(p.xb + (size_t)row * 1024 + (lane + i * 64) * 4) = o; }
  }
}

__device__ __forceinline__ int w1_col(int n) {
  if (n < 2304) return n; if (n < 2560) return 2560 + (n - 2304); if (n < 3072) return 3072 + (n - 2560);
  if (n < 3840) return 3840 + (n - 3072); if (n < 4096) return 4608 + (n - 3840);
  if (n < 4352) return 2304 + (n - 4096); if (n < 4608) return 2816 + (n - 4352);
  if (n < 4864) return 3584 + (n - 4608); return 4864 + (n - 4864);
}
__device__ __forceinline__ int wg_col(int n) {
  const int tn = n >> 8, c = n & 255, wn = c >> 7, nn = (c >> 4) & 7, dl = c & 15, dg = nn >> 2, b = nn & 3;
  return 5120 + b * 1024 + tn * 64 + wn * 32 + dg * 16 + dl;
}

__device__ void phase_prep(const Params& p, int layer, unsigned char* smem) {
  const int tid = get_tid(), lane = tid & 63, wave = tid >> 6;
  prep_xb(p, layer);
  const float* w_in = p.w_in + (size_t)layer * DM * PW;
  const float* ng = p.norm_g + layer * DM;
  const float* wb = p.w_branch + (size_t)layer * 4 * 256 * 1024;
  const float* wo = p.w_out + (size_t)layer * 1024 * 1024;
  bf16_t* T = (bf16_t*)smem;
  const int NT0 = 80 * 16, NT1 = 64 * 16, NT2 = 64 * 4, NT3 = 16 * 16;
  for (int tile = blockIdx.x; tile < NT0 + NT1 + NT2 + NT3; tile += gridDim.x) {
    int kind, tl = tile;
    if (tl < NT0) kind = 0; else if ((tl -= NT0) < NT1) kind = 1; else if ((tl -= NT1) < NT2) kind = 2; else { tl -= NT2; kind = 3; }
    const int nkt = kind == 2 ? 4 : 16;
    const int n0 = (tl / nkt) * 64, k0 = (tl % nkt) * 64;
    const int n = n0 + lane;
    const float* src; size_t ls; bf16_t* dst; int K;
    if (kind == 0) { src = w_in + w1_col(n); ls = PW; dst = p.w1t; K = 1024; }
    else if (kind == 1) { src = w_in + wg_col(n); ls = PW; dst = p.wgt; K = 1024; }
    else if (kind == 2) { src = wb + (size_t)(n >> 10) * 256 * 1024 + (n & 1023); ls = 1024; dst = p.wbrt; K = 256; }
    else { src = wo + n; ls = 1024; dst = p.woutt; K = 1024; }
    float v[16];
#pragma unroll
    for (int i = 0; i < 16; ++i) v[i] = src[(size_t)(k0 + wave * 16 + i) * ls];
    if (kind < 2) {
#pragma unroll
      for (int i = 0; i < 16; ++i) v[i] *= ng[k0 + wave * 16 + i];
    }
#pragma unroll
    for (int i = 0; i < 8; ++i) *(unsigned*)(T + lane * 72 + wave * 16 + 2 * i) = pack2(v[2 * i], v[2 * i + 1]);
    __syncthreads();
#pragma unroll
    for (int i = 0; i < 2; ++i) {
      const int id = tid + i * 256, nl = id >> 3, kc = id & 7;
      *(u32x4*)(dst + (size_t)(n0 + nl) * K + k0 + kc * 8) = *(const u32x4*)(T + nl * 72 + kc * 8);
    }
    __syncthreads();
  }
}

__device__ __forceinline__ int lds_off(int r, int c) { return r * 128 + ((c ^ ((r >> 1) & 7)) << 4); }

#define LAS __attribute__((address_space(3)))
constexpr int GSTAGE = 24576;
#define DMA16(G, L) __builtin_amdgcn_global_load_lds((const unsigned*)(G), (LAS unsigned*)(L), 16, 0, 0)
#define DMA_TILE(T, ST) { const size_t ko = (size_t)(T) * 64; LAS unsigned char* d_ = lds + (ST) * GSTAGE + ldsw; \
    DMA16(Ab + ko + voffA, d_); DMA16(Ab + ko + (voffA + 64u * lda2), d_ + 4096); \
    DMA16(Bb + ko + voffB, d_ + 8192); DMA16(Bb + ko + (voffB + 64u * ldb2), d_ + 12288); \
    DMA16(Bb + ko + (voffB + 128u * ldb2), d_ + 16384); DMA16(Bb + ko + (voffB + 192u * ldb2), d_ + 20480); }

__device__ __forceinline__ void gemm_compute(f32x4 (&acc)[4][8], const LAS unsigned char* a_, int aoff, int boff) {
  const LAS unsigned char* b_ = a_ + 8192;
  bf16x8 af[4], bfr[8];
#pragma unroll
  for (int m = 0; m < 4; ++m) af[m] = *(const LAS bf16x8*)(a_ + aoff + m * 1024);
#pragma unroll
  for (int n = 0; n < 8; ++n) bfr[n] = *(const LAS bf16x8*)(b_ + boff + n * 1024);
  asm volatile("" :: "v"(af[0]), "v"(af[1]), "v"(af[2]), "v"(af[3]));
#pragma unroll
  for (int m = 0; m < 4; ++m)
#pragma unroll
    for (int n = 0; n < 8; ++n) acc[m][n] = __builtin_amdgcn_mfma_f32_16x16x32_bf16(bfr[n], af[m], acc[m][n], 0, 0, 0);
}

#define DMA_HALF0(T, ST) { const size_t ko = (size_t)(T) * 64; LAS unsigned char* d_ = lds + (ST) * GSTAGE + ldsw; \
    DMA16(Ab + ko + voffA, d_); DMA16(Ab + ko + (voffA + 64u * lda2), d_ + 4096); DMA16(Bb + ko + voffB, d_ + 8192); }
#define DMA_HALF1(T, ST) { const size_t ko = (size_t)(T) * 64; LAS unsigned char* d_ = lds + (ST) * GSTAGE + ldsw; \
    DMA16(Bb + ko + (voffB + 64u * ldb2), d_ + 12288); DMA16(Bb + ko + (voffB + 128u * ldb2), d_ + 16384); DMA16(Bb + ko + (voffB + 192u * ldb2), d_ + 20480); }
__device__ __forceinline__ void gemm_core(f32x4 (&acc)[4][8], const bf16_t* Aptr, int lda, const bf16_t* Bt, int ldb, int K, unsigned char* smem) {
  const int tid = get_tid(), lane = tid & 63, wave = tid >> 6, wm = wave >> 1, wn = wave & 1;
  const int dl = lane & 15, gq = lane >> 4, swz = ((dl >> 3) & 1) * 3;
  const int aoff = (wm * 64 + dl) * 64 + ((gq ^ swz) << 4);
  const int boff = (wn * 128 + dl) * 64 + ((gq ^ swz) << 4);
  LAS unsigned char* lds = (LAS unsigned char*)smem;
  const int r0 = tid >> 2, csrc = (tid & 3) ^ (((r0 >> 3) & 1) * 3);
  const int ldsw = tid * 16;
  const unsigned lda2 = (unsigned)lda * 2u, ldb2 = (unsigned)ldb * 2u;
  const unsigned voffA = (unsigned)r0 * lda2 + csrc * 16, voffB = (unsigned)r0 * ldb2 + csrc * 16;
  const unsigned char* Ab = (const unsigned char*)Aptr; const unsigned char* Bb = (const unsigned char*)Bt;
  const int nt = K >> 5;
  DMA_TILE(0, 0) DMA_TILE(1, 1)
  int st = 0, st2 = 2;
#pragma unroll 1
  for (int t = 0; t < nt; ++t) {
    if (t + 1 < nt) asm volatile("s_waitcnt vmcnt(6)" ::: "memory"); else asm volatile("s_waitcnt vmcnt(0)" ::: "memory");
    asm volatile("" ::: "memory"); __builtin_amdgcn_s_barrier(); asm volatile("" ::: "memory");
    {
      const LAS unsigned char* a_ = lds + st * GSTAGE; const LAS unsigned char* b_ = a_ + 8192;
      bf16x8 af[4], bfr[8];
#pragma unroll
      for (int m = 0; m < 4; ++m) af[m] = *(const LAS bf16x8*)(a_ + aoff + m * 1024);
#pragma unroll
      for (int n = 0; n < 8; ++n) bfr[n] = *(const LAS bf16x8*)(b_ + boff + n * 1024);
      asm volatile("" :: "v"(af[0]), "v"(af[1]), "v"(af[2]), "v"(af[3]));
      __builtin_amdgcn_sched_barrier(0);
#pragma unroll
      for (int m = 0; m < 2; ++m)
#pragma unroll
        for (int n = 0; n < 8; ++n) acc[m][n] = __builtin_amdgcn_mfma_f32_16x16x32_bf16(bfr[n], af[m], acc[m][n], 0, 0, 0);
      __builtin_amdgcn_sched_barrier(0);
      if (t + 2 < nt) DMA_HALF0(t + 2, st2)
      __builtin_amdgcn_sched_barrier(0);
#pragma unroll
      for (int m = 2; m < 4; ++m)
#pragma unroll
        for (int n = 0; n < 8; ++n) acc[m][n] = __builtin_amdgcn_mfma_f32_16x16x32_bf16(bfr[n], af[m], acc[m][n], 0, 0, 0);
      __builtin_amdgcn_sched_barrier(0);
      if (t + 2 < nt) DMA_HALF1(t + 2, st2)
    }
    st = st == 2 ? 0 : st + 1; st2 = st2 == 2 ? 0 : st2 + 1;
  }
  asm volatile("" ::: "memory"); __builtin_amdgcn_s_barrier(); asm volatile("" ::: "memory");
}

__device__ __forceinline__ void zero_acc(f32x4 (&acc)[4][8]) {
#pragma unroll
  for (int m = 0; m < 4; ++m)
#pragma unroll
    for (int n = 0; n < 8; ++n) acc[m][n] = (f32x4){0.f, 0.f, 0.f, 0.f};
}

__device__ __forceinline__ bool tile_of(int it, int ntn, int& tm, int& tn) {
  if (gridDim.x == 256 || gridDim.x == 512) {
    const int xcd = blockIdx.x & 7, s = blockIdx.x >> 3;
    const int gmh = gridDim.x == 512 ? 16 : 8;
    const int gn_cnt = ntn >> 2, g = it * 8 + xcd;
    if (g >= (384 / gmh) * gn_cnt) return false;
    const int gm = g / gn_cnt, gn = g % gn_cnt;
    tm = gm * gmh + (s & (gmh - 1)); tn = gn * 4 + s / gmh;
    return true;
  }
  const int tile = blockIdx.x + it * gridDim.x;
  if (tile >= 384 * ntn) return false;
  tm = tile / ntn; tn = tile % ntn; return true;
}

__device__ void phase_g1(const Params& p, int layer, unsigned char* smem) {
  const int lane = get_tid() & 63, wave = get_tid() >> 6, wm = wave >> 1, wn = wave & 1;
  int tm, tn;
  for (int it = 0; tile_of(it, 20, tm, tn); ++it) {
    const int row0 = tm * 128, col0 = tn * 256;
    f32x4 acc[4][8]; zero_acc(acc);
    gemm_core(acc, p.xb + (size_t)row0 * 1024, 1024, p.w1t + (size_t)col0 * 1024, 1024, 1024, smem);
    if (col0 < 1536) {
      const float* gn = (col0 < 768 ? p.q_norm_g : p.k_norm_g) + layer * 64;
      const float sc = col0 < 768 ? 0.125f : 1.f;
#pragma unroll
      for (int m = 0; m < 4; ++m)
#pragma unroll
        for (int hh = 0; hh < 2; ++hh) {
          float ss = 0.f;
#pragma unroll
          for (int n = 0; n < 4; ++n)
#pragma unroll
            for (int j = 0; j < 4; ++j) ss += acc[m][hh * 4 + n][j] * acc[m][hh * 4 + n][j];
          ss += __shfl_xor(ss, 16); ss += __shfl_xor(ss, 32);
          const float rs = rsqrtf(ss * (1.f / 64.f) + 1e-6f) * sc;
#pragma unroll
          for (int n = 0; n < 4; ++n) {
            const f32x4 gv = *(const f32x4*)(gn + n * 16 + (lane >> 4) * 4);
#pragma unroll
            for (int j = 0; j < 4; ++j) acc[m][hh * 4 + n][j] *= rs * gv[j];
          }
        }
    }
    {
      unsigned char* wl = smem + wave * 17408;
      const bool act = col0 >= 4096;
#pragma unroll
      for (int m = 0; m < 4; ++m)
#pragma unroll
        for (int n = 0; n < 8; ++n) {
          float v0 = acc[m][n][0], v1 = acc[m][n][1], v2 = acc[m][n][2], v3 = acc[m][n][3];
          if (act) { v0 *= sigmoidf_(v0); v1 *= sigmoidf_(v1); v2 *= sigmoidf_(v2); v3 *= sigmoidf_(v3); }
          uint2 o; o.x = pack2(v0, v1); o.y = pack2(v2, v3);
          *(uint2*)(wl + (m * 16 + (lane & 15)) * 272 + (n * 16 + (lane >> 4) * 4) * 2) = o;
        }
      bf16_t* dst; int ld;
      if (col0 < QKVW) { dst = p.qkv + col0; ld = QKVW; }
      else if (col0 < 4096) { dst = p.rest + (col0 - QKVW); ld = RESTW; }
      else { dst = p.ys + (col0 - 4096); ld = 1024; }
      dst += (size_t)(row0 + wm * 64) * ld + wn * 128;
#pragma unroll
      for (int i = 0; i < 16; ++i) {
        const int id = i * 64 + lane, r = id >> 4, c16 = id & 15;
        const u32x4 v = *(const u32x4*)(wl + r * 272 + c16 * 16);
        *(u32x4*)(dst + (size_t)r * ld + c16 * 8) = v;
      }
    }
    __syncthreads();
  }
}

__device__ void phase_branch(const Params& p, unsigned char* smem) {
  const int lane = get_tid() & 63, wave = get_tid() >> 6, wm = wave >> 1, wn = wave & 1;
  int tm, tn;
  for (int it = 0; tile_of(it, 16, tm, tn); ++it) {
    const int row0 = tm * 128, col0 = tn * 256, b = tn >> 2;
    f32x4 acc[4][8]; zero_acc(acc);
    gemm_core(acc, p.ys + (size_t)row0 * 1024 + b * 256, 1024, p.wbrt + (size_t)col0 * 256, 256, 256, smem);
#pragma unroll
    for (int m = 0; m < 4; ++m) {
      const int row = row0 + wm * 64 + m * 16 + (lane & 15);
#pragma unroll
      for (int n = 0; n < 8; ++n) {
        const int colt = col0 + wn * 128 + n * 16, bb = colt >> 10, d16 = (colt & 1023) >> 4;
        uint2 o; o.x = pack2(acc[m][n][0], acc[m][n][1]); o.y = pack2(acc[m][n][2], acc[m][n][3]);
        *(uint2*)(p.branch + ((((((size_t)tm * 2 + wm) * 4 + m) * 4 + bb) * 64 + d16) * 64 + lane) * 4) = o;
      }
    }
  }
}

__device__ void phase_gate(const Params& p, int layer, unsigned char* smem) {
  const int lane = get_tid() & 63, wave = get_tid() >> 6, wm = wave >> 1, wn = wave & 1;
  int tm, tn;
  for (int it = 0; tile_of(it, 16, tm, tn); ++it) {
    const int row0 = tm * 128;
    f32x4 acc[4][8]; zero_acc(acc);
    gemm_core(acc, p.xb + (size_t)row0 * 1024, 1024, p.wgt + (size_t)tn * 256 * 1024, 1024, 1024, smem);
#pragma unroll
    for (int m = 0; m < 4; ++m) {
      const int row = row0 + wm * 64 + m * 16 + (lane & 15);
#pragma unroll
      for (int dg = 0; dg < 2; ++dg) {
        const int d = tn * 64 + wn * 32 + dg * 16 + (lane >> 4) * 4;
        float s0 = 0.f, s1 = 0.f, s2 = 0.f, s3 = 0.f;
#pragma unroll
        for (int b = 0; b < 4; ++b) {
          uint2 br = *(const uint2*)(p.branch + ((((((size_t)tm * 2 + wm) * 4 + m) * 4 + b) * 64 + (tn * 4 + wn * 2 + dg)) * 64 + lane) * 4);
          s0 += sigmoidf_(acc[m][dg * 4 + b][0]) * __uint_as_float(br.x << 16);
          s1 += sigmoidf_(acc[m][dg * 4 + b][1]) * __uint_as_float(br.x & 0xffff0000u);
          s2 += sigmoidf_(acc[m][dg * 4 + b][2]) * __uint_as_float(br.y << 16);
          s3 += sigmoidf_(acc[m][dg * 4 + b][3]) * __uint_as_float(br.y & 0xffff0000u);
        }
        uint2 o; o.x = pack2(s0, s1); o.y = pack2(s2, s3);
        *(uint2*)(p.ys + (size_t)row * 1024 + d) = o;
        asm volatile("" ::: "memory");
      }
    }
  }
}

__device__ void phase_out(const Params& p, int layer, unsigned char* smem) {
  const int lane = get_tid() & 63, wave = get_tid() >> 6, wm = wave >> 1, wn = wave & 1;
  int tm, tn;
  for (int it = 0; tile_of(it, 4, tm, tn); ++it) {
    const int row0 = tm * 128, col0 = tn * 256;
    f32x4 acc[4][8]; zero_acc(acc);
    gemm_core(acc, p.ys + (size_t)row0 * 1024, 1024, p.woutt + (size_t)col0 * 1024, 1024, 1024, smem);
#pragma unroll
    for (int m = 0; m < 4; ++m) {
      const int row = row0 + wm * 64 + m * 16 + (lane & 15);
      const float* xr = xrow_ptr(p, layer, row);
#pragma unroll
      for (int n = 0; n < 8; ++n) {
        const int col = col0 + wn * 128 + n * 16 + (lane >> 4) * 4;
        float4 xv = *(const float4*)(xr + col);
        float4 o; o.x = xv.x + acc[m][n][0]; o.y = xv.y + acc[m][n][1]; o.z = xv.z + acc[m][n][2]; o.w = xv.w + acc[m][n][3];
        if (!DRY(p)) *(float4*)(p.out + (size_t)row * 1024 + col) = o;
      }
    }
  }
}

constexpr int QS_STRIDE = 144, KS_STRIDE = 144, VT_STRIDE = 432;
struct AttnRaw { u32x4 q0, q1, ka0, kb0, va0, vb0, ka1, kb1, va1, vb1, ka2, kb2, va2, vb2, ka3, kb3, va3, vb3; };
__device__ __forceinline__ void attn_issue(const Params& p, int item, AttnRaw& R) {
  const int tid = get_tid();
  const int n = item % 12, run = item / 12, T0 = run * 64;
  const int g = n >> 2, d = g == 0 ? 1 : (g == 1 ? 4 : 16);
  int sstart, slen; seq_of(T0, sstart, slen);
  const int rho = (T0 - sstart) >> 6;
  const int r = rho % d, i0 = (rho / d) * 64;
  const int part = tid & 3;
  {
    const int q = tid >> 2;
    const int pq = d * (i0 + q) + r;
    const bf16_t* base = p.qkv + (size_t)(sstart + pq) * QKVW + n * 64 + part * 16;
    R.q0 = *(const u32x4*)base; R.q1 = *(const u32x4*)(base + 8);
  }
#define ATTN_ISSUE1(IT, KA, KB, VA, VB) { const int rr = (tid >> 2) + (IT) * 64; const int pos = d * (i0 - 64 + rr) + r; \
    const bool ok = rr < 192 && pos >= 0 && pos < slen; const u32x4 z = {0u, 0u, 0u, 0u}; KA = z; KB = z; VA = z; VB = z; \
    if (ok) { const bf16_t* base = p.qkv + (size_t)(sstart + pos) * QKVW + n * 64 + part * 16; \
      KA = *(const u32x4*)(base + 768); KB = *(const u32x4*)(base + 768 + 8); VA = *(const u32x4*)(base + 1536); VB = *(const u32x4*)(base + 1536 + 8); } }
  ATTN_ISSUE1(0, R.ka0, R.kb0, R.va0, R.vb0)
  ATTN_ISSUE1(1, R.ka1, R.kb1, R.va1, R.vb1)
  ATTN_ISSUE1(2, R.ka2, R.kb2, R.va2, R.vb2)
  ATTN_ISSUE1(3, R.ka3, R.kb3, R.va3, R.vb3)
}

__device__ __forceinline__ void attn_item(const Params& p, int layer, int item, AttnRaw& R, int next_item, unsigned char* smem) {
  const int tid = get_tid(), lane = tid & 63, w = tid >> 6;
  const int n = item % 12, run = item / 12, T0 = run * 64;
  const int g = n >> 2, h = n & 3, d = g == 0 ? 1 : (g == 1 ? 4 : 16);
  int sstart, slen; seq_of(T0, sstart, slen);
  const int rho = (T0 - sstart) >> 6;
  const int r = rho % d, i0 = (rho / d) * 64;
  unsigned char* Qs = smem;
  unsigned char* Ks = smem + 64 * QS_STRIDE;
  unsigned char* Vt = Ks + 208 * KS_STRIDE;
  const float* kg = p.k_norm_g + layer * 64;
  const float* qg = p.q_norm_g + layer * 64;
  const int part = tid & 3;
  {
    const int q = tid >> 2;
    *(u32x4*)(Qs + q * QS_STRIDE + part * 32) = R.q0;
    *(u32x4*)(Qs + q * QS_STRIDE + part * 32 + 16) = R.q1;
  }
#define ATTN_PUT1(IT, KA, KB, VA, VB) { const int rr = (tid >> 2) + (IT) * 64; \
    if (rr < 208) { *(u32x4*)(Ks + rr * KS_STRIDE + part * 32) = KA; *(u32x4*)(Ks + rr * KS_STRIDE + part * 32 + 16) = KB; \
      const unsigned vw[8] = {VA[0], VA[1], VA[2], VA[3], VB[0], VB[1], VB[2], VB[3]}; \
      _Pragma("unroll") for (int j = 0; j < 8; ++j) { \
        *(bf16_t*)(Vt + (part * 16 + 2 * j) * VT_STRIDE + rr * 2) = (bf16_t)(vw[j] & 0xffffu); \
        *(bf16_t*)(Vt + (part * 16 + 2 * j + 1) * VT_STRIDE + rr * 2) = (bf16_t)(vw[j] >> 16); } } }
  ATTN_PUT1(0, R.ka0, R.kb0, R.va0, R.vb0)
  ATTN_PUT1(1, R.ka1, R.kb1, R.va1, R.vb1)
  ATTN_PUT1(2, R.ka2, R.kb2, R.va2, R.vb2)
  ATTN_PUT1(3, R.ka3, R.kb3, R.va3, R.vb3)
  if (next_item >= 0) attn_issue(p, next_item, R);
  __syncthreads();
  const int dl = lane & 15, gq = lane >> 4;
  bf16x8 qf0 = *(const bf16x8*)(Qs + (16 * w + dl) * QS_STRIDE + gq * 16);
  bf16x8 qf1 = *(const bf16x8*)(Qs + (16 * w + dl) * QS_STRIDE + 64 + gq * 16);
  const float slope = exp2f(-8.f * (float)(n + 1) / 12.f) * (float)d;
  float pv[10][4];
  float dsum = 0.f;
#pragma unroll
  for (int t = 0; t < 10; ++t) {
    const unsigned char* kp = Ks + ((w + t) * 16 + dl) * KS_STRIDE + gq * 16;
    f32x4 sacc = {0.f, 0.f, 0.f, 0.f};
    sacc = __builtin_amdgcn_mfma_f32_16x16x32_bf16(*(const bf16x8*)kp, qf0, sacc, 0, 0, 0);
    sacc = __builtin_amdgcn_mfma_f32_16x16x32_bf16(*(const bf16x8*)(kp + 64), qf1, sacc, 0, 0, 0);
#pragma unroll
    for (int j = 0; j < 4; ++j) {
      const int m = 16 * t + 4 * gq + j - dl;
      const int kr = (w + t) * 16 + 4 * gq + j;
      const int pos = d * (i0 - 64 + kr) + r;
      const bool ok = m >= 0 && m <= 128 && pos >= 0 && pos < slen;
      const float e = ok ? __expf(sacc[j] - slope * fabsf((float)(m - 64))) : 0.f;
      pv[t][j] = e; dsum += e;
    }
  }
  f32x4 oacc[4];
#pragma unroll
  for (int dt = 0; dt < 4; ++dt) oacc[dt] = (f32x4){0.f, 0.f, 0.f, 0.f};
#pragma unroll
  for (int u = 0; u < 5; ++u) {
    union { bf16x8 v; unsigned uu[4]; } pb;
    pb.uu[0] = pack2(pv[2 * u][0], pv[2 * u][1]); pb.uu[1] = pack2(pv[2 * u][2], pv[2 * u][3]);
    pb.uu[2] = pack2(pv[2 * u + 1][0], pv[2 * u + 1][1]); pb.uu[3] = pack2(pv[2 * u + 1][2], pv[2 * u + 1][3]);
#pragma unroll
    for (int dt = 0; dt < 4; ++dt) {
      const unsigned char* vp = Vt + (dt * 16 + dl) * VT_STRIDE + ((w + 2 * u) * 16 + 4 * gq) * 2;
      union { bf16x8 v; uint2 h2[2]; } va;
      va.h2[0] = *(const uint2*)vp; va.h2[1] = *(const uint2*)(vp + 32);
      oacc[dt] = __builtin_amdgcn_mfma_f32_16x16x32_bf16(va.v, pb.v, oacc[dt], 0, 0, 0);
    }
  }
  dsum += __shfl_xor(dsum, 16); dsum += __shfl_xor(dsum, 32);
  {
    const int ql = 16 * w + dl;
    const size_t tok = (size_t)(sstart + d * (i0 + ql) + r);
    bf16_t* np = p.pnum + (size_t)g * ((size_t)MTOK * 256) + (tok * 4 + h) * 64 + 4 * gq;
#pragma unroll
    for (int dt = 0; dt < 4; ++dt) { uint2 o; o.x = pack2(oacc[dt][0], oacc[dt][1]); o.y = pack2(oacc[dt][2], oacc[dt][3]); *(uint2*)(np + dt * 16) = o; }
    if (gq == 0) p.pden[(size_t)g * ((size_t)MTOK * 4) + tok * 4 + h] = dsum;
  }
  __syncthreads();
}

__device__ void attn_combine(const Params& p) {
  const size_t nvec = (size_t)MTOK * 64;
  for (size_t i = (size_t)blockIdx.x * 256 + get_tid(); i < nvec; i += (size_t)gridDim.x * 256) {
    const size_t th = i >> 4;
    const int e4 = (int)(i & 15);
    f32x4 a, b, c;
    { const uint2 u0 = *(const uint2*)(p.pnum + i * 4), u1 = *(const uint2*)(p.pnum + (size_t)MTOK * 256 + i * 4), u2 = *(const uint2*)(p.pnum + 2 * (size_t)MTOK * 256 + i * 4);
      a[0] = __uint_as_float(u0.x << 16); a[1] = __uint_as_float(u0.x & 0xffff0000u); a[2] = __uint_as_float(u0.y << 16); a[3] = __uint_as_float(u0.y & 0xffff0000u);
      b[0] = __uint_as_float(u1.x << 16); b[1] = __uint_as_float(u1.x & 0xffff0000u); b[2] = __uint_as_float(u1.y << 16); b[3] = __uint_as_float(u1.y & 0xffff0000u);
      c[0] = __uint_as_float(u2.x << 16); c[1] = __uint_as_float(u2.x & 0xffff0000u); c[2] = __uint_as_float(u2.y << 16); c[3] = __uint_as_float(u2.y & 0xffff0000u); }
    const float den = p.pden[th] + p.pden[(size_t)MTOK * 4 + th] + p.pden[2 * (size_t)MTOK * 4 + th];
    const float inv = 1.f / den;
    const size_t tok = th >> 2; const int h = (int)(th & 3);
    bf16_t* y = p.ys + tok * 1024 + h * 64 + e4 * 4;
    uint2 yv = *(const uint2*)y;
    float y0 = __uint_as_float(yv.x << 16), y1 = __uint_as_float(yv.x & 0xffff0000u), y2 = __uint_as_float(yv.y << 16), y3 = __uint_as_float(yv.y & 0xffff0000u);
    uint2 o; o.x = pack2(y0 * (a[0] + b[0] + c[0]) * inv, y1 * (a[1] + b[1] + c[1]) * inv); o.y = pack2(y2 * (a[2] + b[2] + c[2]) * inv, y3 * (a[3] + b[3] + c[3]) * inv);
    if (!DRY(p)) *(uint2*)y = o;
  }
}

__device__ void pool_item(const Params& p, int layer, int item, unsigned char* smem) {
  const int tid = get_tid(), lane = tid & 63, wave = tid >> 6, dl = lane & 15, gq = lane >> 4;
  const int g = item & 3, T0 = (item >> 2) * 64;
  int sstart, slen; seq_of(T0, sstart, slen);
  const int P0 = T0 - sstart;
  const int hw = 1 << g;
  float* u = (float*)smem;
  bf16_t* db = (bf16_t*)(u + 80 * 64);
  for (int i = tid; i < 80 * 64; i += 256) {
    const int rr = i >> 6, c = i & 63, pos = P0 - 8 + rr;
    u[i] = (pos >= 0 && pos < slen) ? bf2f(p.rest[(size_t)(sstart + pos) * RESTW + g * 64 + c]) : 0.f;
  }
  const float* pw = p.pool_w + ((size_t)layer * 4 + g) * 4096 + 16 * wave + dl;
  bf16x8 af[2];
#pragma unroll
  for (int ks = 0; ks < 2; ++ks) {
    union { bf16x8 v; unsigned uu[4]; } f;
#pragma unroll
    for (int e = 0; e < 4; ++e) { const int c = ks * 32 + gq * 8 + 2 * e; f.uu[e] = pack2(pw[c * 64], pw[(c + 1) * 64]); }
    af[ks] = f.v;
  }
  __syncthreads();
  for (int i = tid; i < 64 * 64; i += 256) {
    const int t = i >> 6, c = i & 63, pos = P0 + t;
    float sm = 0.f;
    for (int o = -hw; o < hw; ++o) sm += u[(t + 8 + o) * 64 + c];
    const int lo = pos - hw > 0 ? pos - hw : 0, hi = pos + hw < slen ? pos + hw : slen;
    db[t * 72 + c] = f2bf(sm / (float)(hi - lo) - u[(t + 8) * 64 + c]);
  }
  __syncthreads();
  const f32x4 sc = *(const f32x4*)(p.pool_scale + layer * 256 + g * 64 + 16 * wave + 4 * gq);
#pragma unroll
  for (int tt = 0; tt < 4; ++tt) {
    f32x4 acc = {0.f, 0.f, 0.f, 0.f};
#pragma unroll
    for (int ks = 0; ks < 2; ++ks) {
      const bf16x8 bd = *(const bf16x8*)(db + (tt * 16 + dl) * 72 + ks * 32 + gq * 8);
      acc = __builtin_amdgcn_mfma_f32_16x16x32_bf16(af[ks], bd, acc, 0, 0, 0);
    }
    bf16_t* y = p.ys + (size_t)(T0 + tt * 16 + dl) * 1024 + 256 + g * 64 + 16 * wave + 4 * gq;
    const uint2 yv = *(const uint2*)y;
    uint2 o;
    o.x = pack2(__uint_as_float(yv.x << 16) * acc[0] * sc[0], __uint_as_float(yv.x & 0xffff0000u) * acc[1] * sc[1]);
    o.y = pack2(__uint_as_float(yv.y << 16) * acc[2] * sc[2], __uint_as_float(yv.y & 0xffff0000u) * acc[3] * sc[3]);
    if (!DRY(p)) *(uint2*)y = o;
  }
  __syncthreads();
}

__device__ void sg_item(const Params& p, int layer, int item, unsigned char* smem) {
  const int tid = get_tid(), lane = tid & 63, wave = tid >> 6, dl = lane & 15, gq = lane >> 4;
  const int g = item & 3, T0 = (item >> 2) * 128;
  bf16_t* vnT = (bf16_t*)smem;
  for (int s_ = wave; s_ < 128; s_ += 4) {
    const bf16_t* vr = p.rest + (size_t)(T0 + s_) * RESTW + 512;
    float ss = 0.f; float mine = 0.f;
#pragma unroll
    for (int j = 0; j < 4; ++j) { float v = bf2f(vr[j * 64 + lane]); ss += v * v; if (j == g) mine = v; }
    ss = wave_sum(ss);
    const float rs = rsqrtf(ss * (1.f / 256.f) + 1e-6f);
    vnT[lane * 136 + s_] = f2bf(mine * rs * p.sg_norm_g[layer * 256 + g * 64 + lane]);
  }
  __syncthreads();
  const float* gw = p.sg_w + ((size_t)layer * 4 + g) * 128 * 128;
#pragma unroll 1
  for (int tt2 = 0; tt2 < 2; ++tt2) {
    const int t = (wave * 2 + tt2) * 16 + dl;
    const float* wrow = gw + t * 128 + gq * 8;
    f32x4 acc[4];
#pragma unroll
    for (int dt = 0; dt < 4; ++dt) acc[dt] = (f32x4){0.f, 0.f, 0.f, 0.f};
#pragma unroll
    for (int ks = 0; ks < 4; ++ks) {
      const f32x4 w0 = *(const f32x4*)(wrow + ks * 32), w1 = *(const f32x4*)(wrow + ks * 32 + 4);
      union { bf16x8 v; unsigned uu[4]; } bw;
      bw.uu[0] = pack2(w0[0], w0[1]); bw.uu[1] = pack2(w0[2], w0[3]); bw.uu[2] = pack2(w1[0], w1[1]); bw.uu[3] = pack2(w1[2], w1[3]);
#pragma unroll
      for (int dt = 0; dt < 4; ++dt) {
        const bf16x8 av = *(const bf16x8*)(vnT + (dt * 16 + dl) * 136 + ks * 32 + gq * 8);
        acc[dt] = __builtin_amdgcn_mfma_f32_16x16x32_bf16(av, bw.v, acc[dt], 0, 0, 0);
      }
    }
    const float bias = p.sg_b[(layer * 4 + g) * 128 + t];
#pragma unroll
    for (int dt = 0; dt < 4; ++dt) {
      const int d0 = dt * 16 + 4 * gq;
      const uint2 uv = *(const uint2*)(p.rest + (size_t)(T0 + t) * RESTW + 256 + g * 64 + d0);
      bf16_t* y = p.ys + (size_t)(T0 + t) * 1024 + 512 + g * 64 + d0;
      const uint2 yv = *(const uint2*)y;
      uint2 o;
      o.x = pack2(__uint_as_float(yv.x << 16) * __uint_as_float(uv.x << 16) * (acc[dt][0] + bias), __uint_as_float(yv.x & 0xffff0000u) * __uint_as_float(uv.x & 0xffff0000u) * (acc[dt][1] + bias));
      o.y = pack2(__uint_as_float(yv.y << 16) * __uint_as_float(uv.y << 16) * (acc[dt][2] + bias), __uint_as_float(yv.y & 0xffff0000u) * __uint_as_float(uv.y & 0xffff0000u) * (acc[dt][3] + bias));
      if (!DRY(p)) *(uint2*)y = o;
    }
  }
  __syncthreads();
}

constexpr int SBT = 16;
struct RwkvLds {
  bf16_t twb[SBT * 72], tab[SBT * 72];
  float accw[SBT * 64], acca[SBT * 64];
  float R[SBT * 64], W[SBT * 64], K[SBT * 64], V[SBT * 64], KK[SBT * 64], B[SBT * 64];
  float ot[SBT * 64];
  float bon[SBT * 64];
};

__device__ __forceinline__ float red8(float v) { v += dpp_qx1(v); v += dpp_qx2(v); v += dpp_hm(v); return v; }
__device__ __forceinline__ float red16(float v) { v = red8(v); v += __int_as_float(__builtin_amdgcn_update_dpp(0, __float_as_int(v), 0x140, 0xF, 0xF, true)); return v; }

struct ScanOps { f32x4 w0, w1, b0, b1, kk0, kk1, k0, k1, r0, r1; float2 v; };
template <bool PASS_C>
__device__ __forceinline__ ScanOps load_ops(const RwkvLds& L, int tk, int j0, int row0) {
  ScanOps o;
  o.w0 = *(const f32x4*)(L.W + tk * 64 + j0); o.w1 = *(const f32x4*)(L.W + tk * 64 + j0 + 4);
  o.b0 = *(const f32x4*)(L.B + tk * 64 + j0); o.b1 = *(const f32x4*)(L.B + tk * 64 + j0 + 4);
  o.kk0 = *(const f32x4*)(L.KK + tk * 64 + j0); o.kk1 = *(const f32x4*)(L.KK + tk * 64 + j0 + 4);
  o.k0 = *(const f32x4*)(L.K + tk * 64 + j0); o.k1 = *(const f32x4*)(L.K + tk * 64 + j0 + 4);
  if (PASS_C) { o.r0 = *(const f32x4*)(L.R + tk * 64 + j0); o.r1 = *(const f32x4*)(L.R + tk * 64 + j0 + 4); }
  else { o.r0 = o.w0; o.r1 = o.w1; }
  o.v = *(const float2*)(L.V + tk * 64 + row0);
  return o;
}

#define RAW_LOAD(SBI) { _Pragma("unroll") for (int i = 0; i < 4; ++i) { \
      const int tau = (SBI) * SBT + wave * 4 + i; \
      const int t = dir ? (t0 + 127 - tau) : (t0 + tau); \
      const bf16_t* cr = p.rest + (size_t)t * RESTW; \
      raw[i][0] = cr[768 + cidx]; raw[i][1] = cr[1024 + cidx]; raw[i][2] = cr[1280 + cidx]; raw[i][3] = cr[1536 + dir * 128 + lane]; raw[i][4] = cr[1536 + dir * 128 + 64 + lane]; \
      if (i == 0) { const int tp = dir ? t + 1 : t - 1; const bool pv = tp >= sstart && tp < send; const bf16_t* pr = p.rest + (size_t)(pv ? tp : t) * RESTW; \
        rawp[0] = pv ? pr[768 + cidx] : (bf16_t)0; rawp[1] = pv ? pr[1024 + cidx] : (bf16_t)0; rawp[2] = pv ? pr[1280 + cidx] : (bf16_t)0; \
        rawp[3] = pv ? pr[1536 + dir * 128 + lane] : (bf16_t)0; rawp[4] = pv ? pr[1536 + dir * 128 + 64 + lane] : (bf16_t)0; } } }

template <bool PASS_C>
__device__ void rwkv_job(const Params& p, int layer, int job, unsigned char* smem) {
  RwkvLds& L = *(RwkvLds*)smem;
  const int tid = get_tid(), lane = tid & 63, wave = tid >> 6;
  const int hd = job & 3, cp = job >> 2, t0 = cp * 128;
  int sstart, slen; seq_of(t0, sstart, slen);
  const int send = sstart + slen;
  const int rp = tid >> 3, jg = tid & 7, row0 = rp * 2, j0 = jg * 8;
  float* ytg0 = p.pg + ((size_t)cp * 8 + hd) * 8192;
  float* ytg1 = p.pg + ((size_t)cp * 8 + 4 + hd) * 8192;
#pragma unroll 1
  for (int dir = 0; dir < 2; ++dir) {
    const int ld = layer * 2 + dir;
    float* slot = p.pg + ((size_t)cp * 8 + dir * 4 + hd) * 8192;
    __syncthreads();
    bf16x8 wfr[2], afr[2];
    {
      const int dl_ = lane & 15, gq_ = lane >> 4;
      const float* wsrc = p.w_up + (size_t)ld * 64 * 256 + hd * 64 + 16 * wave + dl_;
      const float* asrc = p.a_up + (size_t)ld * 64 * 256 + hd * 64 + 16 * wave + dl_;
#pragma unroll
      for (int ks = 0; ks < 2; ++ks) {
        union { bf16x8 v; unsigned u[4]; } fw, fa;
#pragma unroll
        for (int e = 0; e < 4; ++e) {
          const int m = ks * 32 + gq_ * 8 + 2 * e;
          fw.u[e] = pack2(wsrc[(size_t)m * 256], wsrc[(size_t)(m + 1) * 256]);
          fa.u[e] = pack2(asrc[(size_t)m * 256], asrc[(size_t)(m + 1) * 256]);
        }
        wfr[ks] = fw.v; afr[ks] = fa.v;
      }
    }
    f32x2 S[2][4], Pst[2][4];
#pragma unroll
    for (int rr = 0; rr < 2; ++rr)
#pragma unroll
      for (int q = 0; q < 4; ++q) {
        if (PASS_C) { S[rr][q] = *(const f32x2*)(slot + 4096 + (row0 + rr) * 64 + j0 + 2 * q); Pst[rr][q] = (f32x2){0.f, 0.f}; }
        else { S[rr][q] = (f32x2){0.f, 0.f}; Pst[rr][q] = (f32x2){(row0 + rr == j0 + 2 * q) ? 1.f : 0.f, (row0 + rr == j0 + 2 * q + 1) ? 1.f : 0.f}; }
      }
    const int cidx = hd * 64 + lane;
    const float mu_r = p.mu_rkv[ld * 768 + cidx], mu_k = p.mu_rkv[ld * 768 + 256 + cidx], mu_v = p.mu_rkv[ld * 768 + 512 + cidx];
    const float mu_w = p.mu_lat[ld * 128 + lane], mu_a = p.mu_lat[ld * 128 + 64 + lane];
    const float w0v = p.w0[ld * 256 + cidx], a0v = p.a0[ld * 256 + cidx];
    const float kkv = p.k_k[ld * 256 + cidx], kav = p.k_a[ld * 256 + cidx], rkv_ = p.r_k[ld * 256 + cidx];
    bf16_t raw[4][5], rawp[5];
    RAW_LOAD(0)
#pragma unroll 1
    for (int sb = 0; sb < 128 / SBT; ++sb) {
      __syncthreads();
#pragma unroll
      for (int i = 0; i < 4; ++i) {
        const int tk = wave * 4 + i;
        const float cr_r = bf2f(raw[i][0]), cr_k = bf2f(raw[i][1]), cr_v = bf2f(raw[i][2]), cr_w = bf2f(raw[i][3]), cr_a = bf2f(raw[i][4]);
        const float pr_r = bf2f(i ? raw[i ? i - 1 : 0][0] : rawp[0]), pr_k = bf2f(i ? raw[i ? i - 1 : 0][1] : rawp[1]), pr_v = bf2f(i ? raw[i ? i - 1 : 0][2] : rawp[2]);
        const float pr_w = bf2f(i ? raw[i ? i - 1 : 0][3] : rawp[3]), pr_a = bf2f(i ? raw[i ? i - 1 : 0][4] : rawp[4]);
        L.R[tk * 64 + lane] = cr_r + (pr_r - cr_r) * mu_r;
        L.K[tk * 64 + lane] = cr_k + (pr_k - cr_k) * mu_k;
        L.V[tk * 64 + lane] = cr_v + (pr_v - cr_v) * mu_v;
        { const float xw = cr_w + (pr_w - cr_w) * mu_w; L.twb[tk * 72 + lane] = f2bf(1.f - 2.f * __builtin_amdgcn_rcpf(1.f + __expf(2.f * xw))); }
        L.tab[tk * 72 + lane] = f2bf(cr_a + (pr_a - cr_a) * mu_a);
      }
      if (sb + 1 < 128 / SBT) RAW_LOAD(sb + 1)
      __syncthreads();
      {
        const int dl_ = lane & 15, gq_ = lane >> 4;
        f32x4 dw = {0.f, 0.f, 0.f, 0.f}, da = {0.f, 0.f, 0.f, 0.f};
#pragma unroll
        for (int ks = 0; ks < 2; ++ks) {
          const bf16x8 bw = *(const bf16x8*)(L.twb + dl_ * 72 + ks * 32 + gq_ * 8);
          const bf16x8 ba = *(const bf16x8*)(L.tab + dl_ * 72 + ks * 32 + gq_ * 8);
          dw = __builtin_amdgcn_mfma_f32_16x16x32_bf16(wfr[ks], bw, dw, 0, 0, 0);
          da = __builtin_amdgcn_mfma_f32_16x16x32_bf16(afr[ks], ba, da, 0, 0, 0);
        }
        *(f32x4*)(L.accw + dl_ * 64 + 16 * wave + 4 * gq_) = dw;
        *(f32x4*)(L.acca + dl_ * 64 + 16 * wave + 4 * gq_) = da;
      }
      __syncthreads();
      float accw[4], acca[4];
#pragma unroll
      for (int i = 0; i < 4; ++i) { accw[i] = L.accw[(wave * 4 + i) * 64 + lane]; acca[i] = L.acca[(wave * 4 + i) * 64 + lane]; }
#pragma unroll
      for (int i = 0; i < 4; ++i) {
        const int tk = wave * 4 + i;
        const float wpre = w0v + accw[i];
        const float nx = -wpre;
        const float sp = fmaxf(nx, 0.f) + __logf(1.f + __expf(-fabsf(nx)));
        const float wlog = -sp - 0.5f;
        const float decay = __expf(-__expf(wlog));
        const float a = sigmoidf_(a0v + acca[i]);
        const float k = L.K[tk * 64 + lane], r = L.R[tk * 64 + lane], v = L.V[tk * 64 + lane];
        float kk = k * kkv;
        const float ss = wave_sum(kk * kk);
        kk *= rsqrtf(ss + 1e-12f);
        const float k2 = k * (1.f + (a - 1.f) * kav);
        L.W[tk * 64 + lane] = decay; L.K[tk * 64 + lane] = k2; L.KK[tk * 64 + lane] = kk; L.B[tk * 64 + lane] = kk * a;
        if (PASS_C) { const float bs = wave_sum(r * k2 * rkv_); L.bon[tk * 64 + lane] = bs * v; }
      }
      __syncthreads();
      ScanOps cur = load_ops<PASS_C>(L, 0, j0, row0);
#pragma unroll 4
      for (int tk = 0; tk < SBT; ++tk) {
        const ScanOps nx = load_ops<PASS_C>(L, (tk + 1) & (SBT - 1), j0, row0);
        const f32x2 w2[4] = {cur.w0.lo, cur.w0.hi, cur.w1.lo, cur.w1.hi};
        const f32x2 b2[4] = {cur.b0.lo, cur.b0.hi, cur.b1.lo, cur.b1.hi};
        const f32x2 kk2[4] = {cur.kk0.lo, cur.kk0.hi, cur.kk1.lo, cur.kk1.hi};
        const f32x2 k2[4] = {cur.k0.lo, cur.k0.hi, cur.k1.lo, cur.k1.hi};
        const float vr[2] = {cur.v.x, cur.v.y};
        float sa[2], sp[2] = {0.f, 0.f};
#pragma unroll
        for (int rr = 0; rr < 2; ++rr) {
          f32x2 a = S[rr][0] * kk2[0];
          a += S[rr][1] * kk2[1]; a += S[rr][2] * kk2[2]; a += S[rr][3] * kk2[3];
          sa[rr] = a.x + a.y;
          if (!PASS_C) {
            f32x2 q_ = Pst[rr][0] * kk2[0];
            q_ += Pst[rr][1] * kk2[1]; q_ += Pst[rr][2] * kk2[2]; q_ += Pst[rr][3] * kk2[3];
            sp[rr] = q_.x + q_.y;
          }
        }
        sa[0] = red8(sa[0]); sa[1] = red8(sa[1]);
        if (!PASS_C) { sp[0] = red8(sp[0]); sp[1] = red8(sp[1]); }
#pragma unroll
        for (int rr = 0; rr < 2; ++rr)
#pragma unroll
          for (int q = 0; q < 4; ++q) {
            S[rr][q] = S[rr][q] * w2[q] + (k2[q] * vr[rr] - b2[q] * sa[rr]);
            if (!PASS_C) Pst[rr][q] = Pst[rr][q] * w2[q] - b2[q] * sp[rr];
          }
        if (PASS_C) {
          const f32x2 r2[4] = {cur.r0.lo, cur.r0.hi, cur.r1.lo, cur.r1.hi};
          f32x2 oa = S[0][0] * r2[0]; oa += S[0][1] * r2[1]; oa += S[0][2] * r2[2]; oa += S[0][3] * r2[3];
          f32x2 ob = S[1][0] * r2[0]; ob += S[1][1] * r2[1]; ob += S[1][2] * r2[2]; ob += S[1][3] * r2[3];
          float o0 = red8(oa.x + oa.y), o1 = red8(ob.x + ob.y);
          if (jg == 0) { L.ot[tk * 64 + row0] = o0; L.ot[tk * 64 + row0 + 1] = o1; }
        }
        cur = nx;
      }
      if (PASS_C) {
        __syncthreads();
        const int x = tid >> 4, part = tid & 15;
        const int tk = dir ? (SBT - 1 - x) : x, tau = sb * SBT + tk;
        const int tl = dir ? (127 - tau) : tau;
        const f32x4 ov = *(const f32x4*)(L.ot + tk * 64 + part * 4);
        float o[4] = {ov[0], ov[1], ov[2], ov[3]};
        float s1 = red16(o[0] + o[1] + o[2] + o[3]);
        const float mu = s1 * (1.f / 64.f);
        float s2 = 0.f;
#pragma unroll
        for (int e = 0; e < 4; ++e) { o[e] -= mu; s2 += o[e] * o[e]; }
        s2 = red16(s2);
        const float rs = rsqrtf(s2 * (1.f / 64.f) + 64e-5f);
        const int ch = hd * 64 + part * 4;
        const f32x4 lg = *(const f32x4*)(p.ln_g + layer * 256 + ch), lb = *(const f32x4*)(p.ln_b + layer * 256 + ch);
        const f32x4 bo = *(const f32x4*)(L.bon + tk * 64 + part * 4);
        f32x4 y;
#pragma unroll
        for (int e = 0; e < 4; ++e) y[e] = o[e] * rs * lg[e] + lb[e] + bo[e];
        float* yg = (tl < 64 ? ytg0 + tl * 64 : ytg1 + (tl - 64) * 64) + part * 4;
        if (dir == 0) *(f32x4*)yg = y;
        else {
          const f32x4 y0 = *(const f32x4*)yg;
          bf16_t* yp = p.ys + (size_t)(t0 + tl) * 1024 + 768 + ch;
          const uint2 yv = *(const uint2*)yp;
          uint2 ov2;
          ov2.x = pack2(__uint_as_float(yv.x << 16) * (y[0] + y0[0]), __uint_as_float(yv.x & 0xffff0000u) * (y[1] + y0[1]));
          ov2.y = pack2(__uint_as_float(yv.y << 16) * (y[2] + y0[2]), __uint_as_float(yv.y & 0xffff0000u) * (y[3] + y0[3]));
          if (!DRY(p)) *(uint2*)yp = ov2;
        }
      }
    }
    if (!PASS_C) {
#pragma unroll
      for (int rr = 0; rr < 2; ++rr)
#pragma unroll
        for (int q = 0; q < 4; ++q) { *(f32x2*)(slot + (row0 + rr) * 64 + j0 + 2 * q) = Pst[rr][q]; *(f32x2*)(slot + 4096 + (row0 + rr) * 64 + j0 + 2 * q) = S[rr][q]; }
    }
  }
  __syncthreads();
}

__device__ void rwkv_passB(const Params& p, unsigned char* smem) {
  float* Pl = (float*)smem;
  float* Sl = Pl + 2 * 4096;
  const int tid = get_tid();
  for (int wk = blockIdx.x; wk < 128; wk += gridDim.x) {
    const int rg = wk & 3, hd = (wk >> 2) & 3, dir = (wk >> 4) & 1, seq = wk >> 5;
    const int cbase = seq == 0 ? 0 : seq == 1 ? 64 : seq == 2 ? 128 : 256;
    const int nch = seq < 2 ? 64 : 128;
    const int row = tid >> 4, jq = tid & 15;
    __syncthreads();
    for (int i = tid; i < 2 * 16 * 64; i += 256) Sl[i] = 0.f;
    float4 pf0, pf1, pf2, pf3, gf;
    {
      const int c = dir ? nch - 1 : 0;
      const float* slot = p.pg + ((size_t)(cbase + c) * 8 + dir * 4 + hd) * 8192;
      pf0 = ((const float4*)slot)[tid]; pf1 = ((const float4*)slot)[tid + 256]; pf2 = ((const float4*)slot)[tid + 512]; pf3 = ((const float4*)slot)[tid + 768];
      gf = *(const float4*)(slot + 4096 + (rg * 16 + row) * 64 + jq * 4);
    }
#pragma unroll 1
    for (int ci = 0; ci < nch; ++ci) {
      const int c = dir ? nch - 1 - ci : ci;
      float* slot = p.pg + ((size_t)(cbase + c) * 8 + dir * 4 + hd) * 8192;
      float* Pb = Pl + (ci & 1) * 4096;
      ((float4*)Pb)[tid] = pf0; ((float4*)Pb)[tid + 256] = pf1; ((float4*)Pb)[tid + 512] = pf2; ((float4*)Pb)[tid + 768] = pf3;
      float* gp = slot + 4096 + (rg * 16 + row) * 64 + jq * 4;
      float4 acc = gf;
      if (ci + 1 < nch) {
        const int c2 = dir ? nch - 2 - ci : ci + 1;
        const float* s2 = p.pg + ((size_t)(cbase + c2) * 8 + dir * 4 + hd) * 8192;
        pf0 = ((const float4*)s2)[tid]; pf1 = ((const float4*)s2)[tid + 256]; pf2 = ((const float4*)s2)[tid + 512]; pf3 = ((const float4*)s2)[tid + 768];
        gf = *(const float4*)(s2 + 4096 + (rg * 16 + row) * 64 + jq * 4);
      }
      __syncthreads();
      const float* Sc = Sl + (ci & 1) * 1024;
      const float4 sold = *(const float4*)(Sc + row * 64 + jq * 4);
#pragma unroll 4
      for (int m4 = 0; m4 < 16; ++m4) {
        const float4 s4 = *(const float4*)(Sc + row * 64 + m4 * 4);
        const float sv[4] = {s4.x, s4.y, s4.z, s4.w};
#pragma unroll
        for (int e = 0; e < 4; ++e) {
          const float4 pv = *(const float4*)(Pb + (m4 * 4 + e) * 64 + jq * 4);
          acc.x += sv[e] * pv.x; acc.y += sv[e] * pv.y; acc.z += sv[e] * pv.z; acc.w += sv[e] * pv.w;
        }
      }
      if (!DRY(p)) *(float4*)gp = sold;
      *(float4*)(Sl + ((ci + 1) & 1) * 1024 + row * 64 + jq * 4) = acc;
    }
  }
}

__device__ void phase_bmix(const Params& p, int layer, unsigned char* smem) {
  const int NA = 9216, NS = 1536, NP = 3072;
  const bool weighted = gridDim.x == 512;
  if (!weighted || blockIdx.x < 128) { __builtin_amdgcn_s_setprio(3); rwkv_passB(p, smem); __builtin_amdgcn_s_setprio(0); }
  int first, cnt, stride;
  if (weighted) {
    if (blockIdx.x >= 128) { first = (blockIdx.x - 128) * 24; cnt = 24; } else { first = 0; cnt = 0; }
    stride = 1;
  } else { first = blockIdx.x; stride = gridDim.x; cnt = (NA - first + stride - 1) / stride; if (first >= NA) cnt = 0; }
  if (cnt > 0) {
    AttnRaw R;
    attn_issue(p, first, R);
#pragma unroll 1
    for (int k = 0; k < cnt; ++k) attn_item(p, layer, first + k * stride, R, k + 1 < cnt ? first + (k + 1) * stride : -1, smem);
  }
  const int b0 = (int)blockIdx.x, bs = (int)gridDim.x;
  if (b0 >= 0) {
#pragma unroll 1
    for (int it = b0; it < NS + NP; it += bs) {
      if (it < NS) sg_item(p, layer, it, smem);
      else pool_item(p, layer, it - NS, smem);
    }
  }
}

#define XB_TMO      128
#define XB_XCNT(j)  (256  + 64 * (j))
#define XB_XSUB(j)  (1280 + 64 * (j))
#define XB_XGEN(j)  (2304 + 64 * (j))
#define XB_TOP      3328
#define XB_TOPGEN   3392
#define XCD_BAR_WORDS 3456
#define XB_SPIN_CAP (1u << 22)
__device__ __forceinline__ unsigned xb_ld(unsigned* q)              { return __hip_atomic_load(q, __ATOMIC_RELAXED, __HIP_MEMORY_SCOPE_AGENT); }
__device__ __forceinline__ unsigned xb_add(unsigned* q, unsigned v) { return __hip_atomic_fetch_add(q, v, __ATOMIC_RELAXED, __HIP_MEMORY_SCOPE_AGENT); }
__device__ __forceinline__ unsigned xb_xcc_id() { return (unsigned)__builtin_amdgcn_s_getreg((3 << 11) | 20) & 0xFu; }
#define XB_SPIN(cond, bar) do { unsigned _sp = 0; while (cond) { __builtin_amdgcn_s_sleep(1); \
    if ((++_sp & 255u) == 0u) { if (xb_ld(&(bar)[XB_TMO])) break; if (_sp > XB_SPIN_CAP) { atomicAdd(&(bar)[XB_TMO], 1u); break; } } } } while (0)
struct XcdBarrier { unsigned* bar; unsigned x; volatile LAS unsigned* st; };
__device__ __forceinline__ XcdBarrier xcd_barrier_post(unsigned* bar, volatile LAS unsigned* st) {
  XcdBarrier b; b.bar = bar; b.x = xb_xcc_id(); b.st = st;
  if (threadIdx.x == 0) (void)xb_add(&bar[XB_XCNT(b.x)], 1u);
  return b;
}
__device__ __forceinline__ void xcd_barrier_complete(unsigned* bar, unsigned x, unsigned& nloc, unsigned& nx) {
  const unsigned G = gridDim.x * gridDim.y * gridDim.z;
  unsigned sum, cnt, mine, sp = 0u;
  for (;;) {
    sum = 0u; cnt = 0u; mine = 0u;
#pragma unroll
    for (unsigned j = 0; j < 16; ++j) { const unsigned c = xb_ld(&bar[XB_XCNT(j)]); sum += c; cnt += (c > 0u) ? 1u : 0u; mine = (j == x) ? c : mine; }
    if (sum == G) break;
    __builtin_amdgcn_s_sleep(1);
    if ((++sp & 255u) == 0u) { if (xb_ld(&bar[XB_TMO])) break; if (sp > XB_SPIN_CAP) { atomicAdd(&bar[XB_TMO], 1u); break; } }
  }
  nloc = mine > 0u ? mine : 1u; nx = cnt > 0u ? cnt : 1u;
}
__device__ __forceinline__ void xcd_barrier(const XcdBarrier& b) {
  asm volatile("s_waitcnt vmcnt(0)" ::: "memory");
  __syncthreads();
  if (threadIdx.x == 0) {
    unsigned* bar = b.bar;
    __builtin_amdgcn_s_waitcnt(0);
    unsigned nloc = b.st[0], nx = b.st[1];
    if (nloc == 0u) { xcd_barrier_complete(bar, b.x, nloc, nx); b.st[0] = nloc; b.st[1] = nx; }
    const unsigned old = xb_add(&bar[XB_XSUB(b.x)], 1u);
    const unsigned gen = old / nloc;
    if (old + 1u == (gen + 1u) * nloc) {
      __builtin_amdgcn_fence(__ATOMIC_RELEASE, "agent");
      asm volatile("s_waitcnt vmcnt(0)" ::: "memory");
      const unsigned og = xb_add(&bar[XB_TOP], 1u);
      const unsigned tg = og / nx;
      if (og + 1u == (tg + 1u) * nx) xb_add(&bar[XB_TOPGEN], 1u);
      else XB_SPIN(xb_ld(&bar[XB_TOPGEN]) == tg, bar);
      __builtin_amdgcn_fence(__ATOMIC_ACQUIRE, "agent");
      xb_add(&bar[XB_XGEN(b.x)], 1u);
      asm volatile("s_waitcnt vmcnt(0)" ::: "memory");
    } else {
      XB_SPIN(xb_ld(&bar[XB_XGEN(b.x)]) == gen, bar);
      __builtin_amdgcn_fence(__ATOMIC_ACQUIRE, "agent");
      asm volatile("s_waitcnt vmcnt(0)" ::: "memory");
    }
  }
  __syncthreads();
}

__device__ __forceinline__ void run_phase(const Params& p, int layer, int sub, unsigned char* smem) {
  switch (sub) {
    case 0: phase_prep(p, layer, smem); break;
    case 1: phase_g1(p, layer, smem); break;
    case 2: for (int j = blockIdx.x; j < 1536; j += gridDim.x) rwkv_job<false>(p, layer, j, smem); break;
    case 3: phase_bmix(p, layer, smem); break;
    case 4: for (int j = blockIdx.x; j < 1536; j += gridDim.x) rwkv_job<true>(p, layer, j, smem); attn_combine(p); break;
    case 5: phase_branch(p, smem); break;
    case 6: phase_gate(p, layer, smem); break;
    case 7: phase_out(p, layer, smem); break;
  }
}
__global__ void __launch_bounds__(256, 2) mega(Params p) {
  extern __shared__ __attribute__((aligned(16))) unsigned char smem[];
  cg::grid_group grid = cg::this_grid();
  volatile LAS unsigned* bst = (volatile LAS unsigned*)((LAS unsigned char*)smem + 73728);
  if (threadIdx.x < 4) bst[threadIdx.x] = 0u;
  __syncthreads();
  const XcdBarrier xbar = xcd_barrier_post(p.bar, bst);
  for (int ph = p.phase_lo; ph < p.phase_hi; ++ph) {
    const int layer = ph / NPH, sub = ph % NPH;
#if PROBE_MASK
    for (int rep = (PROBE_MASK >> sub) & 1; rep >= 0; --rep) {
      __syncthreads(); if (get_tid() == 0) s_dry = rep; __syncthreads();
      run_phase(p, layer, sub, smem);
      if (rep) grid.sync();
    }
#else
    run_phase(p, layer, sub, smem);
#endif
    if (ph + 1 < p.phase_hi) { if (ph == p.phase_lo) grid.sync(); else xcd_barrier(xbar); }
  }
}

extern "C" void kernel_launch(void* const* d_in, const int* in_sizes, int n_in, void* d_out, int out_size, void* d_ws, size_t ws_size, hipStream_t stream) {
  static int grid_blocks = 0;
  if (!grid_blocks) {
    hipFuncSetAttribute((const void*)mega, hipFuncAttributeMaxDynamicSharedMemorySize, SMEM_BYTES);
    int dev = 0, cus = 0, per_cu = 0;
    hipGetDevice(&dev);
    hipDeviceGetAttribute(&cus, hipDeviceAttributeMultiprocessorCount, dev);
    hipOccupancyMaxActiveBlocksPerMultiprocessor(&per_cu, mega, 256, SMEM_BYTES);
    if (per_cu < 1) per_cu = 1;
    grid_blocks = cus * per_cu;
  }
  Params p{};
  p.xp = (const float*)d_in[0]; p.xs = (const float*)d_in[1];
  p.norm_g = (const float*)d_in[2]; p.w_in = (const float*)d_in[3]; p.q_norm_g = (const float*)d_in[4]; p.k_norm_g = (const float*)d_in[5];
  p.pool_w = (const float*)d_in[6]; p.pool_scale = (const float*)d_in[7]; p.sg_norm_g = (const float*)d_in[8]; p.sg_w = (const float*)d_in[9]; p.sg_b = (const float*)d_in[10];
  p.mu_rkv = (const float*)d_in[11]; p.mu_lat = (const float*)d_in[12]; p.w0 = (const float*)d_in[13]; p.w_up = (const float*)d_in[14]; p.a0 = (const float*)d_in[15]; p.a_up = (const float*)d_in[16];
  p.k_k = (const float*)d_in[17]; p.k_a = (const float*)d_in[18]; p.r_k = (const float*)d_in[19]; p.ln_g = (const float*)d_in[20]; p.ln_b = (const float*)d_in[21];
  p.w_branch = (const float*)d_in[22]; p.w_out = (const float*)d_in[23];
  p.out = (float*)d_out;
  unsigned char* ws = (unsigned char*)d_ws;
  size_t off = 0;
  p.qkv = (bf16_t*)(ws + off); off += (size_t)MTOK * QKVW * 2;
  p.rest = (bf16_t*)(ws + off); off += (size_t)MTOK * RESTW * 2;
  p.ys = (bf16_t*)(ws + off); off += (size_t)MTOK * 1024 * 2;
  p.w1t = (bf16_t*)(ws + off); off += (size_t)5120 * 1024 * 2;
  p.wgt = (bf16_t*)(ws + off); off += (size_t)4096 * 1024 * 2;
  p.wbrt = (bf16_t*)(ws + off); off += (size_t)4096 * 256 * 2;
  p.woutt = (bf16_t*)(ws + off); off += (size_t)1024 * 1024 * 2;
  p.rstd = nullptr;
  p.xb = (bf16_t*)(ws + off); off += (size_t)MTOK * 1024 * 2;
  p.pnum = (bf16_t*)(ws + off); off += (size_t)3 * MTOK * 256 * 2;
  p.pden = (float*)p.w1t;
  p.pg = (float*)(ws + off); off += (size_t)3072 * 8192 * 4;
  p.bar = (unsigned*)(ws + off); off += (size_t)XCD_BAR_WORDS * 4;
  p.branch = p.qkv;
  if (off > ws_size) { fprintf(stderr, "workspace too small: need %zu have %zu\n", off, ws_size); return; }
  (void)hipMemsetAsync(p.bar, 0, (size_t)XCD_BAR_WORDS * 4, stream);
#if MULTI_LAUNCH
  for (int ph = 0; ph < 2 * NPH; ++ph) {
    p.phase_lo = ph; p.phase_hi = ph + 1;
    hipLaunchKernelGGL(mega, dim3(grid_blocks), dim3(256), SMEM_BYTES, stream, p);
  }
#else
  p.phase_lo = 0; p.phase_hi = 2 * NPH;
  void* args[] = {&p};
  hipError_t e = hipLaunchCooperativeKernel((void*)mega, dim3(grid_blocks), dim3(256), args, SMEM_BYTES, stream);
  if (e != hipSuccess) fprintf(stderr, "cooperative launch failed: %s (grid %d)\n", hipGetErrorString(e), grid_blocks);
#endif
}
```

```cpp
#include <hip/hip_runtime.h>
#include <hip/hip_cooperative_groups.h>
#include <cstdio>
namespace cg = cooperative_groups;

#ifndef PROBE_MASK
#define PROBE_MASK 0
#endif
#ifndef PROBE_NOGL
#define PROBE_NOGL 0
#endif
#if PROBE_MASK
__shared__ int s_dry;
#define DRY(p) (s_dry)
#define NOGL (PROBE_NOGL && s_dry)
#else
#define DRY(p) 0
#define NOGL 0
#endif
#ifndef MULTI_LAUNCH
#define MULTI_LAUNCH 0
#endif

typedef unsigned short bf16_t;
typedef short bf16x8 __attribute__((ext_vector_type(8)));
typedef float f32x4 __attribute__((ext_vector_type(4)));
typedef unsigned u32x4 __attribute__((ext_vector_type(4)));
typedef float f32x2 __attribute__((ext_vector_type(2)));
typedef __bf16 bf2v __attribute__((ext_vector_type(2)));

constexpr int MTOK = 49152;
constexpr int DM = 1024;
constexpr int PW = 9216;
constexpr int QKVW = 2304;
constexpr int RESTW = 1792;
constexpr int SMEM_BYTES = 73728 + 16;
constexpr int NPH = 8;

struct Params {
  const float* xp; const float* xs;
  const float* norm_g; const float* w_in; const float* q_norm_g; const float* k_norm_g;
  const float* pool_w; const float* pool_scale; const float* sg_norm_g; const float* sg_w; const float* sg_b;
  const float* mu_rkv; const float* mu_lat; const float* w0; const float* w_up; const float* a0; const float* a_up;
  const float* k_k; const float* k_a; const float* r_k; const float* ln_g; const float* ln_b;
  const float* w_branch; const float* w_out;
  float* out;
  bf16_t* qkv; bf16_t* rest; bf16_t* ys;
  bf16_t* w1t; bf16_t* wgt; bf16_t* wbrt; bf16_t* woutt;
  float* rstd; float* pg; bf16_t* branch; bf16_t* xb; bf16_t* pnum; float* pden; unsigned* bar;
  int phase_lo, phase_hi;
  int dry, pad_;
};

__device__ __forceinline__ int get_tid() { int t = threadIdx.x; asm volatile("" : "+v"(t)); return t; }
__device__ __forceinline__ float bf2f(bf16_t v) { return __uint_as_float(((unsigned)v) << 16); }
__device__ __forceinline__ bf16_t f2bf(float f) { unsigned u = __float_as_uint(f); u += 0x7fffu + ((u >> 16) & 1u); return (bf16_t)(u >> 16); }
__device__ __forceinline__ unsigned pack2(float a, float b) { return (unsigned)f2bf(a) | ((unsigned)f2bf(b) << 16); }
__device__ __forceinline__ float sigmoidf_(float x) { return __builtin_amdgcn_rcpf(1.f + __expf(-x)); }
__device__ __forceinline__ float dpp_qx1(float v) { return __int_as_float(__builtin_amdgcn_update_dpp(0, __float_as_int(v), 0xB1, 0xF, 0xF, true)); }
__device__ __forceinline__ float dpp_qx2(float v) { return __int_as_float(__builtin_amdgcn_update_dpp(0, __float_as_int(v), 0x4E, 0xF, 0xF, true)); }
__device__ __forceinline__ float dpp_hm(float v) { return __int_as_float(__builtin_amdgcn_update_dpp(0, __float_as_int(v), 0x141, 0xF, 0xF, true)); }
__device__ __forceinline__ float wave_sum(float v) {
  v += __int_as_float(__builtin_amdgcn_update_dpp(0, __float_as_int(v), 0xB1, 0xF, 0xF, true));
  v += __int_as_float(__builtin_amdgcn_update_dpp(0, __float_as_int(v), 0x4E, 0xF, 0xF, true));
  v += __int_as_float(__builtin_amdgcn_update_dpp(0, __float_as_int(v), 0x141, 0xF, 0xF, true));
  v += __int_as_float(__builtin_amdgcn_update_dpp(0, __float_as_int(v), 0x140, 0xF, 0xF, true));
  v += __shfl_xor(v, 16); v += __shfl_xor(v, 32);
  return v;
}
__device__ __forceinline__ const float* xrow_ptr(const Params& p, int layer, int row) {
  if (layer == 0) return row < 16384 ? p.xp + (size_t)row * DM : p.xs + (size_t)(row - 16384) * DM;
  return p.out + (size_t)row * DM;
}
__device__ __forceinline__ void seq_of(int T0, int& sstart, int& slen) {
  if (T0 < 16384) { sstart = T0 & ~8191; slen = 8192; } else { sstart = 16384 + ((T0 - 16384) & ~16383); slen = 16384; }
}

__device__ void prep_xb(const Params& p, int layer) {
  const int tid = get_tid(), lane = tid & 63;
  const int gw = (blockIdx.x * 256 + tid) >> 6, nw = gridDim.x * 4;
  for (int row = gw; row < MTOK; row += nw) {
    const float4* x = (const float4*)xrow_ptr(p, layer, row);
    float ss = 0.f;
#pragma unroll
    for (int i = 0; i < 4; ++i) { float4 v = x[lane + i * 64]; ss += v.x * v.x + v.y * v.y + v.z * v.z + v.w * v.w; }
    ss = wave_sum(ss);
    const float rs = rsqrtf(ss * (1.f / 1024.f) + 1e-6f);
#pragma unroll
    for (int i = 0; i < 4; ++i) { float4 v = x[lane + i * 64]; uint2 o; o.x = pack2(v.x * rs, v.y * rs); o.y = pack2(v.z * rs, v.w * rs); *(uint2*)(p.xb + (size_t)row * 1024 + (lane + i * 64) * 4) = o; }
  }
}

__device__ __forceinline__ int w1_col(int n) {
  if (n < 2304) return n; if (n < 2560) return 2560 + (n - 2304); if (n < 3072) return 3072 + (n - 2560);
  if (n < 3840) return 3840 + (n - 3072); if (n < 4096) return 4608 + (n - 3840);
  if (n < 4352) return 2304 + (n - 4096); if (n < 4608) return 2816 + (n - 4352);
  if (n < 4864) return 3584 + (n - 4608); return 4864 + (n - 4864);
}
__device__ __forceinline__ int wg_col(int n) {
  const int tn = n >> 8, c = n & 255, wn = c >> 7, nn = (c >> 4) & 7, dl = c & 15, dg = nn >> 2, b = nn & 3;
  return 5120 + b * 1024 + tn * 64 + wn * 32 + dg * 16 + dl;
}

__device__ void phase_prep(const Params& p, int layer, unsigned char* smem) {
  const int tid = get_tid(), lane = tid & 63, wave = tid >> 6;
  prep_xb(p, layer);
  const float* w_in = p.w_in + (size_t)layer * DM * PW;
  const float* ng = p.norm_g + layer * DM;
  const float* wb = p.w_branch + (size_t)layer * 4 * 256 * 1024;
  const float* wo = p.w_out + (size_t)layer * 1024 * 1024;
  bf16_t* T = (bf16_t*)smem;
  const int NT0 = 80 * 16, NT1 = 64 * 16, NT2 = 64 * 4, NT3 = 16 * 16;
  for (int tile = blockIdx.x; tile < NT0 + NT1 + NT2 + NT3; tile += gridDim.x) {
    int kind, tl = tile;
    if (tl < NT0) kind = 0; else if ((tl -= NT0) < NT1) kind = 1; else if ((tl -= NT1) < NT2) kind = 2; else { tl -= NT2; kind = 3; }
    const int nkt = kind == 2 ? 4 : 16;
    const int n0 = (tl / nkt) * 64, k0 = (tl % nkt) * 64;
    const int n = n0 + lane;
    const float* src; size_t ls; bf16_t* dst; int K;
    if (kind == 0) { src = w_in + w1_col(n); ls = PW; dst = p.w1t; K = 1024; }
    else if (kind == 1) { src = w_in + wg_col(n); ls = PW; dst = p.wgt; K = 1024; }
    else if (kind == 2) { src = wb + (size_t)(n >> 10) * 256 * 1024 + (n & 1023); ls = 1024; dst = p.wbrt; K = 256; }
    else { src = wo + n; ls = 1024; dst = p.woutt; K = 1024; }
    float v[16];
#pragma unroll
    for (int i = 0; i < 16; ++i) v[i] = src[(size_t)(k0 + wave * 16 + i) * ls];
    if (kind < 2) {
#pragma unroll
      for (int i = 0; i < 16; ++i) v[i] *= ng[k0 + wave * 16 + i];
    }
#pragma unroll
    for (int i = 0; i < 8; ++i) *(unsigned*)(T + lane * 72 + wave * 16 + 2 * i) = pack2(v[2 * i], v[2 * i + 1]);
    __syncthreads();
#pragma unroll
    for (int i = 0; i < 2; ++i) {
      const int id = tid + i * 256, nl = id >> 3, kc = id & 7;
      *(u32x4*)(dst + (size_t)(n0 + nl) * K + k0 + kc * 8) = *(const u32x4*)(T + nl * 72 + kc * 8);
    }
    __syncthreads();
  }
}

__device__ __forceinline__ int lds_off(int r, int c) { return r * 128 + ((c ^ ((r >> 1) & 7)) << 4); }

#define LAS __attribute__((address_space(3)))
constexpr int GSTAGE = 24576;
#define DMA16(G, L) __builtin_amdgcn_global_load_lds((const unsigned*)(G), (LAS unsigned*)(L), 16, 0, 0)
#define DMA_TILE(T, ST) { const size_t ko = (size_t)(T) * 64; LAS unsigned char* d_ = lds + (ST) * GSTAGE + ldsw; \
    DMA16(Ab + ko + voffA, d_); DMA16(Ab + ko + (voffA + 64u * lda2), d_ + 4096); \
    DMA16(Bb + ko + voffB, d_ + 8192); DMA16(Bb + ko + (voffB + 64u * ldb2), d_ + 12288); \
    DMA16(Bb + ko + (voffB + 128u * ldb2), d_ + 16384); DMA16(Bb + ko + (voffB + 192u * ldb2), d_ + 20480); }

__device__ __forceinline__ void gemm_compute(f32x4 (&acc)[4][8], const LAS unsigned char* a_, int aoff, int boff) {
  const LAS unsigned char* b_ = a_ + 8192;
  bf16x8 af[4], bfr[8];
#pragma unroll
  for (int m = 0; m < 4; ++m) af[m] = *(const LAS bf16x8*)(a_ + aoff + m * 1024);
#pragma unroll
  for (int n = 0; n < 8; ++n) bfr[n] = *(const LAS bf16x8*)(b_ + boff + n * 1024);
  asm volatile("" :: "v"(af[0]), "v"(af[1]), "v"(af[2]), "v"(af[3]));
#pragma unroll
  for (int m = 0; m < 4; ++m)
#pragma unroll
    for (int n = 0; n < 8; ++n) acc[m][n] = __builtin_amdgcn_mfma_f32_16x16x32_bf16(bfr[n], af[m], acc[m][n], 0, 0, 0);
}

#define DMA_HALF0(T, ST) { const size_t ko = (size_t)(T) * 64; LAS unsigned char* d_ = lds + (ST) * GSTAGE + ldsw; \
    DMA16(Ab + ko + voffA, d_); DMA16(Ab + ko + (voffA + 64u * lda2), d_ + 4096); DMA16(Bb + ko + voffB, d_ + 8192); }
#define DMA_HALF1(T, ST) { const size_t ko = (size_t)(T) * 64; LAS unsigned char* d_ = lds + (ST) * GSTAGE + ldsw; \
    DMA16(Bb + ko + (voffB + 64u * ldb2), d_ + 12288); DMA16(Bb + ko + (voffB + 128u * ldb2), d_ + 16384); DMA16(Bb + ko + (voffB + 192u * ldb2), d_ + 20480); }
__device__ __forceinline__ void gemm_core(f32x4 (&acc)[4][8], const bf16_t* Aptr, int lda, const bf16_t* Bt, int ldb, int K, unsigned char* smem) {
  const int tid = get_tid(), lane = tid & 63, wave = tid >> 6, wm = wave >> 1, wn = wave & 1;
  const int dl = lane & 15, gq = lane >> 4, swz = ((dl >> 3) & 1) * 3;
  const int aoff = (wm * 64 + dl) * 64 + ((gq ^ swz) << 4);
  const int boff = (wn * 128 + dl) * 64 + ((gq ^ swz) << 4);
  LAS unsigned char* lds = (LAS unsigned char*)smem;
  const int r0 = tid >> 2, csrc = (tid & 3) ^ (((r0 >> 3) & 1) * 3);
  const int ldsw = tid * 16;
  const unsigned lda2 = (unsigned)lda * 2u, ldb2 = (unsigned)ldb * 2u;
  const unsigned voffA = (unsigned)r0 * lda2 + csrc * 16, voffB = (unsigned)r0 * ldb2 + csrc * 16;
  const unsigned char* Ab = (const unsigned char*)Aptr; const unsigned char* Bb = (const unsigned char*)Bt;
  const int nt = K >> 5;
  DMA_TILE(0, 0) DMA_TILE(1, 1)
  int st = 0, st2 = 2;
#pragma unroll 1
  for (int t = 0; t < nt; ++t) {
    if (t + 1 < nt) asm volatile("s_waitcnt vmcnt(6)" ::: "memory"); else asm volatile("s_waitcnt vmcnt(0)" ::: "memory");
    asm volatile("" ::: "memory"); __builtin_amdgcn_s_barrier(); asm volatile("" ::: "memory");
    {
      const LAS unsigned char* a_ = lds + st * GSTAGE; const LAS unsigned char* b_ = a_ + 8192;
      bf16x8 af[4], bfr[8];
#pragma unroll
      for (int m = 0; m < 4; ++m) af[m] = *(const LAS bf16x8*)(a_ + aoff + m * 1024);
#pragma unroll
      for (int n = 0; n < 8; ++n) bfr[n] = *(const LAS bf16x8*)(b_ + boff + n * 1024);
      asm volatile("" :: "v"(af[0]), "v"(af[1]), "v"(af[2]), "v"(af[3]));
      __builtin_amdgcn_sched_barrier(0);
#pragma unroll
      for (int m = 0; m < 2; ++m)
#pragma unroll
        for (int n = 0; n < 8; ++n) acc[m][n] = __builtin_amdgcn_mfma_f32_16x16x32_bf16(bfr[n], af[m], acc[m][n], 0, 0, 0);
      __builtin_amdgcn_sched_barrier(0);
      if (t + 2 < nt) DMA_HALF0(t + 2, st2)
      __builtin_amdgcn_sched_barrier(0);
#pragma unroll
      for (int m = 2; m < 4; ++m)
#pragma unroll
        for (int n = 0; n < 8; ++n) acc[m][n] = __builtin_amdgcn_mfma_f32_16x16x32_bf16(bfr[n], af[m], acc[m][n], 0, 0, 0);
      __builtin_amdgcn_sched_barrier(0);
      if (t + 2 < nt) DMA_HALF1(t + 2, st2)
    }
    st = st == 2 ? 0 : st + 1; st2 = st2 == 2 ? 0 : st2 + 1;
  }
  asm volatile("" ::: "memory"); __builtin_amdgcn_s_barrier(); asm volatile("" ::: "memory");
}

__device__ __forceinline__ void zero_acc(f32x4 (&acc)[4][8]) {
#pragma unroll
  for (int m = 0; m < 4; ++m)
#pragma unroll
    for (int n = 0; n < 8; ++n) acc[m][n] = (f32x4){0.f, 0.f, 0.f, 0.f};
}

__device__ __forceinline__ bool tile_of(int it, int ntn, int& tm, int& tn) {
  if (gridDim.x == 256 || gridDim.x == 512) {
    const int xcd = blockIdx.x & 7, s = blockIdx.x >> 3;
    const int gmh = gridDim.x == 512 ? 16 : 8;
    const int gn_cnt = ntn >> 2, g = it * 8 + xcd;
    if (g >= (384 / gmh) * gn_cnt) return false;
    const int gm = g / gn_cnt, gn = g % gn_cnt;
    tm = gm * gmh + (s & (gmh - 1)); tn = gn * 4 + s / gmh;
    return true;
  }
  const int tile = blockIdx.x + it * gridDim.x;
  if (tile >= 384 * ntn) return false;
  tm = tile / ntn; tn = tile % ntn; return true;
}

__device__ void phase_g1(const Params& p, int layer, unsigned char* smem) {
  const int lane = get_tid() & 63, wave = get_tid() >> 6, wm = wave >> 1, wn = wave & 1;
  int tm, tn;
  for (int it = 0; tile_of(it, 20, tm, tn); ++it) {
    const int row0 = tm * 128, col0 = tn * 256;
    f32x4 acc[4][8]; zero_acc(acc);
    gemm_core(acc, p.xb + (size_t)row0 * 1024, 1024, p.w1t + (size_t)col0 * 1024, 1024, 1024, smem);
    if (col0 < 1536) {
      const float* gn = (col0 < 768 ? p.q_norm_g : p.k_norm_g) + layer * 64;
      const float sc = col0 < 768 ? 0.125f : 1.f;
#pragma unroll
      for (int m = 0; m < 4; ++m)
#pragma unroll
        for (int hh = 0; hh < 2; ++hh) {
          float ss = 0.f;
#pragma unroll
          for (int n = 0; n < 4; ++n)
#pragma unroll
            for (int j = 0; j < 4; ++j) ss += acc[m][hh * 4 + n][j] * acc[m][hh * 4 + n][j];
          ss += __shfl_xor(ss, 16); ss += __shfl_xor(ss, 32);
          const float rs = rsqrtf(ss * (1.f / 64.f) + 1e-6f) * sc;
#pragma unroll
          for (int n = 0; n < 4; ++n) {
            const f32x4 gv = *(const f32x4*)(gn + n * 16 + (lane >> 4) * 4);
#pragma unroll
            for (int j = 0; j < 4; ++j) acc[m][hh * 4 + n][j] *= rs * gv[j];
          }
        }
    }
    {
      unsigned char* wl = smem + wave * 17408;
      const bool act = col0 >= 4096;
#pragma unroll
      for (int m = 0; m < 4; ++m)
#pragma unroll
        for (int n = 0; n < 8; ++n) {
          float v0 = acc[m][n][0], v1 = acc[m][n][1], v2 = acc[m][n][2], v3 = acc[m][n][3];
          if (act) { v0 *= sigmoidf_(v0); v1 *= sigmoidf_(v1); v2 *= sigmoidf_(v2); v3 *= sigmoidf_(v3); }
          uint2 o; o.x = pack2(v0, v1); o.y = pack2(v2, v3);
          *(uint2*)(wl + (m * 16 + (lane & 15)) * 272 + (n * 16 + (lane >> 4) * 4) * 2) = o;
        }
      bf16_t* dst; int ld;
      if (col0 < QKVW) { dst = p.qkv + col0; ld = QKVW; }
      else if (col0 < 4096) { dst = p.rest + (col0 - QKVW); ld = RESTW; }
      else { dst = p.ys + (col0 - 4096); ld = 1024; }
      dst += (size_t)(row0 + wm * 64) * ld + wn * 128;
#pragma unroll
      for (int i = 0; i < 16; ++i) {
        const int id = i * 64 + lane, r = id >> 4, c16 = id & 15;
        const u32x4 v = *(const u32x4*)(wl + r * 272 + c16 * 16);
        *(u32x4*)(dst + (size_t)r * ld + c16 * 8) = v;
      }
    }
    __syncthreads();
  }
}

__device__ void phase_branch(const Params& p, unsigned char* smem) {
  const int lane = get_tid() & 63, wave = get_tid() >> 6, wm = wave >> 1, wn = wave & 1;
  int tm, tn;
  for (int it = 0; tile_of(it, 16, tm, tn); ++it) {
    const int row0 = tm * 128, col0 = tn * 256, b = tn >> 2;
    f32x4 acc[4][8]; zero_acc(acc);
    gemm_core(acc, p.ys + (size_t)row0 * 1024 + b * 256, 1024, p.wbrt + (size_t)col0 * 256, 256, 256, smem);
#pragma unroll
    for (int m = 0; m < 4; ++m) {
      const int row = row0 + wm * 64 + m * 16 + (lane & 15);
#pragma unroll
      for (int n = 0; n < 8; ++n) {
        const int colt = col0 + wn * 128 + n * 16, bb = colt >> 10, d16 = (colt & 1023) >> 4;
        uint2 o; o.x = pack2(acc[m][n][0], acc[m][n][1]); o.y = pack2(acc[m][n][2], acc[m][n][3]);
        *(uint2*)(p.branch + ((((((size_t)tm * 2 + wm) * 4 + m) * 4 + bb) * 64 + d16) * 64 + lane) * 4) = o;
      }
    }
  }
}

__device__ void phase_gate(const Params& p, int layer, unsigned char* smem) {
  const int lane = get_tid() & 63, wave = get_tid() >> 6, wm = wave >> 1, wn = wave & 1;
  int tm, tn;
  for (int it = 0; tile_of(it, 16, tm, tn); ++it) {
    const int row0 = tm * 128;
    f32x4 acc[4][8]; zero_acc(acc);
    gemm_core(acc, p.xb + (size_t)row0 * 1024, 1024, p.wgt + (size_t)tn * 256 * 1024, 1024, 1024, smem);
#pragma unroll
    for (int m = 0; m < 4; ++m) {
      const int row = row0 + wm * 64 + m * 16 + (lane & 15);
#pragma unroll
      for (int dg = 0; dg < 2; ++dg) {
        const int d = tn * 64 + wn * 32 + dg * 16 + (lane >> 4) * 4;
        float s0 = 0.f, s1 = 0.f, s2 = 0.f, s3 = 0.f;
#pragma unroll
        for (int b = 0; b < 4; ++b) {
          uint2 br = *(const uint2*)(p.branch + ((((((size_t)tm * 2 + wm) * 4 + m) * 4 + b) * 64 + (tn * 4 + wn * 2 + dg)) * 64 + lane) * 4);
          s0 += sigmoidf_(acc[m][dg * 4 + b][0]) * __uint_as_float(br.x << 16);
          s1 += sigmoidf_(acc[m][dg * 4 + b][1]) * __uint_as_float(br.x & 0xffff0000u);
          s2 += sigmoidf_(acc[m][dg * 4 + b][2]) * __uint_as_float(br.y << 16);
          s3 += sigmoidf_(acc[m][dg * 4 + b][3]) * __uint_as_float(br.y & 0xffff0000u);
        }
        uint2 o; o.x = pack2(s0, s1); o.y = pack2(s2, s3);
        *(uint2*)(p.ys + (size_t)row * 1024 + d) = o;
        asm volatile("" ::: "memory");
      }
    }
  }
}

__device__ void phase_out(const Params& p, int layer, unsigned char* smem) {
  const int lane = get_tid() & 63, wave = get_tid() >> 6, wm = wave >> 1, wn = wave & 1;
  int tm, tn;
  for (int it = 0; tile_of(it, 4, tm, tn); ++it) {
    const int row0 = tm * 128, col0 = tn * 256;
    f32x4 acc[4][8]; zero_acc(acc);
    gemm_core(acc, p.ys + (size_t)row0 * 1024, 1024, p.woutt + (size_t)col0 * 1024, 1024, 1024, smem);
#pragma unroll
    for (int m = 0; m < 4; ++m) {
      const int row = row0 + wm * 64 + m * 16 + (lane & 15);
      const float* xr = xrow_ptr(p, layer, row);
#pragma unroll
      for (int n = 0; n < 8; ++n) {
        const int col = col0 + wn * 128 + n * 16 + (lane >> 4) * 4;
        float4 xv = *(const float4*)(xr + col);
        float4 o; o.x = xv.x + acc[m][n][0]; o.y = xv.y + acc[m][n][1]; o.z = xv.z + acc[m][n][2]; o.w = xv.w + acc[m][n][3];
        if (!DRY(p)) *(float4*)(p.out + (size_t)row * 1024 + col) = o;
      }
    }
  }
}

constexpr int QS_STRIDE = 144, KS_STRIDE = 144, VT_STRIDE = 432;
struct AttnRaw { u32x4 q0, q1, ka0, kb0, va0, vb0, ka1, kb1, va1, vb1, ka2, kb2, va2, vb2, ka3, kb3, va3, vb3; };
__device__ __forceinline__ void attn_issue(const Params& p, int item, AttnRaw& R) {
  const int tid = get_tid();
  const int n = item % 12, run = item / 12, T0 = run * 64;
  const int g = n >> 2, d = g == 0 ? 1 : (g == 1 ? 4 : 16);
  int sstart, slen; seq_of(T0, sstart, slen);
  const int rho = (T0 - sstart) >> 6;
  const int r = rho % d, i0 = (rho / d) * 64;
  const int part = tid & 3;
  {
    const int q = tid >> 2;
    const int pq = d * (i0 + q) + r;
    const bf16_t* base = p.qkv + (size_t)(sstart + pq) * QKVW + n * 64 + part * 16;
    R.q0 = *(const u32x4*)base; R.q1 = *(const u32x4*)(base + 8);
  }
#define ATTN_ISSUE1(IT, KA, KB, VA, VB) { const int rr = (tid >> 2) + (IT) * 64; const int pos = d * (i0 - 64 + rr) + r; \
    const bool ok = rr < 192 && pos >= 0 && pos < slen; const u32x4 z = {0u, 0u, 0u, 0u}; KA = z; KB = z; VA = z; VB = z; \
    if (ok) { const bf16_t* base = p.qkv + (size_t)(sstart + pos) * QKVW + n * 64 + part * 16; \
      KA = *(const u32x4*)(base + 768); KB = *(const u32x4*)(base + 768 + 8); VA = *(const u32x4*)(base + 1536); VB = *(const u32x4*)(base + 1536 + 8); } }
  ATTN_ISSUE1(0, R.ka0, R.kb0, R.va0, R.vb0)
  ATTN_ISSUE1(1, R.ka1, R.kb1, R.va1, R.vb1)
  ATTN_ISSUE1(2, R.ka2, R.kb2, R.va2, R.vb2)
}

__device__ __forceinline__ void attn_item(const Params& p, int layer, int item, AttnRaw& R, int next_item, unsigned char* smem) {
  const int tid = get_tid(), lane = tid & 63, w = tid >> 6;
  const int n = item % 12, run = item / 12, T0 = run * 64;
  const int g = n >> 2, h = n & 3, d = g == 0 ? 1 : (g == 1 ? 4 : 16);
  int sstart, slen; seq_of(T0, sstart, slen);
  const int rho = (T0 - sstart) >> 6;
  const int r = rho % d, i0 = (rho / d) * 64;
  unsigned char* Qs = smem;
  unsigned char* Ks = smem + 64 * QS_STRIDE;
  unsigned char* Vt = Ks + 208 * KS_STRIDE;
  const float* kg = p.k_norm_g + layer * 64;
  const float* qg = p.q_norm_g + layer * 64;
  const int part = tid & 3;
  {
    const int q = tid >> 2;
    *(u32x4*)(Qs + q * QS_STRIDE + part * 32) = R.q0;
    *(u32x4*)(Qs + q * QS_STRIDE + part * 32 + 16) = R.q1;
  }
#define ATTN_PUT1(IT, KA, KB, VA, VB) { const int rr = (tid >> 2) + (IT) * 64; \
    if (rr < 208) { *(u32x4*)(Ks + rr * KS_STRIDE + part * 32) = KA; *(u32x4*)(Ks + rr * KS_STRIDE + part * 32 + 16) = KB; \
      const unsigned vw[8] = {VA[0], VA[1], VA[2], VA[3], VB[0], VB[1], VB[2], VB[3]}; \
      _Pragma("unroll") for (int j = 0; j < 8; ++j) { \
        *(bf16_t*)(Vt + (part * 16 + 2 * j) * VT_STRIDE + rr * 2) = (bf16_t)(vw[j] & 0xffffu); \
        *(bf16_t*)(Vt + (part * 16 + 2 * j + 1) * VT_STRIDE + rr * 2) = (bf16_t)(vw[j] >> 16); } } }
  ATTN_PUT1(0, R.ka0, R.kb0, R.va0, R.vb0)
  ATTN_PUT1(1, R.ka1, R.kb1, R.va1, R.vb1)
  ATTN_PUT1(2, R.ka2, R.kb2, R.va2, R.vb2)
  if (next_item >= 0) attn_issue(p, next_item, R);
  __syncthreads();
  const int dl = lane & 15, gq = lane >> 4;
  bf16x8 qf0 = *(const bf16x8*)(Qs + (16 * w + dl) * QS_STRIDE + gq * 16);
  bf16x8 qf1 = *(const bf16x8*)(Qs + (16 * w + dl) * QS_STRIDE + 64 + gq * 16);
  const float slope = exp2f(-8.f * (float)(n + 1) / 12.f) * (float)d;
  float pv[10][4];
  float dsum = 0.f;
#pragma unroll
  for (int j = 0; j < 4; ++j) pv[9][j] = 0.f;
#pragma unroll
  for (int t = 0; t < 9; ++t) {
    const unsigned char* kp = Ks + ((w + t) * 16 + dl) * KS_STRIDE + gq * 16;
    f32x4 sacc = {0.f, 0.f, 0.f, 0.f};
    sacc = __builtin_amdgcn_mfma_f32_16x16x32_bf16(*(const bf16x8*)kp, qf0, sacc, 0, 0, 0);
    sacc = __builtin_amdgcn_mfma_f32_16x16x32_bf16(*(const bf16x8*)(kp + 64), qf1, sacc, 0, 0, 0);
#pragma unroll
    for (int j = 0; j < 4; ++j) {
      const int m = 16 * t + 4 * gq + j - dl;
      const int kr = (w + t) * 16 + 4 * gq + j;
      const int pos = d * (i0 - 64 + kr) + r;
      const bool ok = m >= 0 && m <= 128 && pos >= 0 && pos < slen;
      const float e = ok ? __expf(sacc[j] - slope * fabsf((float)(m - 64))) : 0.f;
      pv[t][j] = e; dsum += e;
    }
  }
  f32x4 oacc[4];
#pragma unroll
  for (int dt = 0; dt < 4; ++dt) oacc[dt] = (f32x4){0.f, 0.f, 0.f, 0.f};
#pragma unroll
  for (int u = 0; u < 5; ++u) {
    union { bf16x8 v; unsigned uu[4]; } pb;
    pb.uu[0] = pack2(pv[2 * u][0], pv[2 * u][1]); pb.uu[1] = pack2(pv[2 * u][2], pv[2 * u][3]);
    pb.uu[2] = pack2(pv[2 * u + 1][0], pv[2 * u + 1][1]); pb.uu[3] = pack2(pv[2 * u + 1][2], pv[2 * u + 1][3]);
#pragma unroll
    for (int dt = 0; dt < 4; ++dt) {
      const unsigned char* vp = Vt + (dt * 16 + dl) * VT_STRIDE + ((w + 2 * u) * 16 + 4 * gq) * 2;
      union { bf16x8 v; uint2 h2[2]; } va;
      va.h2[0] = *(const uint2*)vp; va.h2[1] = u < 4 ? *(const uint2*)(vp + 32) : make_uint2(0u, 0u);
      oacc[dt] = __builtin_amdgcn_mfma_f32_16x16x32_bf16(va.v, pb.v, oacc[dt], 0, 0, 0);
    }
  }
  dsum += __shfl_xor(dsum, 16); dsum += __shfl_xor(dsum, 32);
  {
    const int ql = 16 * w + dl;
    const size_t tok = (size_t)(sstart + d * (i0 + ql) + r);
    bf16_t* np = p.pnum + (size_t)g * ((size_t)MTOK * 256) + (tok * 4 + h) * 64 + 4 * gq;
#pragma unroll
    for (int dt = 0; dt < 4; ++dt) { uint2 o; o.x = pack2(oacc[dt][0], oacc[dt][1]); o.y = pack2(oacc[dt][2], oacc[dt][3]); *(uint2*)(np + dt * 16) = o; }
    if (gq == 0) p.pden[(size_t)g * ((size_t)MTOK * 4) + tok * 4 + h] = dsum;
  }
  __syncthreads();
}

__device__ void attn_combine(const Params& p) {
  const size_t nvec = (size_t)MTOK * 64;
  for (size_t i = (size_t)blockIdx.x * 256 + get_tid(); i < nvec; i += (size_t)gridDim.x * 256) {
    const size_t th = i >> 4;
    const int e4 = (int)(i & 15);
    f32x4 a, b, c;
    { const uint2 u0 = *(const uint2*)(p.pnum + i * 4), u1 = *(const uint2*)(p.pnum + (size_t)MTOK * 256 + i * 4), u2 = *(const uint2*)(p.pnum + 2 * (size_t)MTOK * 256 + i * 4);
      a[0] = __uint_as_float(u0.x << 16); a[1] = __uint_as_float(u0.x & 0xffff0000u); a[2] = __uint_as_float(u0.y << 16); a[3] = __uint_as_float(u0.y & 0xffff0000u);
      b[0] = __uint_as_float(u1.x << 16); b[1] = __uint_as_float(u1.x & 0xffff0000u); b[2] = __uint_as_float(u1.y << 16); b[3] = __uint_as_float(u1.y & 0xffff0000u);
      c[0] = __uint_as_float(u2.x << 16); c[1] = __uint_as_float(u2.x & 0xffff0000u); c[2] = __uint_as_float(u2.y << 16); c[3] = __uint_as_float(u2.y & 0xffff0000u); }
    const float den = p.pden[th] + p.pden[(size_t)MTOK * 4 + th] + p.pden[2 * (size_t)MTOK * 4 + th];
    const float inv = 1.f / den;
    const size_t tok = th >> 2; const int h = (int)(th & 3);
    bf16_t* y = p.ys + tok * 1024 + h * 64 + e4 * 4;
    uint2 yv = *(const uint2*)y;
    float y0 = __uint_as_float(yv.x << 16), y1 = __uint_as_float(yv.x & 0xffff0000u), y2 = __uint_as_float(yv.y << 16), y3 = __uint_as_float(yv.y & 0xffff0000u);
    uint2 o; o.x = pack2(y0 * (a[0] + b[0] + c[0]) * inv, y1 * (a[1] + b[1] + c[1]) * inv); o.y = pack2(y2 * (a[2] + b[2] + c[2]) * inv, y3 * (a[3] + b[3] + c[3]) * inv);
    if (!DRY(p)) *(uint2*)y = o;
  }
}

__device__ void pool_item(const Params& p, int layer, int item, unsigned char* smem) {
  const int tid = get_tid(), lane = tid & 63, wave = tid >> 6, dl = lane & 15, gq = lane >> 4;
  const int g = item & 3, T0 = (item >> 2) * 64;
  int sstart, slen; seq_of(T0, sstart, slen);
  const int P0 = T0 - sstart;
  const int hw = 1 << g;
  float* u = (float*)smem;
  bf16_t* db = (bf16_t*)(u + 80 * 64);
  for (int i = tid; i < 80 * 64; i += 256) {
    const int rr = i >> 6, c = i & 63, pos = P0 - 8 + rr;
    u[i] = (pos >= 0 && pos < slen) ? bf2f(p.rest[(size_t)(sstart + pos) * RESTW + g * 64 + c]) : 0.f;
  }
  const float* pw = p.pool_w + ((size_t)layer * 4 + g) * 4096 + 16 * wave + dl;
  bf16x8 af[2];
#pragma unroll
  for (int ks = 0; ks < 2; ++ks) {
    union { bf16x8 v; unsigned uu[4]; } f;
#pragma unroll
    for (int e = 0; e < 4; ++e) { const int c = ks * 32 + gq * 8 + 2 * e; f.uu[e] = pack2(pw[c * 64], pw[(c + 1) * 64]); }
    af[ks] = f.v;
  }
  __syncthreads();
  for (int i = tid; i < 64 * 64; i += 256) {
    const int t = i >> 6, c = i & 63, pos = P0 + t;
    float sm = 0.f;
    for (int o = -hw; o < hw; ++o) sm += u[(t + 8 + o) * 64 + c];
    const int lo = pos - hw > 0 ? pos - hw : 0, hi = pos + hw < slen ? pos + hw : slen;
    db[t * 72 + c] = f2bf(sm / (float)(hi - lo) - u[(t + 8) * 64 + c]);
  }
  __syncthreads();
  const f32x4 sc = *(const f32x4*)(p.pool_scale + layer * 256 + g * 64 + 16 * wave + 4 * gq);
#pragma unroll
  for (int tt = 0; tt < 4; ++tt) {
    f32x4 acc = {0.f, 0.f, 0.f, 0.f};
#pragma unroll
    for (int ks = 0; ks < 2; ++ks) {
      const bf16x8 bd = *(const bf16x8*)(db + (tt * 16 + dl) * 72 + ks * 32 + gq * 8);
      acc = __builtin_amdgcn_mfma_f32_16x16x32_bf16(af[ks], bd, acc, 0, 0, 0);
    }
    bf16_t* y = p.ys + (size_t)(T0 + tt * 16 + dl) * 1024 + 256 + g * 64 + 16 * wave + 4 * gq;
    const uint2 yv = *(const uint2*)y;
    uint2 o;
    o.x = pack2(__uint_as_float(yv.x << 16) * acc[0] * sc[0], __uint_as_float(yv.x & 0xffff0000u) * acc[1] * sc[1]);
    o.y = pack2(__uint_as_float(yv.y << 16) * acc[2] * sc[2], __uint_as_float(yv.y & 0xffff0000u) * acc[3] * sc[3]);
    if (!DRY(p)) *(uint2*)y = o;
  }
  __syncthreads();
}

__device__ void sg_item(const Params& p, int layer, int item, unsigned char* smem) {
  const int tid = get_tid(), lane = tid & 63, wave = tid >> 6, dl = lane & 15, gq = lane >> 4;
  const int g = item & 3, T0 = (item >> 2) * 128;
  bf16_t* vnT = (bf16_t*)smem;
  for (int s_ = wave; s_ < 128; s_ += 4) {
    const bf16_t* vr = p.rest + (size_t)(T0 + s_) * RESTW + 512;
    float ss = 0.f; float mine = 0.f;
#pragma unroll
    for (int j = 0; j < 4; ++j) { float v = bf2f(vr[j * 64 + lane]); ss += v * v; if (j == g) mine = v; }
    ss = wave_sum(ss);
    const float rs = rsqrtf(ss * (1.f / 256.f) + 1e-6f);
    vnT[lane * 136 + s_] = f2bf(mine * rs * p.sg_norm_g[layer * 256 + g * 64 + lane]);
  }
  __syncthreads();
  const float* gw = p.sg_w + ((size_t)layer * 4 + g) * 128 * 128;
#pragma unroll 1
  for (int tt2 = 0; tt2 < 2; ++tt2) {
    const int t = (wave * 2 + tt2) * 16 + dl;
    const float* wrow = gw + t * 128 + gq * 8;
    f32x4 acc[4];
#pragma unroll
    for (int dt = 0; dt < 4; ++dt) acc[dt] = (f32x4){0.f, 0.f, 0.f, 0.f};
#pragma unroll
    for (int ks = 0; ks < 4; ++ks) {
      const f32x4 w0 = *(const f32x4*)(wrow + ks * 32), w1 = *(const f32x4*)(wrow + ks * 32 + 4);
      union { bf16x8 v; unsigned uu[4]; } bw;
      bw.uu[0] = pack2(w0[0], w0[1]); bw.uu[1] = pack2(w0[2], w0[3]); bw.uu[2] = pack2(w1[0], w1[1]); bw.uu[3] = pack2(w1[2], w1[3]);
#pragma unroll
      for (int dt = 0; dt < 4; ++dt) {
        const bf16x8 av = *(const bf16x8*)(vnT + (dt * 16 + dl) * 136 + ks * 32 + gq * 8);
        acc[dt] = __builtin_amdgcn_mfma_f32_16x16x32_bf16(av, bw.v, acc[dt], 0, 0, 0);
      }
    }
    const float bias = p.sg_b[(layer * 4 + g) * 128 + t];
#pragma unroll
    for (int dt = 0; dt < 4; ++dt) {
      const int d0 = dt * 16 + 4 * gq;
      const uint2 uv = *(const uint2*)(p.rest + (size_t)(T0 + t) * RESTW + 256 + g * 64 + d0);
      bf16_t* y = p.ys + (size_t)(T0 + t) * 1024 + 512 + g * 64 + d0;
      const uint2 yv = *(const uint2*)y;
      uint2 o;
      o.x = pack2(__uint_as_float(yv.x << 16) * __uint_as_float(uv.x << 16) * (acc[dt][0] + bias), __uint_as_float(yv.x & 0xffff0000u) * __uint_as_float(uv.x & 0xffff0000u) * (acc[dt][1] + bias));
      o.y = pack2(__uint_as_float(yv.y << 16) * __uint_as_float(uv.y << 16) * (acc[dt][2] + bias), __uint_as_float(yv.y & 0xffff0000u) * __uint_as_float(uv.y & 0xffff0000u) * (acc[dt][3] + bias));
      if (!DRY(p)) *(uint2*)y = o;
    }
  }
  __syncthreads();
}

constexpr int SBT = 16;
struct RwkvLds {
  bf16_t twb[SBT * 72], tab[SBT * 72];
  float accw[SBT * 64], acca[SBT * 64];
  float R[SBT * 64], W[SBT * 64], K[SBT * 64], V[SBT * 64], KK[SBT * 64], B[SBT * 64];
  float ot[SBT * 64];
  float bon[SBT * 64];
};

__device__ __forceinline__ float red8(float v) { v += dpp_qx1(v); v += dpp_qx2(v); v += dpp_hm(v); return v; }
__device__ __forceinline__ float red16(float v) { v = red8(v); v += __int_as_float(__builtin_amdgcn_update_dpp(0, __float_as_int(v), 0x140, 0xF, 0xF, true)); return v; }

struct ScanOps { f32x4 w0, w1, b0, b1, kk0, kk1, k0, k1, r0, r1; float2 v; };
template <bool PASS_C>
__device__ __forceinline__ ScanOps load_ops(const RwkvLds& L, int tk, int j0, int row0) {
  ScanOps o;
  o.w0 = *(const f32x4*)(L.W + tk * 64 + j0); o.w1 = *(const f32x4*)(L.W + tk * 64 + j0 + 4);
  o.b0 = *(const f32x4*)(L.B + tk * 64 + j0); o.b1 = *(const f32x4*)(L.B + tk * 64 + j0 + 4);
  o.kk0 = *(const f32x4*)(L.KK + tk * 64 + j0); o.kk1 = *(const f32x4*)(L.KK + tk * 64 + j0 + 4);
  o.k0 = *(const f32x4*)(L.K + tk * 64 + j0); o.k1 = *(const f32x4*)(L.K + tk * 64 + j0 + 4);
  if (PASS_C) { o.r0 = *(const f32x4*)(L.R + tk * 64 + j0); o.r1 = *(const f32x4*)(L.R + tk * 64 + j0 + 4); }
  else { o.r0 = o.w0; o.r1 = o.w1; }
  o.v = *(const float2*)(L.V + tk * 64 + row0);
  return o;
}

#define RAW_LOAD(SBI) { _Pragma("unroll") for (int i = 0; i < 4; ++i) { \
      const int tau = (SBI) * SBT + wave * 4 + i; \
      const int t = dir ? (t0 + 127 - tau) : (t0 + tau); \
      const bf16_t* cr = p.rest + (size_t)t * RESTW; \
      raw[i][0] = cr[768 + cidx]; raw[i][1] = cr[1024 + cidx]; raw[i][2] = cr[1280 + cidx]; raw[i][3] = cr[1536 + dir * 128 + lane]; raw[i][4] = cr[1536 + dir * 128 + 64 + lane]; \
      if (i == 0) { const int tp = dir ? t + 1 : t - 1; const bool pv = tp >= sstart && tp < send; const bf16_t* pr = p.rest + (size_t)(pv ? tp : t) * RESTW; \
        rawp[0] = pv ? pr[768 + cidx] : (bf16_t)0; rawp[1] = pv ? pr[1024 + cidx] : (bf16_t)0; rawp[2] = pv ? pr[1280 + cidx] : (bf16_t)0; \
        rawp[3] = pv ? pr[1536 + dir * 128 + lane] : (bf16_t)0; rawp[4] = pv ? pr[1536 + dir * 128 + 64 + lane] : (bf16_t)0; } } }

template <bool PASS_C>
__device__ void rwkv_job(const Params& p, int layer, int job, unsigned char* smem) {
  RwkvLds& L = *(RwkvLds*)smem;
  const int tid = get_tid(), lane = tid & 63, wave = tid >> 6;
  const int hd = job & 3, cp = job >> 2, t0 = cp * 128;
  int sstart, slen; seq_of(t0, sstart, slen);
  const int send = sstart + slen;
  const int rp = tid >> 3, jg = tid & 7, row0 = rp * 2, j0 = jg * 8;
  float* ytg0 = p.pg + ((size_t)cp * 8 + hd) * 8192;
  float* ytg1 = p.pg + ((size_t)cp * 8 + 4 + hd) * 8192;
#pragma unroll 1
  for (int dir = 0; dir < 2; ++dir) {
    const int ld = layer * 2 + dir;
    float* slot = p.pg + ((size_t)cp * 8 + dir * 4 + hd) * 8192;
    __syncthreads();
    bf16x8 wfr[2], afr[2];
    {
      const int dl_ = lane & 15, gq_ = lane >> 4;
      const float* wsrc = p.w_up + (size_t)ld * 64 * 256 + hd * 64 + 16 * wave + dl_;
      const float* asrc = p.a_up + (size_t)ld * 64 * 256 + hd * 64 + 16 * wave + dl_;
#pragma unroll
      for (int ks = 0; ks < 2; ++ks) {
        union { bf16x8 v; unsigned u[4]; } fw, fa;
#pragma unroll
        for (int e = 0; e < 4; ++e) {
          const int m = ks * 32 + gq_ * 8 + 2 * e;
          fw.u[e] = pack2(wsrc[(size_t)m * 256], wsrc[(size_t)(m + 1) * 256]);
          fa.u[e] = pack2(asrc[(size_t)m * 256], asrc[(size_t)(m + 1) * 256]);
        }
        wfr[ks] = fw.v; afr[ks] = fa.v;
      }
    }
    f32x2 S[2][4], Pst[2][4];
#pragma unroll
    for (int rr = 0; rr < 2; ++rr)
#pragma unroll
      for (int q = 0; q < 4; ++q) {
        if (PASS_C) { S[rr][q] = *(const f32x2*)(slot + 4096 + (row0 + rr) * 64 + j0 + 2 * q); Pst[rr][q] = (f32x2){0.f, 0.f}; }
        else { S[rr][q] = (f32x2){0.f, 0.f}; Pst[rr][q] = (f32x2){(row0 + rr == j0 + 2 * q) ? 1.f : 0.f, (row0 + rr == j0 + 2 * q + 1) ? 1.f : 0.f}; }
      }
    const int cidx = hd * 64 + lane;
    const float mu_r = p.mu_rkv[ld * 768 + cidx], mu_k = p.mu_rkv[ld * 768 + 256 + cidx], mu_v = p.mu_rkv[ld * 768 + 512 + cidx];
    const float mu_w = p.mu_lat[ld * 128 + lane], mu_a = p.mu_lat[ld * 128 + 64 + lane];
    const float w0v = p.w0[ld * 256 + cidx], a0v = p.a0[ld * 256 + cidx];
    const float kkv = p.k_k[ld * 256 + cidx], kav = p.k_a[ld * 256 + cidx], rkv_ = p.r_k[ld * 256 + cidx];
    bf16_t raw[4][5], rawp[5];
    RAW_LOAD(0)
#pragma unroll 1
    for (int sb = 0; sb < 128 / SBT; ++sb) {
      __syncthreads();
#pragma unroll
      for (int i = 0; i < 4; ++i) {
        const int tk = wave * 4 + i;
        const float cr_r = bf2f(raw[i][0]), cr_k = bf2f(raw[i][1]), cr_v = bf2f(raw[i][2]), cr_w = bf2f(raw[i][3]), cr_a = bf2f(raw[i][4]);
        const float pr_r = bf2f(i ? raw[i ? i - 1 : 0][0] : rawp[0]), pr_k = bf2f(i ? raw[i ? i - 1 : 0][1] : rawp[1]), pr_v = bf2f(i ? raw[i ? i - 1 : 0][2] : rawp[2]);
        const float pr_w = bf2f(i ? raw[i ? i - 1 : 0][3] : rawp[3]), pr_a = bf2f(i ? raw[i ? i - 1 : 0][4] : rawp[4]);
        L.R[tk * 64 + lane] = cr_r + (pr_r - cr_r) * mu_r;
        L.K[tk * 64 + lane] = cr_k + (pr_k - cr_k) * mu_k;
        L.V[tk * 64 + lane] = cr_v + (pr_v - cr_v) * mu_v;
        { const float xw = cr_w + (pr_w - cr_w) * mu_w; L.twb[tk * 72 + lane] = f2bf(1.f - 2.f * __builtin_amdgcn_rcpf(1.f + __expf(2.f * xw))); }
        L.tab[tk * 72 + lane] = f2bf(cr_a + (pr_a - cr_a) * mu_a);
      }
      if (sb + 1 < 128 / SBT) RAW_LOAD(sb + 1)
      __syncthreads();
      {
        const int dl_ = lane & 15, gq_ = lane >> 4;
        f32x4 dw = {0.f, 0.f, 0.f, 0.f}, da = {0.f, 0.f, 0.f, 0.f};
#pragma unroll
        for (int ks = 0; ks < 2; ++ks) {
          const bf16x8 bw = *(const bf16x8*)(L.twb + dl_ * 72 + ks * 32 + gq_ * 8);
          const bf16x8 ba = *(const bf16x8*)(L.tab + dl_ * 72 + ks * 32 + gq_ * 8);
          dw = __builtin_amdgcn_mfma_f32_16x16x32_bf16(wfr[ks], bw, dw, 0, 0, 0);
          da = __builtin_amdgcn_mfma_f32_16x16x32_bf16(afr[ks], ba, da, 0, 0, 0);
        }
        *(f32x4*)(L.accw + dl_ * 64 + 16 * wave + 4 * gq_) = dw;
        *(f32x4*)(L.acca + dl_ * 64 + 16 * wave + 4 * gq_) = da;
      }
      __syncthreads();
      float accw[4], acca[4];
#pragma unroll
      for (int i = 0; i < 4; ++i) { accw[i] = L.accw[(wave * 4 + i) * 64 + lane]; acca[i] = L.acca[(wave * 4 + i) * 64 + lane]; }
#pragma unroll
      for (int i = 0; i < 4; ++i) {
        const int tk = wave * 4 + i;
        const float wpre = w0v + accw[i];
        const float nx = -wpre;
        const float sp = fmaxf(nx, 0.f) + __logf(1.f + __expf(-fabsf(nx)));
        const float wlog = -sp - 0.5f;
        const float decay = __expf(-__expf(wlog));
        const float a = sigmoidf_(a0v + acca[i]);
        const float k = L.K[tk * 64 + lane], r = L.R[tk * 64 + lane], v = L.V[tk * 64 + lane];
        float kk = k * kkv;
        const float ss = wave_sum(kk * kk);
        kk *= rsqrtf(ss + 1e-12f);
        const float k2 = k * (1.f + (a - 1.f) * kav);
        L.W[tk * 64 + lane] = decay; L.K[tk * 64 + lane] = k2; L.KK[tk * 64 + lane] = kk; L.B[tk * 64 + lane] = kk * a;
        if (PASS_C) { const float bs = wave_sum(r * k2 * rkv_); L.bon[tk * 64 + lane] = bs * v; }
      }
      __syncthreads();
      ScanOps cur = load_ops<PASS_C>(L, 0, j0, row0);
#pragma unroll 8
      for (int tk = 0; tk < SBT; ++tk) {
        const ScanOps nx = load_ops<PASS_C>(L, (tk + 1) & (SBT - 1), j0, row0);
        const f32x2 w2[4] = {cur.w0.lo, cur.w0.hi, cur.w1.lo, cur.w1.hi};
        const f32x2 b2[4] = {cur.b0.lo, cur.b0.hi, cur.b1.lo, cur.b1.hi};
        const f32x2 kk2[4] = {cur.kk0.lo, cur.kk0.hi, cur.kk1.lo, cur.kk1.hi};
        const f32x2 k2[4] = {cur.k0.lo, cur.k0.hi, cur.k1.lo, cur.k1.hi};
        const float vr[2] = {cur.v.x, cur.v.y};
        float sa[2], sp[2] = {0.f, 0.f};
#pragma unroll
        for (int rr = 0; rr < 2; ++rr) {
          f32x2 a = S[rr][0] * kk2[0];
          a += S[rr][1] * kk2[1]; a += S[rr][2] * kk2[2]; a += S[rr][3] * kk2[3];
          sa[rr] = a.x + a.y;
          if (!PASS_C) {
            f32x2 q_ = Pst[rr][0] * kk2[0];
            q_ += Pst[rr][1] * kk2[1]; q_ += Pst[rr][2] * kk2[2]; q_ += Pst[rr][3] * kk2[3];
            sp[rr] = q_.x + q_.y;
          }
        }
        sa[0] = red8(sa[0]); sa[1] = red8(sa[1]);
        if (!PASS_C) { sp[0] = red8(sp[0]); sp[1] = red8(sp[1]); }
#pragma unroll
        for (int rr = 0; rr < 2; ++rr)
#pragma unroll
          for (int q = 0; q < 4; ++q) {
            S[rr][q] = S[rr][q] * w2[q] + (k2[q] * vr[rr] - b2[q] * sa[rr]);
            if (!PASS_C) Pst[rr][q] = Pst[rr][q] * w2[q] - b2[q] * sp[rr];
          }
        if (PASS_C) {
          const f32x2 r2[4] = {cur.r0.lo, cur.r0.hi, cur.r1.lo, cur.r1.hi};
          f32x2 oa = S[0][0] * r2[0]; oa += S[0][1] * r2[1]; oa += S[0][2] * r2[2]; oa += S[0][3] * r2[3];
          f32x2 ob = S[1][0] * r2[0]; ob += S[1][1] * r2[1]; ob += S[1][2] * r2[2]; ob += S[1][3] * r2[3];
          float o0 = red8(oa.x + oa.y), o1 = red8(ob.x + ob.y);
          if (jg == 0) { L.ot[tk * 64 + row0] = o0; L.ot[tk * 64 + row0 + 1] = o1; }
        }
        cur = nx;
      }
      if (PASS_C) {
        __syncthreads();
        const int x = tid >> 4, part = tid & 15;
        const int tk = dir ? (SBT - 1 - x) : x, tau = sb * SBT + tk;
        const int tl = dir ? (127 - tau) : tau;
        const f32x4 ov = *(const f32x4*)(L.ot + tk * 64 + part * 4);
        float o[4] = {ov[0], ov[1], ov[2], ov[3]};
        float s1 = red16(o[0] + o[1] + o[2] + o[3]);
        const float mu = s1 * (1.f / 64.f);
        float s2 = 0.f;
#pragma unroll
        for (int e = 0; e < 4; ++e) { o[e] -= mu; s2 += o[e] * o[e]; }
        s2 = red16(s2);
        const float rs = rsqrtf(s2 * (1.f / 64.f) + 64e-5f);
        const int ch = hd * 64 + part * 4;
        const f32x4 lg = *(const f32x4*)(p.ln_g + layer * 256 + ch), lb = *(const f32x4*)(p.ln_b + layer * 256 + ch);
        const f32x4 bo = *(const f32x4*)(L.bon + tk * 64 + part * 4);
        f32x4 y;
#pragma unroll
        for (int e = 0; e < 4; ++e) y[e] = o[e] * rs * lg[e] + lb[e] + bo[e];
        float* yg = (tl < 64 ? ytg0 + tl * 64 : ytg1 + (tl - 64) * 64) + part * 4;
        if (dir == 0) *(f32x4*)yg = y;
        else {
          const f32x4 y0 = *(const f32x4*)yg;
          bf16_t* yp = p.ys + (size_t)(t0 + tl) * 1024 + 768 + ch;
          const uint2 yv = *(const uint2*)yp;
          uint2 ov2;
          ov2.x = pack2(__uint_as_float(yv.x << 16) * (y[0] + y0[0]), __uint_as_float(yv.x & 0xffff0000u) * (y[1] + y0[1]));
          ov2.y = pack2(__uint_as_float(yv.y << 16) * (y[2] + y0[2]), __uint_as_float(yv.y & 0xffff0000u) * (y[3] + y0[3]));
          if (!DRY(p)) *(uint2*)yp = ov2;
        }
      }
    }
    if (!PASS_C) {
#pragma unroll
      for (int rr = 0; rr < 2; ++rr)
#pragma unroll
        for (int q = 0; q < 4; ++q) { *(f32x2*)(slot + (row0 + rr) * 64 + j0 + 2 * q) = Pst[rr][q]; *(f32x2*)(slot + 4096 + (row0 + rr) * 64 + j0 + 2 * q) = S[rr][q]; }
    }
  }
  __syncthreads();
}

__device__ void rwkv_passB(const Params& p, unsigned char* smem) {
  float* Pl = (float*)smem;
  float* Sl = Pl + 2 * 4096;
  const int tid = get_tid();
  for (int wk = blockIdx.x; wk < 128; wk += gridDim.x) {
    const int rg = wk & 3, hd = (wk >> 2) & 3, dir = (wk >> 4) & 1, seq = wk >> 5;
    const int cbase = seq == 0 ? 0 : seq == 1 ? 64 : seq == 2 ? 128 : 256;
    const int nch = seq < 2 ? 64 : 128;
    const int row = tid >> 4, jq = tid & 15;
    __syncthreads();
    for (int i = tid; i < 2 * 16 * 64; i += 256) Sl[i] = 0.f;
    float4 pf0, pf1, pf2, pf3, gf;
    {
      const int c = dir ? nch - 1 : 0;
      const float* slot = p.pg + ((size_t)(cbase + c) * 8 + dir * 4 + hd) * 8192;
      pf0 = ((const float4*)slot)[tid]; pf1 = ((const float4*)slot)[tid + 256]; pf2 = ((const float4*)slot)[tid + 512]; pf3 = ((const float4*)slot)[tid + 768];
      gf = *(const float4*)(slot + 4096 + (rg * 16 + row) * 64 + jq * 4);
    }
#pragma unroll 1
    for (int ci = 0; ci < nch; ++ci) {
      const int c = dir ? nch - 1 - ci : ci;
      float* slot = p.pg + ((size_t)(cbase + c) * 8 + dir * 4 + hd) * 8192;
      float* Pb = Pl + (ci & 1) * 4096;
      ((float4*)Pb)[tid] = pf0; ((float4*)Pb)[tid + 256] = pf1; ((float4*)Pb)[tid + 512] = pf2; ((float4*)Pb)[tid + 768] = pf3;
      float* gp = slot + 4096 + (rg * 16 + row) * 64 + jq * 4;
      float4 acc = gf;
      if (ci + 1 < nch) {
        const int c2 = dir ? nch - 2 - ci : ci + 1;
        const float* s2 = p.pg + ((size_t)(cbase + c2) * 8 + dir * 4 + hd) * 8192;
        pf0 = ((const float4*)s2)[tid]; pf1 = ((const float4*)s2)[tid + 256]; pf2 = ((const float4*)s2)[tid + 512]; pf3 = ((const float4*)s2)[tid + 768];
        gf = *(const float4*)(s2 + 4096 + (rg * 16 + row) * 64 + jq * 4);
      }
      __syncthreads();
      const float* Sc = Sl + (ci & 1) * 1024;
      const float4 sold = *(const float4*)(Sc + row * 64 + jq * 4);
#pragma unroll 4
      for (int m4 = 0; m4 < 16; ++m4) {
        const float4 s4 = *(const float4*)(Sc + row * 64 + m4 * 4);
        const float sv[4] = {s4.x, s4.y, s4.z, s4.w};
#pragma unroll
        for (int e = 0; e < 4; ++e) {
          const float4 pv = *(const float4*)(Pb + (m4 * 4 + e) * 64 + jq * 4);
          acc.x += sv[e] * pv.x; acc.y += sv[e] * pv.y; acc.z += sv[e] * pv.z; acc.w += sv[e] * pv.w;
        }
      }
      if (!DRY(p)) *(float4*)gp = sold;
      *(float4*)(Sl + ((ci + 1) & 1) * 1024 + row * 64 + jq * 4) = acc;
    }
  }
}

__device__ void phase_bmix(const Params& p, int layer, unsigned char* smem) {
  const int NA = 9216, NS = 1536, NP = 3072;
  const bool weighted = gridDim.x == 512;
  if (!weighted || blockIdx.x < 128) { __builtin_amdgcn_s_setprio(3); rwkv_passB(p, smem); __builtin_amdgcn_s_setprio(0); }
  int first, cnt, stride;
  if (weighted) {
    if (blockIdx.x >= 128) { first = (blockIdx.x - 128) * 24; cnt = 24; } else { first = 0; cnt = 0; }
    stride = 1;
  } else { first = blockIdx.x; stride = gridDim.x; cnt = (NA - first + stride - 1) / stride; if (first >= NA) cnt = 0; }
  if (cnt > 0) {
    AttnRaw R;
    attn_issue(p, first, R);
#pragma unroll 1
    for (int k = 0; k < cnt; ++k) attn_item(p, layer, first + k * stride, R, k + 1 < cnt ? first + (k + 1) * stride : -1, smem);
  }
  const int b0 = (int)blockIdx.x, bs = (int)gridDim.x;
  if (b0 >= 0) {
#pragma unroll 1
    for (int it = b0; it < NS + NP; it += bs) {
      if (it < NS) sg_item(p, layer, it, smem);
      else pool_item(p, layer, it - NS, smem);
    }
  }
}

#define XB_TMO      128
#define XB_XCNT(j)  (256  + 64 * (j))
#define XB_XSUB(j)  (1280 + 64 * (j))
#define XB_XGEN(j)  (2304 + 64 * (j))
#define XB_TOP      3328
#define XB_TOPGEN   3392
#define XCD_BAR_WORDS 3456
#define XB_SPIN_CAP (1u << 22)
__device__ __forceinline__ unsigned xb_ld(unsigned* q)              { return __hip_atomic_load(q, __ATOMIC_RELAXED, __HIP_MEMORY_SCOPE_AGENT); }
__device__ __forceinline__ unsigned xb_add(unsigned* q, unsigned v) { return __hip_atomic_fetch_add(q, v, __ATOMIC_RELAXED, __HIP_MEMORY_SCOPE_AGENT); }
__device__ __forceinline__ unsigned xb_xcc_id() { return (unsigned)__builtin_amdgcn_s_getreg((3 << 11) | 20) & 0xFu; }
#define XB_SPIN(cond, bar) do { unsigned _sp = 0; while (cond) { __builtin_amdgcn_s_sleep(1); \
    if ((++_sp & 255u) == 0u) { if (xb_ld(&(bar)[XB_TMO])) break; if (_sp > XB_SPIN_CAP) { atomicAdd(&(bar)[XB_TMO], 1u); break; } } } } while (0)
struct XcdBarrier { unsigned* bar; unsigned x; volatile LAS unsigned* st; };
__device__ __forceinline__ XcdBarrier xcd_barrier_post(unsigned* bar, volatile LAS unsigned* st) {
  XcdBarrier b; b.bar = bar; b.x = xb_xcc_id(); b.st = st;
  if (threadIdx.x == 0) (void)xb_add(&bar[XB_XCNT(b.x)], 1u);
  return b;
}
__device__ __forceinline__ void xcd_barrier_complete(unsigned* bar, unsigned x, unsigned& nloc, unsigned& nx) {
  const unsigned G = gridDim.x * gridDim.y * gridDim.z;
  unsigned sum, cnt, mine, sp = 0u;
  for (;;) {
    sum = 0u; cnt = 0u; mine = 0u;
#pragma unroll
    for (unsigned j = 0; j < 16; ++j) { const unsigned c = xb_ld(&bar[XB_XCNT(j)]); sum += c; cnt += (c > 0u) ? 1u : 0u; mine = (j == x) ? c : mine; }
    if (sum == G) break;
    __builtin_amdgcn_s_sleep(1);
    if ((++sp & 255u) == 0u) { if (xb_ld(&bar[XB_TMO])) break; if (sp > XB_SPIN_CAP) { atomicAdd(&bar[XB_TMO], 1u); break; } }
  }
  nloc = mine > 0u ? mine : 1u; nx = cnt > 0u ? cnt : 1u;
}
__device__ __forceinline__ void xcd_barrier(const XcdBarrier& b) {
  asm volatile("s_waitcnt vmcnt(0)" ::: "memory");
  __syncthreads();
  if (threadIdx.x == 0) {
    unsigned* bar = b.bar;
    __builtin_amdgcn_s_waitcnt(0);
    unsigned nloc = b.st[0], nx = b.st[1];
    if (nloc == 0u) { xcd_barrier_complete(bar, b.x, nloc, nx); b.st[0] = nloc; b.st[1] = nx; }
    const unsigned old = xb_add(&bar[XB_XSUB(b.x)], 1u);
    const unsigned gen = old / nloc;
    if (old + 1u == (gen + 1u) * nloc) {
      __builtin_amdgcn_fence(__ATOMIC_RELEASE, "agent");
      asm volatile("s_waitcnt vmcnt(0)" ::: "memory");
      const unsigned og = xb_add(&bar[XB_TOP], 1u);
      const unsigned tg = og / nx;
      if (og + 1u == (tg + 1u) * nx) xb_add(&bar[XB_TOPGEN], 1u);
      else XB_SPIN(xb_ld(&bar[XB_TOPGEN]) == tg, bar);
      __builtin_amdgcn_fence(__ATOMIC_ACQUIRE, "agent");
      xb_add(&bar[XB_XGEN(b.x)], 1u);
      asm volatile("s_waitcnt vmcnt(0)" ::: "memory");
    } else {
      XB_SPIN(xb_ld(&bar[XB_XGEN(b.x)]) == gen, bar);
      __builtin_amdgcn_fence(__ATOMIC_ACQUIRE, "agent");
      asm volatile("s_waitcnt vmcnt(0)" ::: "memory");
    }
  }
  __syncthreads();
}

__device__ __forceinline__ void run_phase(const Params& p, int layer, int sub, unsigned char* smem) {
  switch (sub) {
    case 0: phase_prep(p, layer, smem); break;
    case 1: phase_g1(p, layer, smem); break;
    case 2: for (int j = blockIdx.x; j < 1536; j += gridDim.x) rwkv_job<false>(p, layer, j, smem); break;
    case 3: phase_bmix(p, layer, smem); break;
    case 4: for (int j = blockIdx.x; j < 1536; j += gridDim.x) rwkv_job<true>(p, layer, j, smem); attn_combine(p); break;
    case 5: phase_branch(p, smem); break;
    case 6: phase_gate(p, layer, smem); break;
    case 7: phase_out(p, layer, smem); break;
  }
}
__global__ void __launch_bounds__(256, 2) mega(Params p) {
  extern __shared__ __attribute__((aligned(16))) unsigned char smem[];
  cg::grid_group grid = cg::this_grid();
  volatile LAS unsigned* bst = (volatile LAS unsigned*)((LAS unsigned char*)smem + 73728);
  if (threadIdx.x < 4) bst[threadIdx.x] = 0u;
  __syncthreads();
  const XcdBarrier xbar = xcd_barrier_post(p.bar, bst);
  for (int ph = p.phase_lo; ph < p.phase_hi; ++ph) {
    const int layer = ph / NPH, sub = ph % NPH;
#if PROBE_MASK
    for (int rep = (PROBE_MASK >> sub) & 1; rep >= 0; --rep) {
      __syncthreads(); if (get_tid() == 0) s_dry = rep; __syncthreads();
      run_phase(p, layer, sub, smem);
      if (rep) grid.sync();
    }
#else
    run_phase(p, layer, sub, smem);
#endif
    if (ph + 1 < p.phase_hi) { if (ph == p.phase_lo) grid.sync(); else xcd_barrier(xbar); }
  }
}

extern "C" void kernel_launch(void* const* d_in, const int* in_sizes, int n_in, void* d_out, int out_size, void* d_ws, size_t ws_size, hipStream_t stream) {
  static int grid_blocks = 0;
  if (!grid_blocks) {
    hipFuncSetAttribute((const void*)mega, hipFuncAttributeMaxDynamicSharedMemorySize, SMEM_BYTES);
    int dev = 0, cus = 0, per_cu = 0;
    hipGetDevice(&dev);
    hipDeviceGetAttribute(&cus, hipDeviceAttributeMultiprocessorCount, dev);
    hipOccupancyMaxActiveBlocksPerMultiprocessor(&per_cu, mega, 256, SMEM_BYTES);
    if (per_cu < 1) per_cu = 1;
    grid_blocks = cus * per_cu;
  }
  Params p{};
  p.xp = (const float*)d_in[0]; p.xs = (const float*)d_in[1];
  p.norm_g = (const float*)d_in[2]; p.w_in = (const float*)d_in[3]; p.q_norm_g = (const float*)d_in[4]; p.k_norm_g = (const float*)d_in[5];
  p.pool_w = (const float*)d_in[6]; p.pool_scale = (const float*)d_in[7]; p.sg_norm_g = (const float*)d_in[8]; p.sg_w = (const float*)d_in[9]; p.sg_b = (const float*)d_in[10];
  p.mu_rkv = (const float*)d_in[11]; p.mu_lat = (const float*)d_in[12]; p.w0 = (const float*)d_in[13]; p.w_up = (const float*)d_in[14]; p.a0 = (const float*)d_in[15]; p.a_up = (const float*)d_in[16];
  p.k_k = (const float*)d_in[17]; p.k_a = (const float*)d_in[18]; p.r_k = (const float*)d_in[19]; p.ln_g = (const float*)d_in[20]; p.ln_b = (const float*)d_in[21];
  p.w_branch = (const float*)d_in[22]; p.w_out = (const float*)d_in[23];
  p.out = (float*)d_out;
  unsigned char* ws = (unsigned char*)d_ws;
  size_t off = 0;
  p.qkv = (bf16_t*)(ws + off); off += (size_t)MTOK * QKVW * 2;
  p.rest = (bf16_t*)(ws + off); off += (size_t)MTOK * RESTW * 2;
  p.ys = (bf16_t*)(ws + off); off += (size_t)MTOK * 1024 * 2;
  p.w1t = (bf16_t*)(ws + off); off += (size_t)5120 * 1024 * 2;
  p.wgt = (bf16_t*)(ws + off); off += (size_t)4096 * 1024 * 2;
  p.wbrt = (bf16_t*)(ws + off); off += (size_t)4096 * 256 * 2;
  p.woutt = (bf16_t*)(ws + off); off += (size_t)1024 * 1024 * 2;
  p.rstd = nullptr;
  p.xb = (bf16_t*)(ws + off); off += (size_t)MTOK * 1024 * 2;
  p.pnum = (bf16_t*)(ws + off); off += (size_t)3 * MTOK * 256 * 2;
  p.pden = (float*)p.w1t;
  p.pg = (float*)(ws + off); off += (size_t)3072 * 8192 * 4;
  p.bar = (unsigned*)(ws + off); off += (size_t)XCD_BAR_WORDS * 4;
  p.branch = p.qkv;
  if (off > ws_size) { fprintf(stderr, "workspace too small: need %zu have %zu\n", off, ws_size); return; }
  (void)hipMemsetAsync(p.bar, 0, (size_t)XCD_BAR_WORDS * 4, stream);
#if MULTI_LAUNCH
  for (int ph = 0; ph < 2 * NPH; ++ph) {
    p.phase_lo = ph; p.phase_hi = ph + 1;
    hipLaunchKernelGGL(mega, dim3(grid_blocks), dim3(256), SMEM_BYTES, stream, p);
  }
#else
  p.phase_lo = 0; p.phase_hi = 2 * NPH;
  void* args[] = {&p};
  hipError_t e = hipLaunchCooperativeKernel((void*)mega, dim3(grid_blocks), dim3(256), args, SMEM_BYTES, stream);
  if (e != hipSuccess) fprintf(stderr, "cooperative launch failed: %s (grid %d)\n", hipGetErrorString(e), grid_blocks);
#endif
}
```

```cpp
#include <hip/hip_runtime.h>
#include <hip/hip_cooperative_groups.h>
#include <cstdio>
namespace cg = cooperative_groups;

#ifndef PROBE_MASK
#define PROBE_MASK 0
#endif
#ifndef PROBE_NOGL
#define PROBE_NOGL 0
#endif
#if PROBE_MASK
__shared__ int s_dry;
#define DRY(p) (s_dry)
#define NOGL (PROBE_NOGL && s_dry)
#else
#define DRY(p) 0
#define NOGL 0
#endif
#ifndef MULTI_LAUNCH
#define MULTI_LAUNCH 0
#endif

typedef unsigned short bf16_t;
typedef short bf16x8 __attribute__((ext_vector_type(8)));
typedef float f32x4 __attribute__((ext_vector_type(4)));
typedef unsigned u32x4 __attribute__((ext_vector_type(4)));
typedef float f32x2 __attribute__((ext_vector_type(2)));
typedef __bf16 bf2v __attribute__((ext_vector_type(2)));

constexpr int MTOK = 49152;
constexpr int DM = 1024;
constexpr int PW = 9216;
constexpr int QKVW = 2304;
constexpr int RESTW = 1792;
constexpr int SMEM_BYTES = 73728 + 16;
constexpr int NPH = 8;

struct Params {
  const float* xp; const float* xs;
  const float* norm_g; const float* w_in; const float* q_norm_g; const float* k_norm_g;
  const float* pool_w; const float* pool_scale; const float* sg_norm_g; const float* sg_w; const float* sg_b;
  const float* mu_rkv; const float* mu_lat; const float* w0; const float* w_up; const float* a0; const float* a_up;
  const float* k_k; const float* k_a; const float* r_k; const float* ln_g; const float* ln_b;
  const float* w_branch; const float* w_out;
  float* out;
  bf16_t* qkv; bf16_t* rest; bf16_t* ys;
  bf16_t* w1t; bf16_t* wgt; bf16_t* wbrt; bf16_t* woutt;
  float* rstd; float* pg; bf16_t* branch; bf16_t* xb; bf16_t* pnum; float* pden; unsigned* bar;
  int phase_lo, phase_hi;
  int dry, pad_;
};

__device__ __forceinline__ int get_tid() { int t = threadIdx.x; asm volatile("" : "+v"(t)); return t; }
__device__ __forceinline__ float bf2f(bf16_t v) { return __uint_as_float(((unsigned)v) << 16); }
__device__ __forceinline__ bf16_t f2bf(float f) { unsigned u = __float_as_uint(f); u += 0x7fffu + ((u >> 16) & 1u); return (bf16_t)(u >> 16); }
__device__ __forceinline__ unsigned pack2(float a, float b) { return (unsigned)f2bf(a) | ((unsigned)f2bf(b) << 16); }
__device__ __forceinline__ float sigmoidf_(float x) { return __builtin_amdgcn_rcpf(1.f + __expf(-x)); }
__device__ __forceinline__ float dpp_qx1(float v) { return __int_as_float(__builtin_amdgcn_update_dpp(0, __float_as_int(v), 0xB1, 0xF, 0xF, true)); }
__device__ __forceinline__ float dpp_qx2(float v) { return __int_as_float(__builtin_amdgcn_update_dpp(0, __float_as_int(v), 0x4E, 0xF, 0xF, true)); }
__device__ __forceinline__ float dpp_hm(float v) { return __int_as_float(__builtin_amdgcn_update_dpp(0, __float_as_int(v), 0x141, 0xF, 0xF, true)); }
__device__ __forceinline__ float wave_sum(float v) {
  v += __int_as_float(__builtin_amdgcn_update_dpp(0, __float_as_int(v), 0xB1, 0xF, 0xF, true));
  v += __int_as_float(__builtin_amdgcn_update_dpp(0, __float_as_int(v), 0x4E, 0xF, 0xF, true));
  v += __int_as_float(__builtin_amdgcn_update_dpp(0, __float_as_int(v), 0x141, 0xF, 0xF, true));
  v += __int_as_float(__builtin_amdgcn_update_dpp(0, __float_as_int(v), 0x140, 0xF, 0xF, true));
  v += __shfl_xor(v, 16); v += __shfl_xor(v, 32);
  return v;
}
__device__ __forceinline__ const float* xrow_ptr(const Params& p, int layer, int row) {
  if (layer == 0) return row < 16384 ? p.xp + (size_t)row * DM : p.xs + (size_t)(row - 16384) * DM;
  return p.out + (size_t)row * DM;
}
__device__ __forceinline__ void seq_of(int T0, int& sstart, int& slen) {
  if (T0 < 16384) { sstart = T0 & ~8191; slen = 8192; } else { sstart = 16384 + ((T0 - 16384) & ~16383); slen = 16384; }
}

__device__ void prep_xb(const Params& p, int layer) {
  const int tid = get_tid(), lane = tid & 63;
  const int gw = (blockIdx.x * 256 + tid) >> 6, nw = gridDim.x * 4;
  for (int row = gw; row < MTOK; row += nw) {
    const float4* x = (const float4*)xrow_ptr(p, layer, row);
    float ss = 0.f;
#pragma unroll
    for (int i = 0; i < 4; ++i) { float4 v = x[lane + i * 64]; ss += v.x * v.x + v.y * v.y + v.z * v.z + v.w * v.w; }
    ss = wave_sum(ss);
    const float rs = rsqrtf(ss * (1.f / 1024.f) + 1e-6f);
#pragma unroll
    for (int i = 0; i < 4; ++i) { float4 v = x[lane + i * 64]; uint2 o; o.x = pack2(v.x * rs, v.y * rs); o.y = pack2(v.z * rs, v.w * rs); *(uint2*)(p.xb + (size_t)row * 1024 + (lane + i * 64) * 4) = o; }
  }
}

__device__ __forceinline__ int w1_col(int n) {
  if (n < 2304) return n; if (n < 2560) return 2560 + (n - 2304); if (n < 3072) return 3072 + (n - 2560);
  if (n < 3840) return 3840 + (n - 3072); if (n < 4096) return 4608 + (n - 3840);
  if (n < 4352) return 2304 + (n - 4096); if (n < 4608) return 2816 + (n - 4352);
  if (n < 4864) return 3584 + (n - 4608); return 4864 + (n - 4864);
}
__device__ __forceinline__ int wg_col(int n) {
  const int tn = n >> 8, c = n & 255, wn = c >> 7, nn = (c >> 4) & 7, dl = c & 15, dg = nn >> 2, b = nn & 3;
  return 5120 + b * 1024 + tn * 64 + wn * 32 + dg * 16 + dl;
}

__device__ void phase_prep(const Params& p, int layer, unsigned char* smem) {
  const int tid = get_tid(), lane = tid & 63, wave = tid >> 6;
  prep_xb(p, layer);
  const float* w_in = p.w_in + (size_t)layer * DM * PW;
  const float* ng = p.norm_g + layer * DM;
  const float* wb = p.w_branch + (size_t)layer * 4 * 256 * 1024;
  const float* wo = p.w_out + (size_t)layer * 1024 * 1024;
  bf16_t* T = (bf16_t*)smem;
  const int NT0 = 80 * 16, NT1 = 64 * 16, NT2 = 64 * 4, NT3 = 16 * 16;
  for (int tile = blockIdx.x; tile < NT0 + NT1 + NT2 + NT3; tile += gridDim.x) {
    int kind, tl = tile;
    if (tl < NT0) kind = 0; else if ((tl -= NT0) < NT1) kind = 1; else if ((tl -= NT1) < NT2) kind = 2; else { tl -= NT2; kind = 3; }
    const int nkt = kind == 2 ? 4 : 16;
    const int n0 = (tl / nkt) * 64, k0 = (tl % nkt) * 64;
    const int n = n0 + lane;
    const float* src; size_t ls; bf16_t* dst; int K;
    if (kind == 0) { src = w_in + w1_col(n); ls = PW; dst = p.w1t; K = 1024; }
    else if (kind == 1) { src = w_in + wg_col(n); ls = PW; dst = p.wgt; K = 1024; }
    else if (kind == 2) { src = wb + (size_t)(n >> 10) * 256 * 1024 + (n & 1023); ls = 1024; dst = p.wbrt; K = 256; }
    else { src = wo + n; ls = 1024; dst = p.woutt; K = 1024; }
    float v[16];
#pragma unroll
    for (int i = 0; i < 16; ++i) v[i] = src[(size_t)(k0 + wave * 16 + i) * ls];
    if (kind < 2) {
#pragma unroll
      for (int i = 0; i < 16; ++i) v[i] *= ng[k0 + wave * 16 + i];
    }
#pragma unroll
    for (int i = 0; i < 8; ++i) *(unsigned*)(T + lane * 72 + wave * 16 + 2 * i) = pack2(v[2 * i], v[2 * i + 1]);
    __syncthreads();
#pragma unroll
    for (int i = 0; i < 2; ++i) {
      const int id = tid + i * 256, nl = id >> 3, kc = id & 7;
      *(u32x4*)(dst + (size_t)(n0 + nl) * K + k0 + kc * 8) = *(const u32x4*)(T + nl * 72 + kc * 8);
    }
    __syncthreads();
  }
}

__device__ __forceinline__ int lds_off(int r, int c) { return r * 128 + ((c ^ ((r >> 1) & 7)) << 4); }

#define LAS __attribute__((address_space(3)))
constexpr int GSTAGE = 24576;
#define DMA16(G, L) __builtin_amdgcn_global_load_lds((const unsigned*)(G), (LAS unsigned*)(L), 16, 0, 0)
#define DMA_TILE(T, ST) { const size_t ko = (size_t)(T) * 64; LAS unsigned char* d_ = lds + (ST) * GSTAGE + ldsw; \
    DMA16(Ab + ko + voffA, d_); DMA16(Ab + ko + (voffA + 64u * lda2), d_ + 4096); \
    DMA16(Bb + ko + voffB, d_ + 8192); DMA16(Bb + ko + (voffB + 64u * ldb2), d_ + 12288); \
    DMA16(Bb + ko + (voffB + 128u * ldb2), d_ + 16384); DMA16(Bb + ko + (voffB + 192u * ldb2), d_ + 20480); }

__device__ __forceinline__ void gemm_compute(f32x4 (&acc)[4][8], const LAS unsigned char* a_, int aoff, int boff) {
  const LAS unsigned char* b_ = a_ + 8192;
  bf16x8 af[4], bfr[8];
#pragma unroll
  for (int m = 0; m < 4; ++m) af[m] = *(const LAS bf16x8*)(a_ + aoff + m * 1024);
#pragma unroll
  for (int n = 0; n < 8; ++n) bfr[n] = *(const LAS bf16x8*)(b_ + boff + n * 1024);
  asm volatile("" :: "v"(af[0]), "v"(af[1]), "v"(af[2]), "v"(af[3]));
#pragma unroll
  for (int m = 0; m < 4; ++m)
#pragma unroll
    for (int n = 0; n < 8; ++n) acc[m][n] = __builtin_amdgcn_mfma_f32_16x16x32_bf16(bfr[n], af[m], acc[m][n], 0, 0, 0);
}

#define DMA_HALF0(T, ST) { const size_t ko = (size_t)(T) * 64; LAS unsigned char* d_ = lds + (ST) * GSTAGE + ldsw; \
    DMA16(Ab + ko + voffA, d_); DMA16(Ab + ko + (voffA + 64u * lda2), d_ + 4096); DMA16(Bb + ko + voffB, d_ + 8192); }
#define DMA_HALF1(T, ST) { const size_t ko = (size_t)(T) * 64; LAS unsigned char* d_ = lds + (ST) * GSTAGE + ldsw; \
    DMA16(Bb + ko + (voffB + 64u * ldb2), d_ + 12288); DMA16(Bb + ko + (voffB + 128u * ldb2), d_ + 16384); DMA16(Bb + ko + (voffB + 192u * ldb2), d_ + 20480); }
__device__ __forceinline__ void gemm_core(f32x4 (&acc)[4][8], const bf16_t* Aptr, int lda, const bf16_t* Bt, int ldb, int K, unsigned char* smem) {
  const int tid = get_tid(), lane = tid & 63, wave = tid >> 6, wm = wave >> 1, wn = wave & 1;
  const int dl = lane & 15, gq = lane >> 4, swz = ((dl >> 3) & 1) * 3;
  const int aoff = (wm * 64 + dl) * 64 + ((gq ^ swz) << 4);
  const int boff = (wn * 128 + dl) * 64 + ((gq ^ swz) << 4);
  LAS unsigned char* lds = (LAS unsigned char*)smem;
  const int r0 = tid >> 2, csrc = (tid & 3) ^ (((r0 >> 3) & 1) * 3);
  const int ldsw = tid * 16;
  const unsigned lda2 = (unsigned)lda * 2u, ldb2 = (unsigned)ldb * 2u;
  const unsigned voffA = (unsigned)r0 * lda2 + csrc * 16, voffB = (unsigned)r0 * ldb2 + csrc * 16;
  const unsigned char* Ab = (const unsigned char*)Aptr; const unsigned char* Bb = (const unsigned char*)Bt;
  const int nt = K >> 5;
  DMA_TILE(0, 0) DMA_TILE(1, 1)
  int st = 0, st2 = 2;
#pragma unroll 1
  for (int t = 0; t < nt; ++t) {
    if (t + 1 < nt) asm volatile("s_waitcnt vmcnt(6)" ::: "memory"); else asm volatile("s_waitcnt vmcnt(0)" ::: "memory");
    asm volatile("" ::: "memory"); __builtin_amdgcn_s_barrier(); asm volatile("" ::: "memory");
    {
      const LAS unsigned char* a_ = lds + st * GSTAGE; const LAS unsigned char* b_ = a_ + 8192;
      bf16x8 af[4], bfr[8];
#pragma unroll
      for (int m = 0; m < 4; ++m) af[m] = *(const LAS bf16x8*)(a_ + aoff + m * 1024);
#pragma unroll
      for (int n = 0; n < 8; ++n) bfr[n] = *(const LAS bf16x8*)(b_ + boff + n * 1024);
      asm volatile("" :: "v"(af[0]), "v"(af[1]), "v"(af[2]), "v"(af[3]));
      __builtin_amdgcn_sched_barrier(0);
#pragma unroll
      for (int m = 0; m < 2; ++m)
#pragma unroll
        for (int n = 0; n < 8; ++n) acc[m][n] = __builtin_amdgcn_mfma_f32_16x16x32_bf16(bfr[n], af[m], acc[m][n], 0, 0, 0);
      __builtin_amdgcn_sched_barrier(0);
      if (t + 2 < nt) DMA_HALF0(t + 2, st2)
      __builtin_amdgcn_sched_barrier(0);
#pragma unroll
      for (int m = 2; m < 4; ++m)
#pragma unroll
        for (int n = 0; n < 8; ++n) acc[m][n] = __builtin_amdgcn_mfma_f32_16x16x32_bf16(bfr[n], af[m], acc[m][n], 0, 0, 0);
      __builtin_amdgcn_sched_barrier(0);
      if (t + 2 < nt) DMA_HALF1(t + 2, st2)
    }
    st = st == 2 ? 0 : st + 1; st2 = st2 == 2 ? 0 : st2 + 1;
  }
  asm volatile("" ::: "memory"); __builtin_amdgcn_s_barrier(); asm volatile("" ::: "memory");
}

__device__ __forceinline__ void zero_acc(f32x4 (&acc)[4][8]) {
#pragma unroll
  for (int m = 0; m < 4; ++m)
#pragma unroll
    for (int n = 0; n < 8; ++n) acc[m][n] = (f32x4){0.f, 0.f, 0.f, 0.f};
}

__device__ __forceinline__ bool tile_of(int it, int ntn, int& tm, int& tn) {
  if (gridDim.x == 256 || gridDim.x == 512) {
    const int xcd = blockIdx.x & 7, s = blockIdx.x >> 3;
    const int gmh = gridDim.x == 512 ? 16 : 8;
    const int gn_cnt = ntn >> 2, g = it * 8 + xcd;
    if (g >= (384 / gmh) * gn_cnt) return false;
    const int gm = g / gn_cnt, gn = g % gn_cnt;
    tm = gm * gmh + (s & (gmh - 1)); tn = gn * 4 + s / gmh;
    return true;
  }
  const int tile = blockIdx.x + it * gridDim.x;
  if (tile >= 384 * ntn) return false;
  tm = tile / ntn; tn = tile % ntn; return true;
}

__device__ void phase_g1(const Params& p, int layer, unsigned char* smem) {
  const int lane = get_tid() & 63, wave = get_tid() >> 6, wm = wave >> 1, wn = wave & 1;
  int tm, tn;
  for (int it = 0; tile_of(it, 20, tm, tn); ++it) {
    const int row0 = tm * 128, col0 = tn * 256;
    f32x4 acc[4][8]; zero_acc(acc);
    gemm_core(acc, p.xb + (size_t)row0 * 1024, 1024, p.w1t + (size_t)col0 * 1024, 1024, 1024, smem);
    if (col0 < 1536) {
      const float* gn = (col0 < 768 ? p.q_norm_g : p.k_norm_g) + layer * 64;
      const float sc = col0 < 768 ? 0.125f : 1.f;
#pragma unroll
      for (int m = 0; m < 4; ++m)
#pragma unroll
        for (int hh = 0; hh < 2; ++hh) {
          float ss = 0.f;
#pragma unroll
          for (int n = 0; n < 4; ++n)
#pragma unroll
            for (int j = 0; j < 4; ++j) ss += acc[m][hh * 4 + n][j] * acc[m][hh * 4 + n][j];
          ss += __shfl_xor(ss, 16); ss += __shfl_xor(ss, 32);
          const float rs = rsqrtf(ss * (1.f / 64.f) + 1e-6f) * sc;
#pragma unroll
          for (int n = 0; n < 4; ++n) {
            const f32x4 gv = *(const f32x4*)(gn + n * 16 + (lane >> 4) * 4);
#pragma unroll
            for (int j = 0; j < 4; ++j) acc[m][hh * 4 + n][j] *= rs * gv[j];
          }
        }
    }
    {
      unsigned char* wl = smem + wave * 17408;
      const bool act = col0 >= 4096;
#pragma unroll
      for (int m = 0; m < 4; ++m)
#pragma unroll
        for (int n = 0; n < 8; ++n) {
          float v0 = acc[m][n][0], v1 = acc[m][n][1], v2 = acc[m][n][2], v3 = acc[m][n][3];
          if (act) { v0 *= sigmoidf_(v0); v1 *= sigmoidf_(v1); v2 *= sigmoidf_(v2); v3 *= sigmoidf_(v3); }
          uint2 o; o.x = pack2(v0, v1); o.y = pack2(v2, v3);
          *(uint2*)(wl + (m * 16 + (lane & 15)) * 272 + (n * 16 + (lane >> 4) * 4) * 2) = o;
        }
      bf16_t* dst; int ld;
      if (col0 < QKVW) { dst = p.qkv + col0; ld = QKVW; }
      else if (col0 < 4096) { dst = p.rest + (col0 - QKVW); ld = RESTW; }
      else { dst = p.ys + (col0 - 4096); ld = 1024; }
      dst += (size_t)(row0 + wm * 64) * ld + wn * 128;
#pragma unroll
      for (int i = 0; i < 16; ++i) {
        const int id = i * 64 + lane, r = id >> 4, c16 = id & 15;
        const u32x4 v = *(const u32x4*)(wl + r * 272 + c16 * 16);
        *(u32x4*)(dst + (size_t)r * ld + c16 * 8) = v;
      }
    }
    __syncthreads();
  }
}

__device__ void phase_branch(const Params& p, unsigned char* smem) {
  const int lane = get_tid() & 63, wave = get_tid() >> 6, wm = wave >> 1, wn = wave & 1;
  int tm, tn;
  for (int it = 0; tile_of(it, 16, tm, tn); ++it) {
    const int row0 = tm * 128, col0 = tn * 256, b = tn >> 2;
    f32x4 acc[4][8]; zero_acc(acc);
    gemm_core(acc, p.ys + (size_t)row0 * 1024 + b * 256, 1024, p.wbrt + (size_t)col0 * 256, 256, 256, smem);
#pragma unroll
    for (int m = 0; m < 4; ++m) {
      const int row = row0 + wm * 64 + m * 16 + (lane & 15);
#pragma unroll
      for (int n = 0; n < 8; ++n) {
        const int colt = col0 + wn * 128 + n * 16, bb = colt >> 10, d16 = (colt & 1023) >> 4;
        uint2 o; o.x = pack2(acc[m][n][0], acc[m][n][1]); o.y = pack2(acc[m][n][2], acc[m][n][3]);
        *(uint2*)(p.branch + ((((((size_t)tm * 2 + wm) * 4 + m) * 4 + bb) * 64 + d16) * 64 + lane) * 4) = o;
      }
    }
  }
}

__device__ void phase_gate(const Params& p, int layer, unsigned char* smem) {
  const int lane = get_tid() & 63, wave = get_tid() >> 6, wm = wave >> 1, wn = wave & 1;
  int tm, tn;
  for (int it = 0; tile_of(it, 16, tm, tn); ++it) {
    const int row0 = tm * 128;
    f32x4 acc[4][8]; zero_acc(acc);
    gemm_core(acc, p.xb + (size_t)row0 * 1024, 1024, p.wgt + (size_t)tn * 256 * 1024, 1024, 1024, smem);
#pragma unroll
    for (int m = 0; m < 4; ++m) {
      const int row = row0 + wm * 64 + m * 16 + (lane & 15);
#pragma unroll
      for (int dg = 0; dg < 2; ++dg) {
        const int d = tn * 64 + wn * 32 + dg * 16 + (lane >> 4) * 4;
        float s0 = 0.f, s1 = 0.f, s2 = 0.f, s3 = 0.f;
#pragma unroll
        for (int b = 0; b < 4; ++b) {
          uint2 br = *(const uint2*)(p.branch + ((((((size_t)tm * 2 + wm) * 4 + m) * 4 + b) * 64 + (tn * 4 + wn * 2 + dg)) * 64 + lane) * 4);
          s0 += sigmoidf_(acc[m][dg * 4 + b][0]) * __uint_as_float(br.x << 16);
          s1 += sigmoidf_(acc[m][dg * 4 + b][1]) * __uint_as_float(br.x & 0xffff0000u);
          s2 += sigmoidf_(acc[m][dg * 4 + b][2]) * __uint_as_float(br.y << 16);
          s3 += sigmoidf_(acc[m][dg * 4 + b][3]) * __uint_as_float(br.y & 0xffff0000u);
        }
        uint2 o; o.x = pack2(s0, s1); o.y = pack2(s2, s3);
        *(uint2*)(p.ys + (size_t)row * 1024 + d) = o;
        asm volatile("" ::: "memory");
      }
    }
  }
}

__device__ void phase_out(const Params& p, int layer, unsigned char* smem) {
  const int lane = get_tid() & 63, wave = get_tid() >> 6, wm = wave >> 1, wn = wave & 1;
  int tm, tn;
  for (int it = 0; tile_of(it, 4, tm, tn); ++it) {
    const int row0 = tm * 128, col0 = tn * 256;
    f32x4 acc[4][8]; zero_acc(acc);
    gemm_core(acc, p.ys + (size_t)row0 * 1024, 1024, p.woutt + (size_t)col0 * 1024, 1024, 1024, smem);
#pragma unroll
    for (int m = 0; m < 4; ++m) {
      const int row = row0 + wm * 64 + m * 16 + (lane & 15);
      const float* xr = xrow_ptr(p, layer, row);
#pragma unroll
      for (int n = 0; n < 8; ++n) {
        const int col = col0 + wn * 128 + n * 16 + (lane >> 4) * 4;
        float4 xv = *(const float4*)(xr + col);
        float4 o; o.x = xv.x + acc[m][n][0]; o.y = xv.y + acc[m][n][1]; o.z = xv.z + acc[m][n][2]; o.w = xv.w + acc[m][n][3];
        if (!DRY(p)) *(float4*)(p.out + (size_t)row * 1024 + col) = o;
      }
    }
  }
}

constexpr int QS_STRIDE = 144, KS_STRIDE = 144, VT_STRIDE = 432;
struct AttnRaw { u32x4 q0, q1, ka0, kb0, va0, vb0, ka1, kb1, va1, vb1, ka2, kb2, va2, vb2, ka3, kb3, va3, vb3; };
__device__ __forceinline__ void attn_issue(const Params& p, int item, AttnRaw& R) {
  const int tid = get_tid();
  const int n = item % 12, run = item / 12, T0 = run * 64;
  const int g = n >> 2, d = g == 0 ? 1 : (g == 1 ? 4 : 16);
  int sstart, slen; seq_of(T0, sstart, slen);
  const int rho = (T0 - sstart) >> 6;
  const int r = rho % d, i0 = (rho / d) * 64;
  const int part = tid & 3;
  {
    const int q = tid >> 2;
    const int pq = d * (i0 + q) + r;
    const bf16_t* base = p.qkv + (size_t)(sstart + pq) * QKVW + n * 64 + part * 16;
    R.q0 = *(const u32x4*)base; R.q1 = *(const u32x4*)(base + 8);
  }
#define ATTN_ISSUE1(IT, KA, KB, VA, VB) { const int rr = (tid >> 2) + (IT) * 64; const int pos = d * (i0 - 64 + rr) + r; \
    const bool ok = rr < 192 && pos >= 0 && pos < slen; const u32x4 z = {0u, 0u, 0u, 0u}; KA = z; KB = z; VA = z; VB = z; \
    if (ok) { const bf16_t* base = p.qkv + (size_t)(sstart + pos) * QKVW + n * 64 + part * 16; \
      KA = *(const u32x4*)(base + 768); KB = *(const u32x4*)(base + 768 + 8); VA = *(const u32x4*)(base + 1536); VB = *(const u32x4*)(base + 1536 + 8); } }
  ATTN_ISSUE1(0, R.ka0, R.kb0, R.va0, R.vb0)
  ATTN_ISSUE1(1, R.ka1, R.kb1, R.va1, R.vb1)
  ATTN_ISSUE1(2, R.ka2, R.kb2, R.va2, R.vb2)
}

__device__ __forceinline__ void attn_item(const Params& p, int layer, int item, AttnRaw& R, int next_item, unsigned char* smem) {
  const int tid = get_tid(), lane = tid & 63, w = tid >> 6;
  const int n = item % 12, run = item / 12, T0 = run * 64;
  const int g = n >> 2, h = n & 3, d = g == 0 ? 1 : (g == 1 ? 4 : 16);
  int sstart, slen; seq_of(T0, sstart, slen);
  const int rho = (T0 - sstart) >> 6;
  const int r = rho % d, i0 = (rho / d) * 64;
  unsigned char* Qs = smem;
  unsigned char* Ks = smem + 64 * QS_STRIDE;
  unsigned char* Vt = Ks + 208 * KS_STRIDE;
  const float* kg = p.k_norm_g + layer * 64;
  const float* qg = p.q_norm_g + layer * 64;
  const int part = tid & 3;
  {
    const int q = tid >> 2;
    *(u32x4*)(Qs + q * QS_STRIDE + part * 32) = R.q0;
    *(u32x4*)(Qs + q * QS_STRIDE + part * 32 + 16) = R.q1;
  }
#define ATTN_PUT1(IT, KA, KB, VA, VB) { const int rr = (tid >> 2) + (IT) * 64; \
    if (rr < 208) { *(u32x4*)(Ks + rr * KS_STRIDE + part * 32) = KA; *(u32x4*)(Ks + rr * KS_STRIDE + part * 32 + 16) = KB; \
      const unsigned vw[8] = {VA[0], VA[1], VA[2], VA[3], VB[0], VB[1], VB[2], VB[3]}; \
      _Pragma("unroll") for (int j = 0; j < 8; ++j) { \
        *(bf16_t*)(Vt + (part * 16 + 2 * j) * VT_STRIDE + rr * 2) = (bf16_t)(vw[j] & 0xffffu); \
        *(bf16_t*)(Vt + (part * 16 + 2 * j + 1) * VT_STRIDE + rr * 2) = (bf16_t)(vw[j] >> 16); } } }
  ATTN_PUT1(0, R.ka0, R.kb0, R.va0, R.vb0)
  ATTN_PUT1(1, R.ka1, R.kb1, R.va1, R.vb1)
  ATTN_PUT1(2, R.ka2, R.kb2, R.va2, R.vb2)
  if (next_item >= 0) attn_issue(p, next_item, R);
  __syncthreads();
  const int dl = lane & 15, gq = lane >> 4;
  bf16x8 qf0 = *(const bf16x8*)(Qs + (16 * w + dl) * QS_STRIDE + gq * 16);
  bf16x8 qf1 = *(const bf16x8*)(Qs + (16 * w + dl) * QS_STRIDE + 64 + gq * 16);
  const float slope = exp2f(-8.f * (float)(n + 1) / 12.f) * (float)d;
  float pv[10][4];
  float dsum = 0.f;
#pragma unroll
  for (int j = 0; j < 4; ++j) pv[9][j] = 0.f;
#pragma unroll
  for (int t = 0; t < 9; ++t) {
    const unsigned char* kp = Ks + ((w + t) * 16 + dl) * KS_STRIDE + gq * 16;
    f32x4 sacc = {0.f, 0.f, 0.f, 0.f};
    sacc = __builtin_amdgcn_mfma_f32_16x16x32_bf16(*(const bf16x8*)kp, qf0, sacc, 0, 0, 0);
    sacc = __builtin_amdgcn_mfma_f32_16x16x32_bf16(*(const bf16x8*)(kp + 64), qf1, sacc, 0, 0, 0);
#pragma unroll
    for (int j = 0; j < 4; ++j) {
      const int m = 16 * t + 4 * gq + j - dl;
      const int kr = (w + t) * 16 + 4 * gq + j;
      const int pos = d * (i0 - 64 + kr) + r;
      const bool ok = m >= 0 && m <= 128 && pos >= 0 && pos < slen;
      const float e = ok ? __expf(sacc[j] - slope * fabsf((float)(m - 64))) : 0.f;
      pv[t][j] = e; dsum += e;
    }
  }
  f32x4 oacc[4];
#pragma unroll
  for (int dt = 0; dt < 4; ++dt) oacc[dt] = (f32x4){0.f, 0.f, 0.f, 0.f};
#pragma unroll
  for (int u = 0; u < 5; ++u) {
    union { bf16x8 v; unsigned uu[4]; } pb;
    pb.uu[0] = pack2(pv[2 * u][0], pv[2 * u][1]); pb.uu[1] = pack2(pv[2 * u][2], pv[2 * u][3]);
    pb.uu[2] = pack2(pv[2 * u + 1][0], pv[2 * u + 1][1]); pb.uu[3] = pack2(pv[2 * u + 1][2], pv[2 * u + 1][3]);
#pragma unroll
    for (int dt = 0; dt < 4; ++dt) {
      const unsigned char* vp = Vt + (dt * 16 + dl) * VT_STRIDE + ((w + 2 * u) * 16 + 4 * gq) * 2;
      union { bf16x8 v; uint2 h2[2]; } va;
      va.h2[0] = *(const uint2*)vp; va.h2[1] = u < 4 ? *(const uint2*)(vp + 32) : make_uint2(0u, 0u);
      oacc[dt] = __builtin_amdgcn_mfma_f32_16x16x32_bf16(va.v, pb.v, oacc[dt], 0, 0, 0);
    }
  }
  dsum += __shfl_xor(dsum, 16); dsum += __shfl_xor(dsum, 32);
  {
    const int ql = 16 * w + dl;
    const size_t tok = (size_t)(sstart + d * (i0 + ql) + r);
    bf16_t* np = p.pnum + (size_t)g * ((size_t)MTOK * 256) + (tok * 4 + h) * 64 + 4 * gq;
#pragma unroll
    for (int dt = 0; dt < 4; ++dt) { uint2 o; o.x = pack2(oacc[dt][0], oacc[dt][1]); o.y = pack2(oacc[dt][2], oacc[dt][3]); *(uint2*)(np + dt * 16) = o; }
    if (gq == 0) p.pden[(size_t)g * ((size_t)MTOK * 4) + tok * 4 + h] = dsum;
  }
  __syncthreads();
}

__device__ void attn_combine(const Params& p) {
  const size_t nvec = (size_t)MTOK * 64;
  for (size_t i = (size_t)blockIdx.x * 256 + get_tid(); i < nvec; i += (size_t)gridDim.x * 256) {
    const size_t th = i >> 4;
    const int e4 = (int)(i & 15);
    f32x4 a, b, c;
    { const uint2 u0 = *(const uint2*)(p.pnum + i * 4), u1 = *(const uint2*)(p.pnum + (size_t)MTOK * 256 + i * 4), u2 = *(const uint2*)(p.pnum + 2 * (size_t)MTOK * 256 + i * 4);
      a[0] = __uint_as_float(u0.x << 16); a[1] = __uint_as_float(u0.x & 0xffff0000u); a[2] = __uint_as_float(u0.y << 16); a[3] = __uint_as_float(u0.y & 0xffff0000u);
      b[0] = __uint_as_float(u1.x << 16); b[1] = __uint_as_float(u1.x & 0xffff0000u); b[2] = __uint_as_float(u1.y << 16); b[3] = __uint_as_float(u1.y & 0xffff0000u);
      c[0] = __uint_as_float(u2.x << 16); c[1] = __uint_as_float(u2.x & 0xffff0000u); c[2] = __uint_as_float(u2.y << 16); c[3] = __uint_as_float(u2.y & 0xffff0000u); }
    const float den = p.pden[th] + p.pden[(size_t)MTOK * 4 + th] + p.pden[2 * (size_t)MTOK * 4 + th];
    const float inv = 1.f / den;
    const size_t tok = th >> 2; const int h = (int)(th & 3);
    bf16_t* y = p.ys + tok * 1024 + h * 64 + e4 * 4;
    uint2 yv = *(const uint2*)y;
    float y0 = __uint_as_float(yv.x << 16), y1 = __uint_as_float(yv.x & 0xffff0000u), y2 = __uint_as_float(yv.y << 16), y3 = __uint_as_float(yv.y & 0xffff0000u);
    uint2 o; o.x = pack2(y0 * (a[0] + b[0] + c[0]) * inv, y1 * (a[1] + b[1] + c[1]) * inv); o.y = pack2(y2 * (a[2] + b[2] + c[2]) * inv, y3 * (a[3] + b[3] + c[3]) * inv);
    if (!DRY(p)) *(uint2*)y = o;
  }
}

__device__ void pool_item(const Params& p, int layer, int item, unsigned char* smem) {
  const int tid = get_tid(), lane = tid & 63, wave = tid >> 6, dl = lane & 15, gq = lane >> 4;
  const int g = item & 3, T0 = (item >> 2) * 64;
  int sstart, slen; seq_of(T0, sstart, slen);
  const int P0 = T0 - sstart;
  const int hw = 1 << g;
  float* u = (float*)smem;
  bf16_t* db = (bf16_t*)(u + 80 * 64);
  for (int i = tid; i < 80 * 64; i += 256) {
    const int rr = i >> 6, c = i & 63, pos = P0 - 8 + rr;
    u[i] = (pos >= 0 && pos < slen) ? bf2f(p.rest[(size_t)(sstart + pos) * RESTW + g * 64 + c]) : 0.f;
  }
  const float* pw = p.pool_w + ((size_t)layer * 4 + g) * 4096 + 16 * wave + dl;
  bf16x8 af[2];
#pragma unroll
  for (int ks = 0; ks < 2; ++ks) {
    union { bf16x8 v; unsigned uu[4]; } f;
#pragma unroll
    for (int e = 0; e < 4; ++e) { const int c = ks * 32 + gq * 8 + 2 * e; f.uu[e] = pack2(pw[c * 64], pw[(c + 1) * 64]); }
    af[ks] = f.v;
  }
  __syncthreads();
  for (int i = tid; i < 64 * 64; i += 256) {
    const int t = i >> 6, c = i & 63, pos = P0 + t;
    float sm = 0.f;
    for (int o = -hw; o < hw; ++o) sm += u[(t + 8 + o) * 64 + c];
    const int lo = pos - hw > 0 ? pos - hw : 0, hi = pos + hw < slen ? pos + hw : slen;
    db[t * 72 + c] = f2bf(sm / (float)(hi - lo) - u[(t + 8) * 64 + c]);
  }
  __syncthreads();
  const f32x4 sc = *(const f32x4*)(p.pool_scale + layer * 256 + g * 64 + 16 * wave + 4 * gq);
#pragma unroll
  for (int tt = 0; tt < 4; ++tt) {
    f32x4 acc = {0.f, 0.f, 0.f, 0.f};
#pragma unroll
    for (int ks = 0; ks < 2; ++ks) {
      const bf16x8 bd = *(const bf16x8*)(db + (tt * 16 + dl) * 72 + ks * 32 + gq * 8);
      acc = __builtin_amdgcn_mfma_f32_16x16x32_bf16(af[ks], bd, acc, 0, 0, 0);
    }
    bf16_t* y = p.ys + (size_t)(T0 + tt * 16 + dl) * 1024 + 256 + g * 64 + 16 * wave + 4 * gq;
    const uint2 yv = *(const uint2*)y;
    uint2 o;
    o.x = pack2(__uint_as_float(yv.x << 16) * acc[0] * sc[0], __uint_as_float(yv.x & 0xffff0000u) * acc[1] * sc[1]);
    o.y = pack2(__uint_as_float(yv.y << 16) * acc[2] * sc[2], __uint_as_float(yv.y & 0xffff0000u) * acc[3] * sc[3]);
    if (!DRY(p)) *(uint2*)y = o;
  }
  __syncthreads();
}

__device__ void sg_item(const Params& p, int layer, int item, unsigned char* smem) {
  const int tid = get_tid(), lane = tid & 63, wave = tid >> 6, dl = lane & 15, gq = lane >> 4;
  const int g = item & 3, T0 = (item >> 2) * 128;
  bf16_t* vnT = (bf16_t*)smem;
  for (int s_ = wave; s_ < 128; s_ += 4) {
    const bf16_t* vr = p.rest + (size_t)(T0 + s_) * RESTW + 512;
    float ss = 0.f; float mine = 0.f;
#pragma unroll
    for (int j = 0; j < 4; ++j) { float v = bf2f(vr[j * 64 + lane]); ss += v * v; if (j == g) mine = v; }
    ss = wave_sum(ss);
    const float rs = rsqrtf(ss * (1.f / 256.f) + 1e-6f);
    vnT[lane * 136 + s_] = f2bf(mine * rs * p.sg_norm_g[layer * 256 + g * 64 + lane]);
  }
  __syncthreads();
  const float* gw = p.sg_w + ((size_t)layer * 4 + g) * 128 * 128;
#pragma unroll 1
  for (int tt2 = 0; tt2 < 2; ++tt2) {
    const int t = (wave * 2 + tt2) * 16 + dl;
    const float* wrow = gw + t * 128 + gq * 8;
    f32x4 acc[4];
#pragma unroll
    for (int dt = 0; dt < 4; ++dt) acc[dt] = (f32x4){0.f, 0.f, 0.f, 0.f};
#pragma unroll
    for (int ks = 0; ks < 4; ++ks) {
      const f32x4 w0 = *(const f32x4*)(wrow + ks * 32), w1 = *(const f32x4*)(wrow + ks * 32 + 4);
      union { bf16x8 v; unsigned uu[4]; } bw;
      bw.uu[0] = pack2(w0[0], w0[1]); bw.uu[1] = pack2(w0[2], w0[3]); bw.uu[2] = pack2(w1[0], w1[1]); bw.uu[3] = pack2(w1[2], w1[3]);
#pragma unroll
      for (int dt = 0; dt < 4; ++dt) {
        const bf16x8 av = *(const bf16x8*)(vnT + (dt * 16 + dl) * 136 + ks * 32 + gq * 8);
        acc[dt] = __builtin_amdgcn_mfma_f32_16x16x32_bf16(av, bw.v, acc[dt], 0, 0, 0);
      }
    }
    const float bias = p.sg_b[(layer * 4 + g) * 128 + t];
#pragma unroll
    for (int dt = 0; dt < 4; ++dt) {
      const int d0 = dt * 16 + 4 * gq;
      const uint2 uv = *(const uint2*)(p.rest + (size_t)(T0 + t) * RESTW + 256 + g * 64 + d0);
      bf16_t* y = p.ys + (size_t)(T0 + t) * 1024 + 512 + g * 64 + d0;
      const uint2 yv = *(const uint2*)y;
      uint2 o;
      o.x = pack2(__uint_as_float(yv.x << 16) * __uint_as_float(uv.x << 16) * (acc[dt][0] + bias), __uint_as_float(yv.x & 0xffff0000u) * __uint_as_float(uv.x & 0xffff0000u) * (acc[dt][1] + bias));
      o.y = pack2(__uint_as_float(yv.y << 16) * __uint_as_float(uv.y << 16) * (acc[dt][2] + bias), __uint_as_float(yv.y & 0xffff0000u) * __uint_as_float(uv.y & 0xffff0000u) * (acc[dt][3] + bias));
      if (!DRY(p)) *(uint2*)y = o;
    }
  }
  __syncthreads();
}

constexpr int SBT = 16;
struct RwkvLds {
  bf16_t twb[SBT * 72], tab[SBT * 72];
  float accw[SBT * 64], acca[SBT * 64];
  float R[SBT * 64], W[SBT * 64], K[SBT * 64], V[SBT * 64], KK[SBT * 64], B[SBT * 64];
  float ot[SBT * 64];
  float bon[SBT * 64];
};

__device__ __forceinline__ float red8(float v) { v += dpp_qx1(v); v += dpp_qx2(v); v += dpp_hm(v); return v; }
__device__ __forceinline__ float red16(float v) { v = red8(v); v += __int_as_float(__builtin_amdgcn_update_dpp(0, __float_as_int(v), 0x140, 0xF, 0xF, true)); return v; }

struct ScanOps { f32x4 w0, w1, b0, b1, kk0, kk1, k0, k1, r0, r1; float2 v; };
template <bool PASS_C>
__device__ __forceinline__ ScanOps load_ops(const RwkvLds& L, int tk, int j0, int row0) {
  ScanOps o;
  o.w0 = *(const f32x4*)(L.W + tk * 64 + j0); o.w1 = *(const f32x4*)(L.W + tk * 64 + j0 + 4);
  o.b0 = *(const f32x4*)(L.B + tk * 64 + j0); o.b1 = *(const f32x4*)(L.B + tk * 64 + j0 + 4);
  o.kk0 = *(const f32x4*)(L.KK + tk * 64 + j0); o.kk1 = *(const f32x4*)(L.KK + tk * 64 + j0 + 4);
  o.k0 = *(const f32x4*)(L.K + tk * 64 + j0); o.k1 = *(const f32x4*)(L.K + tk * 64 + j0 + 4);
  if (PASS_C) { o.r0 = *(const f32x4*)(L.R + tk * 64 + j0); o.r1 = *(const f32x4*)(L.R + tk * 64 + j0 + 4); }
  else { o.r0 = o.w0; o.r1 = o.w1; }
  o.v = *(const float2*)(L.V + tk * 64 + row0);
  return o;
}

#define RAW_LOAD(SBI) { _Pragma("unroll") for (int i = 0; i < 4; ++i) { \
      const int tau = (SBI) * SBT + wave * 4 + i; \
      const int t = dir ? (t0 + 127 - tau) : (t0 + tau); \
      const bf16_t* cr = p.rest + (size_t)t * RESTW; \
      raw[i][0] = cr[768 + cidx]; raw[i][1] = cr[1024 + cidx]; raw[i][2] = cr[1280 + cidx]; raw[i][3] = cr[1536 + dir * 128 + lane]; raw[i][4] = cr[1536 + dir * 128 + 64 + lane]; \
      if (i == 0) { const int tp = dir ? t + 1 : t - 1; const bool pv = tp >= sstart && tp < send; const bf16_t* pr = p.rest + (size_t)(pv ? tp : t) * RESTW; \
        rawp[0] = pv ? pr[768 + cidx] : (bf16_t)0; rawp[1] = pv ? pr[1024 + cidx] : (bf16_t)0; rawp[2] = pv ? pr[1280 + cidx] : (bf16_t)0; \
        rawp[3] = pv ? pr[1536 + dir * 128 + lane] : (bf16_t)0; rawp[4] = pv ? pr[1536 + dir * 128 + 64 + lane] : (bf16_t)0; } } }

template <bool PASS_C>
__device__ void rwkv_job(const Params& p, int layer, int job, unsigned char* smem) {
  RwkvLds& L = *(RwkvLds*)smem;
  const int tid = get_tid(), lane = tid & 63, wave = tid >> 6;
  const int hd = job & 3, cp = job >> 2, t0 = cp * 128;
  int sstart, slen; seq_of(t0, sstart, slen);
  const int send = sstart + slen;
  const int rp = tid >> 3, jg = tid & 7, row0 = rp * 2, j0 = jg * 8;
  float* ytg0 = p.pg + ((size_t)cp * 8 + hd) * 8192;
  float* ytg1 = p.pg + ((size_t)cp * 8 + 4 + hd) * 8192;
#pragma unroll 1
  for (int dir = 0; dir < 2; ++dir) {
    const int ld = layer * 2 + dir;
    float* slot = p.pg + ((size_t)cp * 8 + dir * 4 + hd) * 8192;
    __syncthreads();
    bf16x8 wfr[2], afr[2];
    {
      const int dl_ = lane & 15, gq_ = lane >> 4;
      const float* wsrc = p.w_up + (size_t)ld * 64 * 256 + hd * 64 + 16 * wave + dl_;
      const float* asrc = p.a_up + (size_t)ld * 64 * 256 + hd * 64 + 16 * wave + dl_;
#pragma unroll
      for (int ks = 0; ks < 2; ++ks) {
        union { bf16x8 v; unsigned u[4]; } fw, fa;
#pragma unroll
        for (int e = 0; e < 4; ++e) {
          const int m = ks * 32 + gq_ * 8 + 2 * e;
          fw.u[e] = pack2(wsrc[(size_t)m * 256], wsrc[(size_t)(m + 1) * 256]);
          fa.u[e] = pack2(asrc[(size_t)m * 256], asrc[(size_t)(m + 1) * 256]);
        }
        wfr[ks] = fw.v; afr[ks] = fa.v;
      }
    }
    f32x2 S[2][4], Pst[2][4];
#pragma unroll
    for (int rr = 0; rr < 2; ++rr)
#pragma unroll
      for (int q = 0; q < 4; ++q) {
        if (PASS_C) { S[rr][q] = *(const f32x2*)(slot + 4096 + (row0 + rr) * 64 + j0 + 2 * q); Pst[rr][q] = (f32x2){0.f, 0.f}; }
        else { S[rr][q] = (f32x2){0.f, 0.f}; Pst[rr][q] = (f32x2){(row0 + rr == j0 + 2 * q) ? 1.f : 0.f, (row0 + rr == j0 + 2 * q + 1) ? 1.f : 0.f}; }
      }
    const int cidx = hd * 64 + lane;
    const float mu_r = p.mu_rkv[ld * 768 + cidx], mu_k = p.mu_rkv[ld * 768 + 256 + cidx], mu_v = p.mu_rkv[ld * 768 + 512 + cidx];
    const float mu_w = p.mu_lat[ld * 128 + lane], mu_a = p.mu_lat[ld * 128 + 64 + lane];
    const float w0v = p.w0[ld * 256 + cidx], a0v = p.a0[ld * 256 + cidx];
    const float kkv = p.k_k[ld * 256 + cidx], kav = p.k_a[ld * 256 + cidx], rkv_ = p.r_k[ld * 256 + cidx];
    bf16_t raw[4][5], rawp[5];
    RAW_LOAD(0)
#pragma unroll 1
    for (int sb = 0; sb < 128 / SBT; ++sb) {
      __syncthreads();
#pragma unroll
      for (int i = 0; i < 4; ++i) {
        const int tk = wave * 4 + i;
        const float cr_r = bf2f(raw[i][0]), cr_k = bf2f(raw[i][1]), cr_v = bf2f(raw[i][2]), cr_w = bf2f(raw[i][3]), cr_a = bf2f(raw[i][4]);
        const float pr_r = bf2f(i ? raw[i ? i - 1 : 0][0] : rawp[0]), pr_k = bf2f(i ? raw[i ? i - 1 : 0][1] : rawp[1]), pr_v = bf2f(i ? raw[i ? i - 1 : 0][2] : rawp[2]);
        const float pr_w = bf2f(i ? raw[i ? i - 1 : 0][3] : rawp[3]), pr_a = bf2f(i ? raw[i ? i - 1 : 0][4] : rawp[4]);
        L.R[tk * 64 + lane] = cr_r + (pr_r - cr_r) * mu_r;
        L.K[tk * 64 + lane] = cr_k + (pr_k - cr_k) * mu_k;
        L.V[tk * 64 + lane] = cr_v + (pr_v - cr_v) * mu_v;
        { const float xw = cr_w + (pr_w - cr_w) * mu_w; L.twb[tk * 72 + lane] = f2bf(1.f - 2.f * __builtin_amdgcn_rcpf(1.f + __expf(2.f * xw))); }
        L.tab[tk * 72 + lane] = f2bf(cr_a + (pr_a - cr_a) * mu_a);
      }
      if (sb + 1 < 128 / SBT) RAW_LOAD(sb + 1)
      __syncthreads();
      {
        const int dl_ = lane & 15, gq_ = lane >> 4;
        f32x4 dw = {0.f, 0.f, 0.f, 0.f}, da = {0.f, 0.f, 0.f, 0.f};
#pragma unroll
        for (int ks = 0; ks < 2; ++ks) {
          const bf16x8 bw = *(const bf16x8*)(L.twb + dl_ * 72 + ks * 32 + gq_ * 8);
          const bf16x8 ba = *(const bf16x8*)(L.tab + dl_ * 72 + ks * 32 + gq_ * 8);
          dw = __builtin_amdgcn_mfma_f32_16x16x32_bf16(wfr[ks], bw, dw, 0, 0, 0);
          da = __builtin_amdgcn_mfma_f32_16x16x32_bf16(afr[ks], ba, da, 0, 0, 0);
        }
        *(f32x4*)(L.accw + dl_ * 64 + 16 * wave + 4 * gq_) = dw;
        *(f32x4*)(L.acca + dl_ * 64 + 16 * wave + 4 * gq_) = da;
      }
      __syncthreads();
      float accw[4], acca[4];
#pragma unroll
      for (int i = 0; i < 4; ++i) { accw[i] = L.accw[(wave * 4 + i) * 64 + lane]; acca[i] = L.acca[(wave * 4 + i) * 64 + lane]; }
#pragma unroll
      for (int i = 0; i < 4; ++i) {
        const int tk = wave * 4 + i;
        const float wpre = w0v + accw[i];
        const float nx = -wpre;
        const float sp = fmaxf(nx, 0.f) + __logf(1.f + __expf(-fabsf(nx)));
        const float wlog = -sp - 0.5f;
        const float decay = __expf(-__expf(wlog));
        const float a = sigmoidf_(a0v + acca[i]);
        const float k = L.K[tk * 64 + lane], r = L.R[tk * 64 + lane], v = L.V[tk * 64 + lane];
        float kk = k * kkv;
        const float ss = wave_sum(kk * kk);
        kk *= rsqrtf(ss + 1e-12f);
        const float k2 = k * (1.f + (a - 1.f) * kav);
        L.W[tk * 64 + lane] = decay; L.K[tk * 64 + lane] = k2; L.KK[tk * 64 + lane] = kk; L.B[tk * 64 + lane] = kk * a;
        if (PASS_C) { const float bs = wave_sum(r * k2 * rkv_); L.bon[tk * 64 + lane] = bs * v; }
      }
      __syncthreads();
      ScanOps cur = load_ops<PASS_C>(L, 0, j0, row0);
#pragma unroll 8
      for (int tk = 0; tk < SBT; ++tk) {
        const ScanOps nx = load_ops<PASS_C>(L, (tk + 1) & (SBT - 1), j0, row0);
        const f32x2 w2[4] = {cur.w0.lo, cur.w0.hi, cur.w1.lo, cur.w1.hi};
        const f32x2 b2[4] = {cur.b0.lo, cur.b0.hi, cur.b1.lo, cur.b1.hi};
        const f32x2 kk2[4] = {cur.kk0.lo, cur.kk0.hi, cur.kk1.lo, cur.kk1.hi};
        const f32x2 k2[4] = {cur.k0.lo, cur.k0.hi, cur.k1.lo, cur.k1.hi};
        const float vr[2] = {cur.v.x, cur.v.y};
        float sa[2], sp[2] = {0.f, 0.f};
#pragma unroll
        for (int rr = 0; rr < 2; ++rr) {
          f32x2 a = S[rr][0] * kk2[0];
          a += S[rr][1] * kk2[1]; a += S[rr][2] * kk2[2]; a += S[rr][3] * kk2[3];
          sa[rr] = a.x + a.y;
          if (!PASS_C) {
            f32x2 q_ = Pst[rr][0] * kk2[0];
            q_ += Pst[rr][1] * kk2[1]; q_ += Pst[rr][2] * kk2[2]; q_ += Pst[rr][3] * kk2[3];
            sp[rr] = q_.x + q_.y;
          }
        }
        sa[0] = red8(sa[0]); sa[1] = red8(sa[1]);
        if (!PASS_C) { sp[0] = red8(sp[0]); sp[1] = red8(sp[1]); }
#pragma unroll
        for (int rr = 0; rr < 2; ++rr)
#pragma unroll
          for (int q = 0; q < 4; ++q) {
            S[rr][q] = S[rr][q] * w2[q] + (k2[q] * vr[rr] - b2[q] * sa[rr]);
            if (!PASS_C) Pst[rr][q] = Pst[rr][q] * w2[q] - b2[q] * sp[rr];
          }
        if (PASS_C) {
          const f32x2 r2[4] = {cur.r0.lo, cur.r0.hi, cur.r1.lo, cur.r1.hi};
          f32x2 oa = S[0][0] * r2[0]; oa += S[0][1] * r2[1]; oa += S[0][2] * r2[2]; oa += S[0][3] * r2[3];
          f32x2 ob = S[1][0] * r2[0]; ob += S[1][1] * r2[1]; ob += S[1][2] * r2[2]; ob += S[1][3] * r2[3];
          float o0 = red8(oa.x + oa.y), o1 = red8(ob.x + ob.y);
          if (jg == 0) { L.ot[tk * 64 + row0] = o0; L.ot[tk * 64 + row0 + 1] = o1; }
        }
        cur = nx;
      }
      if (PASS_C) {
        __syncthreads();
        const int x = tid >> 4, part = tid & 15;
        const int tk = dir ? (SBT - 1 - x) : x, tau = sb * SBT + tk;
        const int tl = dir ? (127 - tau) : tau;
        const f32x4 ov = *(const f32x4*)(L.ot + tk * 64 + part * 4);
        float o[4] = {ov[0], ov[1], ov[2], ov[3]};
        float s1 = red16(o[0] + o[1] + o[2] + o[3]);
        const float mu = s1 * (1.f / 64.f);
        float s2 = 0.f;
#pragma unroll
        for (int e = 0; e < 4; ++e) { o[e] -= mu; s2 += o[e] * o[e]; }
        s2 = red16(s2);
        const float rs = rsqrtf(s2 * (1.f / 64.f) + 64e-5f);
        const int ch = hd * 64 + part * 4;
        const f32x4 lg = *(const f32x4*)(p.ln_g + layer * 256 + ch), lb = *(const f32x4*)(p.ln_b + layer * 256 + ch);
        const f32x4 bo = *(const f32x4*)(L.bon + tk * 64 + part * 4);
        f32x4 y;
#pragma unroll
        for (int e = 0; e < 4; ++e) y[e] = o[e] * rs * lg[e] + lb[e] + bo[e];
        float* yg = (tl < 64 ? ytg0 + tl * 64 : ytg1 + (tl - 64) * 64) + part * 4;
        if (dir == 0) *(f32x4*)yg = y;
        else {
          const f32x4 y0 = *(const f32x4*)yg;
          bf16_t* yp = p.ys + (size_t)(t0 + tl) * 1024 + 768 + ch;
          const uint2 yv = *(const uint2*)yp;
          uint2 ov2;
          ov2.x = pack2(__uint_as_float(yv.x << 16) * (y[0] + y0[0]), __uint_as_float(yv.x & 0xffff0000u) * (y[1] + y0[1]));
          ov2.y = pack2(__uint_as_float(yv.y << 16) * (y[2] + y0[2]), __uint_as_float(yv.y & 0xffff0000u) * (y[3] + y0[3]));
          if (!DRY(p)) *(uint2*)yp = ov2;
        }
      }
    }
    if (!PASS_C) {
#pragma unroll
      for (int rr = 0; rr < 2; ++rr)
#pragma unroll
        for (int q = 0; q < 4; ++q) { *(f32x2*)(slot + (row0 + rr) * 64 + j0 + 2 * q) = Pst[rr][q]; *(f32x2*)(slot + 4096 + (row0 + rr) * 64 + j0 + 2 * q) = S[rr][q]; }
    }
  }
  __syncthreads();
}

__device__ void rwkv_passB(const Params& p, unsigned char* smem) {
  float* Pl = (float*)smem;
  float* Sl = Pl + 2 * 4096;
  const int tid = get_tid();
  for (int wk = blockIdx.x; wk < 128; wk += gridDim.x) {
    const int rg = wk & 3, hd = (wk >> 2) & 3, dir = (wk >> 4) & 1, seq = wk >> 5;
    const int cbase = seq == 0 ? 0 : seq == 1 ? 64 : seq == 2 ? 128 : 256;
    const int nch = seq < 2 ? 64 : 128;
    const int row = tid >> 4, jq = tid & 15;
    __syncthreads();
    for (int i = tid; i < 2 * 16 * 64; i += 256) Sl[i] = 0.f;
    float4 pf0, pf1, pf2, pf3, gf;
    {
      const int c = dir ? nch - 1 : 0;
      const float* slot = p.pg + ((size_t)(cbase + c) * 8 + dir * 4 + hd) * 8192;
      pf0 = ((const float4*)slot)[tid]; pf1 = ((const float4*)slot)[tid + 256]; pf2 = ((const float4*)slot)[tid + 512]; pf3 = ((const float4*)slot)[tid + 768];
      gf = *(const float4*)(slot + 4096 + (rg * 16 + row) * 64 + jq * 4);
    }
#pragma unroll 1
    for (int ci = 0; ci < nch; ++ci) {
      const int c = dir ? nch - 1 - ci : ci;
      float* slot = p.pg + ((size_t)(cbase + c) * 8 + dir * 4 + hd) * 8192;
      float* Pb = Pl + (ci & 1) * 4096;
      ((float4*)Pb)[tid] = pf0; ((float4*)Pb)[tid + 256] = pf1; ((float4*)Pb)[tid + 512] = pf2; ((float4*)Pb)[tid + 768] = pf3;
      float* gp = slot + 4096 + (rg * 16 + row) * 64 + jq * 4;
      float4 acc = gf;
      if (ci + 1 < nch) {
        const int c2 = dir ? nch - 2 - ci : ci + 1;
        const float* s2 = p.pg + ((size_t)(cbase + c2) * 8 + dir * 4 + hd) * 8192;
        pf0 = ((const float4*)s2)[tid]; pf1 = ((const float4*)s2)[tid + 256]; pf2 = ((const float4*)s2)[tid + 512]; pf3 = ((const float4*)s2)[tid + 768];
        gf = *(const float4*)(s2 + 4096 + (rg * 16 + row) * 64 + jq * 4);
      }
      __syncthreads();
      const float* Sc = Sl + (ci & 1) * 1024;
      const float4 sold = *(const float4*)(Sc + row * 64 + jq * 4);
#pragma unroll 4
      for (int m4 = 0; m4 < 16; ++m4) {
        const float4 s4 = *(const float4*)(Sc + row * 64 + m4 * 4);
        const float sv[4] = {s4.x, s4.y, s4.z, s4.w};
#pragma unroll
        for (int e = 0; e < 4; ++e) {
          const float4 pv = *(const float4*)(Pb + (m4 * 4 + e) * 64 + jq * 4);
          acc.x += sv[e] * pv.x; acc.y += sv[e] * pv.y; acc.z += sv[e] * pv.z; acc.w += sv[e] * pv.w;
        }
      }
      if (!DRY(p)) *(float4*)gp = sold;
      *(float4*)(Sl + ((ci + 1) & 1) * 1024 + row * 64 + jq * 4) = acc;
    }
  }
}

__device__ void phase_bmix(const Params& p, int layer, unsigned char* smem) {
  const int NA = 9216, NS = 1536, NP = 3072;
  const bool weighted = gridDim.x == 512;
  if (!weighted || blockIdx.x < 128) { __builtin_amdgcn_s_setprio(3); rwkv_passB(p, smem); __builtin_amdgcn_s_setprio(0); }
  int first, cnt, stride;
  if (weighted) {
    if (blockIdx.x >= 128) { first = (blockIdx.x - 128) * 24; cnt = 24; } else { first = 0; cnt = 0; }
    stride = 1;
  } else { first = blockIdx.x; stride = gridDim.x; cnt = (NA - first + stride - 1) / stride; if (first >= NA) cnt = 0; }
  if (cnt > 0) {
    AttnRaw R;
    attn_issue(p, first, R);
#pragma unroll 1
    for (int k = 0; k < cnt; ++k) attn_item(p, layer, first + k * stride, R, k + 1 < cnt ? first + (k + 1) * stride : -1, smem);
  }
  const int b0 = (int)blockIdx.x, bs = (int)gridDim.x;
  if (b0 >= 0) {
#pragma unroll 1
    for (int it = b0; it < NS + NP; it += bs) {
      if (it < NS) sg_item(p, layer, it, smem);
      else pool_item(p, layer, it - NS, smem);
    }
  }
}

#define XB_TMO      128
#define XB_XCNT(j)  (256  + 64 * (j))
#define XB_XSUB(j)  (1280 + 64 * (j))
#define XB_XGEN(j)  (2304 + 64 * (j))
#define XB_TOP      3328
#define XB_TOPGEN   3392
#define XCD_BAR_WORDS 3456
#define XB_SPIN_CAP (1u << 22)
__device__ __forceinline__ unsigned xb_ld(unsigned* q)              { return __hip_atomic_load(q, __ATOMIC_RELAXED, __HIP_MEMORY_SCOPE_AGENT); }
__device__ __forceinline__ unsigned xb_add(unsigned* q, unsigned v) { return __hip_atomic_fetch_add(q, v, __ATOMIC_RELAXED, __HIP_MEMORY_SCOPE_AGENT); }
__device__ __forceinline__ unsigned xb_xcc_id() { return (unsigned)__builtin_amdgcn_s_getreg((3 << 11) | 20) & 0xFu; }
#define XB_SPIN(cond, bar) do { unsigned _sp = 0; while (cond) { __builtin_amdgcn_s_sleep(1); \
    if ((++_sp & 255u) == 0u) { if (xb_ld(&(bar)[XB_TMO])) break; if (_sp > XB_SPIN_CAP) { atomicAdd(&(bar)[XB_TMO], 1u); break; } } } } while (0)
struct XcdBarrier { unsigned* bar; unsigned x; volatile LAS unsigned* st; };
__device__ __forceinline__ XcdBarrier xcd_barrier_post(unsigned* bar, volatile LAS unsigned* st) {
  XcdBarrier b; b.bar = bar; b.x = xb_xcc_id(); b.st = st;
  if (threadIdx.x == 0) (void)xb_add(&bar[XB_XCNT(b.x)], 1u);
  return b;
}
__device__ __forceinline__ void xcd_barrier_complete(unsigned* bar, unsigned x, unsigned& nloc, unsigned& nx) {
  const unsigned G = gridDim.x * gridDim.y * gridDim.z;
  unsigned sum, cnt, mine, sp = 0u;
  for (;;) {
    sum = 0u; cnt = 0u; mine = 0u;
#pragma unroll
    for (unsigned j = 0; j < 16; ++j) { const unsigned c = xb_ld(&bar[XB_XCNT(j)]); sum += c; cnt += (c > 0u) ? 1u : 0u; mine = (j == x) ? c : mine; }
    if (sum == G) break;
    __builtin_amdgcn_s_sleep(1);
    if ((++sp & 255u) == 0u) { if (xb_ld(&bar[XB_TMO])) break; if (sp > XB_SPIN_CAP) { atomicAdd(&bar[XB_TMO], 1u); break; } }
  }
  nloc = mine > 0u ? mine : 1u; nx = cnt > 0u ? cnt : 1u;
}
__device__ __forceinline__ void xcd_barrier(const XcdBarrier& b) {
  asm volatile("s_waitcnt vmcnt(0)" ::: "memory");
  __syncthreads();
  if (threadIdx.x == 0) {
    unsigned* bar = b.bar;
    __builtin_amdgcn_s_waitcnt(0);
    unsigned nloc = b.st[0], nx = b.st[1];
    if (nloc == 0u) { xcd_barrier_complete(bar, b.x, nloc, nx); b.st[0] = nloc; b.st[1] = nx; }
    const unsigned old = xb_add(&bar[XB_XSUB(b.x)], 1u);
    const unsigned gen = old / nloc;
    if (old + 1u == (gen + 1u) * nloc) {
      __builtin_amdgcn_fence(__ATOMIC_RELEASE, "agent");
      asm volatile("s_waitcnt vmcnt(0)" ::: "memory");
      const unsigned og = xb_add(&bar[XB_TOP], 1u);
      const unsigned tg = og / nx;
      if (og + 1u == (tg + 1u) * nx) xb_add(&bar[XB_TOPGEN], 1u);
      else XB_SPIN(xb_ld(&bar[XB_TOPGEN]) == tg, bar);
      __builtin_amdgcn_fence(__ATOMIC_ACQUIRE, "agent");
      xb_add(&bar[XB_XGEN(b.x)], 1u);
      asm volatile("s_waitcnt vmcnt(0)" ::: "memory");
    } else {
      XB_SPIN(xb_ld(&bar[XB_XGEN(b.x)]) == gen, bar);
      __builtin_amdgcn_fence(__ATOMIC_ACQUIRE, "agent");
      asm volatile("s_waitcnt vmcnt(0)" ::: "memory");
    }
  }
  __syncthreads();
}

__device__ __forceinline__ void run_phase(const Params& p, int layer, int sub, unsigned char* smem) {
  switch (sub) {
    case 0: phase_prep(p, layer, smem); break;
    case 1: phase_g1(p, layer, smem); break;
    case 2: for (int j = blockIdx.x; j < 1536; j += gridDim.x) rwkv_job<false>(p, layer, j, smem); break;
    case 3: phase_bmix(p, layer, smem); break;
    case 4: for (int j = blockIdx.x; j < 1536; j += gridDim.x) rwkv_job<true>(p, layer, j, smem); attn_combine(p); break;
    case 5: phase_branch(p, smem); break;
    case 6: phase_gate(p, layer, smem); break;
    case 7: phase_out(p, layer, smem); break;
  }
}
__global__ void __launch_bounds__(256, 2) mega(Params p) {
  extern __shared__ __attribute__((aligned(16))) unsigned char smem[];
  cg::grid_group grid = cg::this_grid();
  volatile LAS unsigned* bst = (volatile LAS unsigned*)((LAS unsigned char*)smem + 73728);
  if (threadIdx.x < 4) bst[threadIdx.x] = 0u;
  __syncthreads();
  const XcdBarrier xbar = xcd_barrier_post(p.bar, bst);
  for (int ph = p.phase_lo; ph < p.phase_hi; ++ph) {
    const int layer = ph / NPH, sub = ph % NPH;
#if PROBE_MASK
    for (int rep = (PROBE_MASK >> sub) & 1; rep >= 0; --rep) {
      __syncthreads(); if (get_tid() == 0) s_dry = rep; __syncthreads();
      run_phase(p, layer, sub, smem);
      if (rep) grid.sync();
    }
#else
    run_phase(p, layer, sub, smem);
#endif
    if (ph + 1 < p.phase_hi) { if (p.phase_hi < 0) grid.sync(); else xcd_barrier(xbar); }
  }
}

extern "C" void kernel_launch(void* const* d_in, const int* in_sizes, int n_in, void* d_out, int out_size, void* d_ws, size_t ws_size, hipStream_t stream) {
  static int grid_blocks = 0;
  if (!grid_blocks) {
    hipFuncSetAttribute((const void*)mega, hipFuncAttributeMaxDynamicSharedMemorySize, SMEM_BYTES);
    int dev = 0, cus = 0, per_cu = 0;
    hipGetDevice(&dev);
    hipDeviceGetAttribute(&cus, hipDeviceAttributeMultiprocessorCount, dev);
    hipOccupancyMaxActiveBlocksPerMultiprocessor(&per_cu, mega, 256, SMEM_BYTES);
    if (per_cu < 1) per_cu = 1;
    grid_blocks = cus * per_cu;
  }
  Params p{};
  p.xp = (const float*)d_in[0]; p.xs = (const float*)d_in[1];
  p.norm_g = (const float*)d_in[2]; p.w_in = (const float*)d_in[3]; p.q_norm_g = (const float*)d_in[4]; p.k_norm_g = (const float*)d_in[5];
  p.pool_w = (const float*)d_in[6]; p.pool_scale = (const float*)d_in[7]; p.sg_norm_g = (const float*)d_in[8]; p.sg_w = (const float*)d_in[9]; p.sg_b = (const float*)d_in[10];
  p.mu_rkv = (const float*)d_in[11]; p.mu_lat = (const float*)d_in[12]; p.w0 = (const float*)d_in[13]; p.w_up = (const float*)d_in[14]; p.a0 = (const float*)d_in[15]; p.a_up = (const float*)d_in[16];
  p.k_k = (const float*)d_in[17]; p.k_a = (const float*)d_in[18]; p.r_k = (const float*)d_in[19]; p.ln_g = (const float*)d_in[20]; p.ln_b = (const float*)d_in[21];
  p.w_branch = (const float*)d_in[22]; p.w_out = (const float*)d_in[23];
  p.out = (float*)d_out;
  unsigned char* ws = (unsigned char*)d_ws;
  size_t off = 0;
  p.qkv = (bf16_t*)(ws + off); off += (size_t)MTOK * QKVW * 2;
  p.rest = (bf16_t*)(ws + off); off += (size_t)MTOK * RESTW * 2;
  p.ys = (bf16_t*)(ws + off); off += (size_t)MTOK * 1024 * 2;
  p.w1t = (bf16_t*)(ws + off); off += (size_t)5120 * 1024 * 2;
  p.wgt = (bf16_t*)(ws + off); off += (size_t)4096 * 1024 * 2;
  p.wbrt = (bf16_t*)(ws + off); off += (size_t)4096 * 256 * 2;
  p.woutt = (bf16_t*)(ws + off); off += (size_t)1024 * 1024 * 2;
  p.rstd = nullptr;
  p.xb = (bf16_t*)(ws + off); off += (size_t)MTOK * 1024 * 2;
  p.pnum = (bf16_t*)(ws + off); off += (size_t)3 * MTOK * 256 * 2;
  p.pden = (float*)p.w1t;
  p.pg = (float*)(ws + off); off += (size_t)3072 * 8192 * 4;
  p.bar = (unsigned*)(ws + off); off += (size_t)XCD_BAR_WORDS * 4;
  p.branch = p.qkv;
  if (off > ws_size) { fprintf(stderr, "workspace too small: need %zu have %zu\n", off, ws_size); return; }
  (void)hipMemsetAsync(p.bar, 0, (size_t)XCD_BAR_WORDS * 4, stream);
#if MULTI_LAUNCH
  for (int ph = 0; ph < 2 * NPH; ++ph) {
    p.phase_lo = ph; p.phase_hi = ph + 1;
    hipLaunchKernelGGL(mega, dim3(grid_blocks), dim3(256), SMEM_BYTES, stream, p);
  }
#else
  p.phase_lo = 0; p.phase_hi = 2 * NPH;
  void* args[] = {&p};
  hipError_t e = hipLaunchCooperativeKernel((void*)mega, dim3(grid_blocks), dim3(256), args, SMEM_BYTES, stream);
  if (e != hipSuccess) fprintf(stderr, "cooperative launch failed: %s (grid %d)\n", hipGetErrorString(e), grid_blocks);
#endif
}
```

```cpp
#include <hip/hip_runtime.h>
#include <hip/hip_cooperative_groups.h>
#include <cstdio>
namespace cg = cooperative_groups;

#ifndef PROBE_MASK
#define PROBE_MASK 0
#endif
#ifndef PROBE_NOGL
#define PROBE_NOGL 0
#endif
#if PROBE_MASK
__shared__ int s_dry;
#define DRY(p) (s_dry)
#define NOGL (PROBE_NOGL && s_dry)
#else
#define DRY(p) 0
#define NOGL 0
#endif
#ifndef MULTI_LAUNCH
#define MULTI_LAUNCH 0
#endif

typedef unsigned short bf16_t;
typedef short bf16x8 __attribute__((ext_vector_type(8)));
typedef float f32x4 __attribute__((ext_vector_type(4)));
typedef unsigned u32x4 __attribute__((ext_vector_type(4)));
typedef float f32x2 __attribute__((ext_vector_type(2)));
typedef __bf16 bf2v __attribute__((ext_vector_type(2)));

constexpr int MTOK = 49152;
constexpr int DM = 1024;
constexpr int PW = 9216;
constexpr int QKVW = 2304;
constexpr int RESTW = 1792;
constexpr int SMEM_BYTES = 73728 + 16;
constexpr int NPH = 8;

struct Params {
  const float* xp; const float* xs;
  const float* norm_g; const float* w_in; const float* q_norm_g; const float* k_norm_g;
  const float* pool_w; const float* pool_scale; const float* sg_norm_g; const float* sg_w; const float* sg_b;
  const float* mu_rkv; const float* mu_lat; const float* w0; const float* w_up; const float* a0; const float* a_up;
  const float* k_k; const float* k_a; const float* r_k; const float* ln_g; const float* ln_b;
  const float* w_branch; const float* w_out;
  float* out;
  bf16_t* qkv; bf16_t* rest; bf16_t* ys;
  bf16_t* w1t; bf16_t* wgt; bf16_t* wbrt; bf16_t* woutt;
  float* rstd; float* pg; bf16_t* branch; bf16_t* xb; bf16_t* pnum; float* pden; unsigned* bar;
  int phase_lo, phase_hi;
  int dry, pad_;
};

__device__ __forceinline__ int get_tid() { int t = threadIdx.x; asm volatile("" : "+v"(t)); return t; }
__device__ __forceinline__ float bf2f(bf16_t v) { return __uint_as_float(((unsigned)v) << 16); }
__device__ __forceinline__ bf16_t f2bf(float f) { unsigned u = __float_as_uint(f); u += 0x7fffu + ((u >> 16) & 1u); return (bf16_t)(u >> 16); }
__device__ __forceinline__ unsigned pack2(float a, float b) { return (unsigned)f2bf(a) | ((unsigned)f2bf(b) << 16); }
__device__ __forceinline__ float sigmoidf_(float x) { return __builtin_amdgcn_rcpf(1.f + __expf(-x)); }
__device__ __forceinline__ float dpp_qx1(float v) { return __int_as_float(__builtin_amdgcn_update_dpp(0, __float_as_int(v), 0xB1, 0xF, 0xF, true)); }
__device__ __forceinline__ float dpp_qx2(float v) { return __int_as_float(__builtin_amdgcn_update_dpp(0, __float_as_int(v), 0x4E, 0xF, 0xF, true)); }
__device__ __forceinline__ float dpp_hm(float v) { return __int_as_float(__builtin_amdgcn_update_dpp(0, __float_as_int(v), 0x141, 0xF, 0xF, true)); }
__device__ __forceinline__ float wave_sum(float v) {
  v += __int_as_float(__builtin_amdgcn_update_dpp(0, __float_as_int(v), 0xB1, 0xF, 0xF, true));
  v += __int_as_float(__builtin_amdgcn_update_dpp(0, __float_as_int(v), 0x4E, 0xF, 0xF, true));
  v += __int_as_float(__builtin_amdgcn_update_dpp(0, __float_as_int(v), 0x141, 0xF, 0xF, true));
  v += __int_as_float(__builtin_amdgcn_update_dpp(0, __float_as_int(v), 0x140, 0xF, 0xF, true));
  v += __shfl_xor(v, 16); v += __shfl_xor(v, 32);
  return v;
}
__device__ __forceinline__ const float* xrow_ptr(const Params& p, int layer, int row) {
  if (layer == 0) return row < 16384 ? p.xp + (size_t)row * DM : p.xs + (size_t)(row - 16384) * DM;
  return p.out + (size_t)row * DM;
}
__device__ __forceinline__ void seq_of(int T0, int& sstart, int& slen) {
  if (T0 < 16384) { sstart = T0 & ~8191; slen = 8192; } else { sstart = 16384 + ((T0 - 16384) & ~16383); slen = 16384; }
}

__device__ void prep_xb(const Params& p, int layer) {
  const int tid = get_tid(), lane = tid & 63;
  const int gw = (blockIdx.x * 256 + tid) >> 6, nw = gridDim.x * 4;
  for (int row = gw; row < MTOK; row += nw) {
    const float4* x = (const float4*)xrow_ptr(p, layer, row);
    float ss = 0.f;
    float4 xv[4];
#pragma unroll
    for (int i = 0; i < 4; ++i) { xv[i] = x[lane + i * 64]; ss += xv[i].x * xv[i].x + xv[i].y * xv[i].y + xv[i].z * xv[i].z + xv[i].w * xv[i].w; }
    ss = wave_sum(ss);
    const float rs = rsqrtf(ss * (1.f / 1024.f) + 1e-6f);
#pragma unroll
    for (int i = 0; i < 4; ++i) { const float4 v = xv[i]; uint2 o; o.x = pack2(v.x * rs, v.y * rs); o.y = pack2(v.z * rs, v.w * rs); *(uint2*)(p.xb + (size_t)row * 1024 + (lane + i * 64) * 4) = o; }
  }
}

__device__ __forceinline__ int w1_col(int n) {
  if (n < 2304) return n; if (n < 2560) return 2560 + (n - 2304); if (n < 3072) return 3072 + (n - 2560);
  if (n < 3840) return 3840 + (n - 3072); if (n < 4096) return 4608 + (n - 3840);
  if (n < 4352) return 2304 + (n - 4096); if (n < 4608) return 2816 + (n - 4352);
  if (n < 4864) return 3584 + (n - 4608); return 4864 + (n - 4864);
}
__device__ __forceinline__ int wg_col(int n) {
  const int tn = n >> 8, c = n & 255, wn = c >> 7, nn = (c >> 4) & 7, dl = c & 15, dg = nn >> 2, b = nn & 3;
  return 5120 + b * 1024 + tn * 64 + wn * 32 + dg * 16 + dl;
}

__device__ void phase_prep(const Params& p, int layer, unsigned char* smem) {
  const int tid = get_tid(), lane = tid & 63, wave = tid >> 6;
  prep_xb(p, layer);
  const float* w_in = p.w_in + (size_t)layer * DM * PW;
  const float* ng = p.norm_g + layer * DM;
  const float* wb = p.w_branch + (size_t)layer * 4 * 256 * 1024;
  const float* wo = p.w_out + (size_t)layer * 1024 * 1024;
  bf16_t* T = (bf16_t*)smem;
  const int NT0 = 80 * 16, NT1 = 64 * 16, NT2 = 64 * 4, NT3 = 16 * 16;
  for (int tile = blockIdx.x; tile < NT0 + NT1 + NT2 + NT3; tile += gridDim.x) {
    int kind, tl = tile;
    if (tl < NT0) kind = 0; else if ((tl -= NT0) < NT1) kind = 1; else if ((tl -= NT1) < NT2) kind = 2; else { tl -= NT2; kind = 3; }
    const int nkt = kind == 2 ? 4 : 16;
    const int n0 = (tl / nkt) * 64, k0 = (tl % nkt) * 64;
    const int n = n0 + lane;
    const float* src; size_t ls; bf16_t* dst; int K;
    if (kind == 0) { src = w_in + w1_col(n); ls = PW; dst = p.w1t; K = 1024; }
    else if (kind == 1) { src = w_in + wg_col(n); ls = PW; dst = p.wgt; K = 1024; }
    else if (kind == 2) { src = wb + (size_t)(n >> 10) * 256 * 1024 + (n & 1023); ls = 1024; dst = p.wbrt; K = 256; }
    else { src = wo + n; ls = 1024; dst = p.woutt; K = 1024; }
    float v[16];
#pragma unroll
    for (int i = 0; i < 16; ++i) v[i] = src[(size_t)(k0 + wave * 16 + i) * ls];
    if (kind < 2) {
#pragma unroll
      for (int i = 0; i < 16; ++i) v[i] *= ng[k0 + wave * 16 + i];
    }
#pragma unroll
    for (int i = 0; i < 8; ++i) *(unsigned*)(T + lane * 72 + wave * 16 + 2 * i) = pack2(v[2 * i], v[2 * i + 1]);
    __syncthreads();
#pragma unroll
    for (int i = 0; i < 2; ++i) {
      const int id = tid + i * 256, nl = id >> 3, kc = id & 7;
      *(u32x4*)(dst + (size_t)(n0 + nl) * K + k0 + kc * 8) = *(const u32x4*)(T + nl * 72 + kc * 8);
    }
    __syncthreads();
  }
}

__device__ __forceinline__ int lds_off(int r, int c) { return r * 128 + ((c ^ ((r >> 1) & 7)) << 4); }

#define LAS __attribute__((address_space(3)))
constexpr int GSTAGE = 24576;
#define DMA16(G, L) __builtin_amdgcn_global_load_lds((const unsigned*)(G), (LAS unsigned*)(L), 16, 0, 0)
#define DMA_TILE(T, ST) { const size_t ko = (size_t)(T) * 64; LAS unsigned char* d_ = lds + (ST) * GSTAGE + ldsw; \
    DMA16(Ab + ko + voffA, d_); DMA16(Ab + ko + (voffA + 64u * lda2), d_ + 4096); \
    DMA16(Bb + ko + voffB, d_ + 8192); DMA16(Bb + ko + (voffB + 64u * ldb2), d_ + 12288); \
    DMA16(Bb + ko + (voffB + 128u * ldb2), d_ + 16384); DMA16(Bb + ko + (voffB + 192u * ldb2), d_ + 20480); }

__device__ __forceinline__ void gemm_compute(f32x4 (&acc)[4][8], const LAS unsigned char* a_, int aoff, int boff) {
  const LAS unsigned char* b_ = a_ + 8192;
  bf16x8 af[4], bfr[8];
#pragma unroll
  for (int m = 0; m < 4; ++m) af[m] = *(const LAS bf16x8*)(a_ + aoff + m * 1024);
#pragma unroll
  for (int n = 0; n < 8; ++n) bfr[n] = *(const LAS bf16x8*)(b_ + boff + n * 1024);
  asm volatile("" :: "v"(af[0]), "v"(af[1]), "v"(af[2]), "v"(af[3]));
#pragma unroll
  for (int m = 0; m < 4; ++m)
#pragma unroll
    for (int n = 0; n < 8; ++n) acc[m][n] = __builtin_amdgcn_mfma_f32_16x16x32_bf16(bfr[n], af[m], acc[m][n], 0, 0, 0);
}

#define DMA_HALF0(T, ST) { const size_t ko = (size_t)(T) * 64; LAS unsigned char* d_ = lds + (ST) * GSTAGE + ldsw; \
    DMA16(Ab + ko + voffA, d_); DMA16(Ab + ko + (voffA + 64u * lda2), d_ + 4096); DMA16(Bb + ko + voffB, d_ + 8192); }
#define DMA_HALF1(T, ST) { const size_t ko = (size_t)(T) * 64; LAS unsigned char* d_ = lds + (ST) * GSTAGE + ldsw; \
    DMA16(Bb + ko + (voffB + 64u * ldb2), d_ + 12288); DMA16(Bb + ko + (voffB + 128u * ldb2), d_ + 16384); DMA16(Bb + ko + (voffB + 192u * ldb2), d_ + 20480); }
__device__ __forceinline__ void gemm_core(f32x4 (&acc)[4][8], const bf16_t* Aptr, int lda, const bf16_t* Bt, int ldb, int K, unsigned char* smem) {
  const int tid = get_tid(), lane = tid & 63, wave = tid >> 6, wm = wave >> 1, wn = wave & 1;
  const int dl = lane & 15, gq = lane >> 4, swz = ((dl >> 3) & 1) * 3;
  const int aoff = (wm * 64 + dl) * 64 + ((gq ^ swz) << 4);
  const int boff = (wn * 128 + dl) * 64 + ((gq ^ swz) << 4);
  LAS unsigned char* lds = (LAS unsigned char*)smem;
  const int r0 = tid >> 2, csrc = (tid & 3) ^ (((r0 >> 3) & 1) * 3);
  const int ldsw = tid * 16;
  const unsigned lda2 = (unsigned)lda * 2u, ldb2 = (unsigned)ldb * 2u;
  const unsigned voffA = (unsigned)r0 * lda2 + csrc * 16, voffB = (unsigned)r0 * ldb2 + csrc * 16;
  const unsigned char* Ab = (const unsigned char*)Aptr; const unsigned char* Bb = (const unsigned char*)Bt;
  const int nt = K >> 5;
  DMA_TILE(0, 0) DMA_TILE(1, 1)
  int st = 0, st2 = 2;
#pragma unroll 1
  for (int t = 0; t < nt; ++t) {
    if (t + 1 < nt) asm volatile("s_waitcnt vmcnt(6)" ::: "memory"); else asm volatile("s_waitcnt vmcnt(0)" ::: "memory");
    asm volatile("" ::: "memory"); __builtin_amdgcn_s_barrier(); asm volatile("" ::: "memory");
    {
      const LAS unsigned char* a_ = lds + st * GSTAGE; const LAS unsigned char* b_ = a_ + 8192;
      bf16x8 af[4], bfr[8];
#pragma unroll
      for (int m = 0; m < 4; ++m) af[m] = *(const LAS bf16x8*)(a_ + aoff + m * 1024);
#pragma unroll
      for (int n = 0; n < 8; ++n) bfr[n] = *(const LAS bf16x8*)(b_ + boff + n * 1024);
      asm volatile("" :: "v"(af[0]), "v"(af[1]), "v"(af[2]), "v"(af[3]));
      __builtin_amdgcn_sched_barrier(0);
#pragma unroll
      for (int m = 0; m < 2; ++m)
#pragma unroll
        for (int n = 0; n < 8; ++n) acc[m][n] = __builtin_amdgcn_mfma_f32_16x16x32_bf16(bfr[n], af[m], acc[m][n], 0, 0, 0);
      __builtin_amdgcn_sched_barrier(0);
      if (t + 2 < nt) DMA_HALF0(t + 2, st2)
      __builtin_amdgcn_sched_barrier(0);
#pragma unroll
      for (int m = 2; m < 4; ++m)
#pragma unroll
        for (int n = 0; n < 8; ++n) acc[m][n] = __builtin_amdgcn_mfma_f32_16x16x32_bf16(bfr[n], af[m], acc[m][n], 0, 0, 0);
      __builtin_amdgcn_sched_barrier(0);
      if (t + 2 < nt) DMA_HALF1(t + 2, st2)
    }
    st = st == 2 ? 0 : st + 1; st2 = st2 == 2 ? 0 : st2 + 1;
  }
  asm volatile("" ::: "memory"); __builtin_amdgcn_s_barrier(); asm volatile("" ::: "memory");
}

__device__ __forceinline__ void zero_acc(f32x4 (&acc)[4][8]) {
#pragma unroll
  for (int m = 0; m < 4; ++m)
#pragma unroll
    for (int n = 0; n < 8; ++n) acc[m][n] = (f32x4){0.f, 0.f, 0.f, 0.f};
}

__device__ __forceinline__ bool tile_of(int it, int ntn, int& tm, int& tn) {
  if (gridDim.x == 256 || gridDim.x == 512) {
    const int xcd = blockIdx.x & 7, s = blockIdx.x >> 3;
    const int gmh = gridDim.x == 512 ? 16 : 8;
    const int gn_cnt = ntn >> 2, g = it * 8 + xcd;
    if (g >= (384 / gmh) * gn_cnt) return false;
    const int gm = g / gn_cnt, gn = g % gn_cnt;
    tm = gm * gmh + (s & (gmh - 1)); tn = gn * 4 + s / gmh;
    return true;
  }
  const int tile = blockIdx.x + it * gridDim.x;
  if (tile >= 384 * ntn) return false;
  tm = tile / ntn; tn = tile % ntn; return true;
}

__device__ void phase_g1(const Params& p, int layer, unsigned char* smem) {
  const int lane = get_tid() & 63, wave = get_tid() >> 6, wm = wave >> 1, wn = wave & 1;
  int tm, tn;
  for (int it = 0; tile_of(it, 20, tm, tn); ++it) {
    const int row0 = tm * 128, col0 = tn * 256;
    f32x4 acc[4][8]; zero_acc(acc);
    gemm_core(acc, p.xb + (size_t)row0 * 1024, 1024, p.w1t + (size_t)col0 * 1024, 1024, 1024, smem);
    if (col0 < 1536) {
      const float* gn = (col0 < 768 ? p.q_norm_g : p.k_norm_g) + layer * 64;
      const float sc = col0 < 768 ? 0.125f : 1.f;
#pragma unroll
      for (int m = 0; m < 4; ++m)
#pragma unroll
        for (int hh = 0; hh < 2; ++hh) {
          float ss = 0.f;
#pragma unroll
          for (int n = 0; n < 4; ++n)
#pragma unroll
            for (int j = 0; j < 4; ++j) ss += acc[m][hh * 4 + n][j] * acc[m][hh * 4 + n][j];
          ss += __shfl_xor(ss, 16); ss += __shfl_xor(ss, 32);
          const float rs = rsqrtf(ss * (1.f / 64.f) + 1e-6f) * sc;
#pragma unroll
          for (int n = 0; n < 4; ++n) {
            const f32x4 gv = *(const f32x4*)(gn + n * 16 + (lane >> 4) * 4);
#pragma unroll
            for (int j = 0; j < 4; ++j) acc[m][hh * 4 + n][j] *= rs * gv[j];
          }
        }
    }
    {
      unsigned char* wl = smem + wave * 17408;
      const bool act = col0 >= 4096;
#pragma unroll
      for (int m = 0; m < 4; ++m)
#pragma unroll
        for (int n = 0; n < 8; ++n) {
          float v0 = acc[m][n][0], v1 = acc[m][n][1], v2 = acc[m][n][2], v3 = acc[m][n][3];
          if (act) { v0 *= sigmoidf_(v0); v1 *= sigmoidf_(v1); v2 *= sigmoidf_(v2); v3 *= sigmoidf_(v3); }
          uint2 o; o.x = pack2(v0, v1); o.y = pack2(v2, v3);
          *(uint2*)(wl + (m * 16 + (lane & 15)) * 272 + (n * 16 + (lane >> 4) * 4) * 2) = o;
        }
      bf16_t* dst; int ld;
      if (col0 < QKVW) { dst = p.qkv + col0; ld = QKVW; }
      else if (col0 < 4096) { dst = p.rest + (col0 - QKVW); ld = RESTW; }
      else { dst = p.ys + (col0 - 4096); ld = 1024; }
      dst += (size_t)(row0 + wm * 64) * ld + wn * 128;
#pragma unroll
      for (int i = 0; i < 16; ++i) {
        const int id = i * 64 + lane, r = id >> 4, c16 = id & 15;
        const u32x4 v = *(const u32x4*)(wl + r * 272 + c16 * 16);
        *(u32x4*)(dst + (size_t)r * ld + c16 * 8) = v;
      }
    }
    __syncthreads();
  }
}

__device__ void phase_branch(const Params& p, unsigned char* smem) {
  const int lane = get_tid() & 63, wave = get_tid() >> 6, wm = wave >> 1, wn = wave & 1;
  int tm, tn;
  for (int it = 0; tile_of(it, 16, tm, tn); ++it) {
    const int row0 = tm * 128, col0 = tn * 256, b = tn >> 2;
    f32x4 acc[4][8]; zero_acc(acc);
    gemm_core(acc, p.ys + (size_t)row0 * 1024 + b * 256, 1024, p.wbrt + (size_t)col0 * 256, 256, 256, smem);
#pragma unroll
    for (int m = 0; m < 4; ++m) {
      const int row = row0 + wm * 64 + m * 16 + (lane & 15);
#pragma unroll
      for (int n = 0; n < 8; ++n) {
        const int colt = col0 + wn * 128 + n * 16, bb = colt >> 10, d16 = (colt & 1023) >> 4;
        uint2 o; o.x = pack2(acc[m][n][0], acc[m][n][1]); o.y = pack2(acc[m][n][2], acc[m][n][3]);
        *(uint2*)(p.branch + ((((((size_t)tm * 2 + wm) * 4 + m) * 4 + bb) * 64 + d16) * 64 + lane) * 4) = o;
      }
    }
  }
}

__device__ void phase_gate(const Params& p, int layer, unsigned char* smem) {
  const int lane = get_tid() & 63, wave = get_tid() >> 6, wm = wave >> 1, wn = wave & 1;
  int tm, tn;
  for (int it = 0; tile_of(it, 16, tm, tn); ++it) {
    const int row0 = tm * 128;
    f32x4 acc[4][8]; zero_acc(acc);
    gemm_core(acc, p.xb + (size_t)row0 * 1024, 1024, p.wgt + (size_t)tn * 256 * 1024, 1024, 1024, smem);
#pragma unroll
    for (int m = 0; m < 4; ++m) {
      const int row = row0 + wm * 64 + m * 16 + (lane & 15);
#pragma unroll
      for (int dg = 0; dg < 2; ++dg) {
        const int d = tn * 64 + wn * 32 + dg * 16 + (lane >> 4) * 4;
        float s0 = 0.f, s1 = 0.f, s2 = 0.f, s3 = 0.f;
#pragma unroll
        for (int b = 0; b < 4; ++b) {
          uint2 br = *(const uint2*)(p.branch + ((((((size_t)tm * 2 + wm) * 4 + m) * 4 + b) * 64 + (tn * 4 + wn * 2 + dg)) * 64 + lane) * 4);
          s0 += sigmoidf_(acc[m][dg * 4 + b][0]) * __uint_as_float(br.x << 16);
          s1 += sigmoidf_(acc[m][dg * 4 + b][1]) * __uint_as_float(br.x & 0xffff0000u);
          s2 += sigmoidf_(acc[m][dg * 4 + b][2]) * __uint_as_float(br.y << 16);
          s3 += sigmoidf_(acc[m][dg * 4 + b][3]) * __uint_as_float(br.y & 0xffff0000u);
        }
        uint2 o; o.x = pack2(s0, s1); o.y = pack2(s2, s3);
        *(uint2*)(p.ys + (size_t)row * 1024 + d) = o;
        asm volatile("" ::: "memory");
      }
    }
  }
}

__device__ void phase_out(const Params& p, int layer, unsigned char* smem) {
  const int lane = get_tid() & 63, wave = get_tid() >> 6, wm = wave >> 1, wn = wave & 1;
  int tm, tn;
  for (int it = 0; tile_of(it, 4, tm, tn); ++it) {
    const int row0 = tm * 128, col0 = tn * 256;
    f32x4 acc[4][8]; zero_acc(acc);
    gemm_core(acc, p.ys + (size_t)row0 * 1024, 1024, p.woutt + (size_t)col0 * 1024, 1024, 1024, smem);
#pragma unroll
    for (int m = 0; m < 4; ++m) {
      const int row = row0 + wm * 64 + m * 16 + (lane & 15);
      const float* xr = xrow_ptr(p, layer, row);
#pragma unroll
      for (int n = 0; n < 8; ++n) {
        const int col = col0 + wn * 128 + n * 16 + (lane >> 4) * 4;
        float4 xv = *(const float4*)(xr + col);
        float4 o; o.x = xv.x + acc[m][n][0]; o.y = xv.y + acc[m][n][1]; o.z = xv.z + acc[m][n][2]; o.w = xv.w + acc[m][n][3];
        if (!DRY(p)) *(float4*)(p.out + (size_t)row * 1024 + col) = o;
      }
    }
  }
}

constexpr int QS_STRIDE = 144, KS_STRIDE = 144, VT_STRIDE = 432;
struct AttnRaw { u32x4 q0, q1, ka0, kb0, va0, vb0, ka1, kb1, va1, vb1, ka2, kb2, va2, vb2, ka3, kb3, va3, vb3; };
__device__ __forceinline__ void attn_issue(const Params& p, int item, AttnRaw& R) {
  const int tid = get_tid();
  const int n = item % 12, run = item / 12, T0 = run * 64;
  const int g = n >> 2, d = g == 0 ? 1 : (g == 1 ? 4 : 16);
  int sstart, slen; seq_of(T0, sstart, slen);
  const int rho = (T0 - sstart) >> 6;
  const int r = rho % d, i0 = (rho / d) * 64;
  const int part = tid & 3;
  {
    const int q = tid >> 2;
    const int pq = d * (i0 + q) + r;
    const bf16_t* base = p.qkv + (size_t)(sstart + pq) * QKVW + n * 64 + part * 16;
    R.q0 = *(const u32x4*)base; R.q1 = *(const u32x4*)(base + 8);
  }
#define ATTN_ISSUE1(IT, KA, KB, VA, VB) { const int rr = (tid >> 2) + (IT) * 64; const int pos = d * (i0 - 64 + rr) + r; \
    const bool ok = rr < 192 && pos >= 0 && pos < slen; const u32x4 z = {0u, 0u, 0u, 0u}; KA = z; KB = z; VA = z; VB = z; \
    if (ok) { const bf16_t* base = p.qkv + (size_t)(sstart + pos) * QKVW + n * 64 + part * 16; \
      KA = *(const u32x4*)(base + 768); KB = *(const u32x4*)(base + 768 + 8); VA = *(const u32x4*)(base + 1536); VB = *(const u32x4*)(base + 1536 + 8); } }
  ATTN_ISSUE1(0, R.ka0, R.kb0, R.va0, R.vb0)
  ATTN_ISSUE1(1, R.ka1, R.kb1, R.va1, R.vb1)
  ATTN_ISSUE1(2, R.ka2, R.kb2, R.va2, R.vb2)
}

__device__ __forceinline__ void attn_item(const Params& p, int layer, int item, AttnRaw& R, int next_item, unsigned char* smem) {
  const int tid = get_tid(), lane = tid & 63, w = tid >> 6;
  const int n = item % 12, run = item / 12, T0 = run * 64;
  const int g = n >> 2, h = n & 3, d = g == 0 ? 1 : (g == 1 ? 4 : 16);
  int sstart, slen; seq_of(T0, sstart, slen);
  const int rho = (T0 - sstart) >> 6;
  const int r = rho % d, i0 = (rho / d) * 64;
  unsigned char* Qs = smem;
  unsigned char* Ks = smem + 64 * QS_STRIDE;
  unsigned char* Vt = Ks + 208 * KS_STRIDE;
  const float* kg = p.k_norm_g + layer * 64;
  const float* qg = p.q_norm_g + layer * 64;
  const int part = tid & 3;
  {
    const int q = tid >> 2;
    *(u32x4*)(Qs + q * QS_STRIDE + part * 32) = R.q0;
    *(u32x4*)(Qs + q * QS_STRIDE + part * 32 + 16) = R.q1;
  }
#define ATTN_PUT1(IT, KA, KB, VA, VB) { const int rr = (tid >> 2) + (IT) * 64; \
    if (rr < 208) { *(u32x4*)(Ks + rr * KS_STRIDE + part * 32) = KA; *(u32x4*)(Ks + rr * KS_STRIDE + part * 32 + 16) = KB; \
      const unsigned vw[8] = {VA[0], VA[1], VA[2], VA[3], VB[0], VB[1], VB[2], VB[3]}; \
      _Pragma("unroll") for (int j = 0; j < 8; ++j) { \
        *(bf16_t*)(Vt + (part * 16 + 2 * j) * VT_STRIDE + rr * 2) = (bf16_t)(vw[j] & 0xffffu); \
        *(bf16_t*)(Vt + (part * 16 + 2 * j + 1) * VT_STRIDE + rr * 2) = (bf16_t)(vw[j] >> 16); } } }
  ATTN_PUT1(0, R.ka0, R.kb0, R.va0, R.vb0)
  ATTN_PUT1(1, R.ka1, R.kb1, R.va1, R.vb1)
  ATTN_PUT1(2, R.ka2, R.kb2, R.va2, R.vb2)
  if (next_item >= 0) attn_issue(p, next_item, R);
  __syncthreads();
  const int dl = lane & 15, gq = lane >> 4;
  bf16x8 qf0 = *(const bf16x8*)(Qs + (16 * w + dl) * QS_STRIDE + gq * 16);
  bf16x8 qf1 = *(const bf16x8*)(Qs + (16 * w + dl) * QS_STRIDE + 64 + gq * 16);
  const float slope = exp2f(-8.f * (float)(n + 1) / 12.f) * (float)d;
  float pv[10][4];
  float dsum = 0.f;
#pragma unroll
  for (int j = 0; j < 4; ++j) pv[9][j] = 0.f;
#pragma unroll
  for (int t = 0; t < 9; ++t) {
    const unsigned char* kp = Ks + ((w + t) * 16 + dl) * KS_STRIDE + gq * 16;
    f32x4 sacc = {0.f, 0.f, 0.f, 0.f};
    sacc = __builtin_amdgcn_mfma_f32_16x16x32_bf16(*(const bf16x8*)kp, qf0, sacc, 0, 0, 0);
    sacc = __builtin_amdgcn_mfma_f32_16x16x32_bf16(*(const bf16x8*)(kp + 64), qf1, sacc, 0, 0, 0);
#pragma unroll
    for (int j = 0; j < 4; ++j) {
      const int m = 16 * t + 4 * gq + j - dl;
      const int kr = (w + t) * 16 + 4 * gq + j;
      const int pos = d * (i0 - 64 + kr) + r;
      const bool ok = m >= 0 && m <= 128 && pos >= 0 && pos < slen;
      const float e = ok ? __expf(sacc[j] - slope * fabsf((float)(m - 64))) : 0.f;
      pv[t][j] = e; dsum += e;
    }
  }
  f32x4 oacc[4];
#pragma unroll
  for (int dt = 0; dt < 4; ++dt) oacc[dt] = (f32x4){0.f, 0.f, 0.f, 0.f};
#pragma unroll
  for (int u = 0; u < 5; ++u) {
    union { bf16x8 v; unsigned uu[4]; } pb;
    pb.uu[0] = pack2(pv[2 * u][0], pv[2 * u][1]); pb.uu[1] = pack2(pv[2 * u][2], pv[2 * u][3]);
    pb.uu[2] = pack2(pv[2 * u + 1][0], pv[2 * u + 1][1]); pb.uu[3] = pack2(pv[2 * u + 1][2], pv[2 * u + 1][3]);
#pragma unroll
    for (int dt = 0; dt < 4; ++dt) {
      const unsigned char* vp = Vt + (dt * 16 + dl) * VT_STRIDE + ((w + 2 * u) * 16 + 4 * gq) * 2;
      union { bf16x8 v; uint2 h2[2]; } va;
      va.h2[0] = *(const uint2*)vp; va.h2[1] = u < 4 ? *(const uint2*)(vp + 32) : make_uint2(0u, 0u);
      oacc[dt] = __builtin_amdgcn_mfma_f32_16x16x32_bf16(va.v, pb.v, oacc[dt], 0, 0, 0);
    }
  }
  dsum += __shfl_xor(dsum, 16); dsum += __shfl_xor(dsum, 32);
  {
    const int ql = 16 * w + dl;
    const size_t tok = (size_t)(sstart + d * (i0 + ql) + r);
    bf16_t* np = p.pnum + (size_t)g * ((size_t)MTOK * 256) + (tok * 4 + h) * 64 + 4 * gq;
#pragma unroll
    for (int dt = 0; dt < 4; ++dt) { uint2 o; o.x = pack2(oacc[dt][0], oacc[dt][1]); o.y = pack2(oacc[dt][2], oacc[dt][3]); *(uint2*)(np + dt * 16) = o; }
    if (gq == 0) p.pden[(size_t)g * ((size_t)MTOK * 4) + tok * 4 + h] = dsum;
  }
  __syncthreads();
}

__device__ void attn_combine(const Params& p) {
  const size_t nvec = (size_t)MTOK * 64;
  for (size_t i = (size_t)blockIdx.x * 256 + get_tid(); i < nvec; i += (size_t)gridDim.x * 256) {
    const size_t th = i >> 4;
    const int e4 = (int)(i & 15);
    f32x4 a, b, c;
    { const uint2 u0 = *(const uint2*)(p.pnum + i * 4), u1 = *(const uint2*)(p.pnum + (size_t)MTOK * 256 + i * 4), u2 = *(const uint2*)(p.pnum + 2 * (size_t)MTOK * 256 + i * 4);
      a[0] = __uint_as_float(u0.x << 16); a[1] = __uint_as_float(u0.x & 0xffff0000u); a[2] = __uint_as_float(u0.y << 16); a[3] = __uint_as_float(u0.y & 0xffff0000u);
      b[0] = __uint_as_float(u1.x << 16); b[1] = __uint_as_float(u1.x & 0xffff0000u); b[2] = __uint_as_float(u1.y << 16); b[3] = __uint_as_float(u1.y & 0xffff0000u);
      c[0] = __uint_as_float(u2.x << 16); c[1] = __uint_as_float(u2.x & 0xffff0000u); c[2] = __uint_as_float(u2.y << 16); c[3] = __uint_as_float(u2.y & 0xffff0000u); }
    const float den = p.pden[th] + p.pden[(size_t)MTOK * 4 + th] + p.pden[2 * (size_t)MTOK * 4 + th];
    const float inv = 1.f / den;
    const size_t tok = th >> 2; const int h = (int)(th & 3);
    bf16_t* y = p.ys + tok * 1024 + h * 64 + e4 * 4;
    uint2 yv = *(const uint2*)y;
    float y0 = __uint_as_float(yv.x << 16), y1 = __uint_as_float(yv.x & 0xffff0000u), y2 = __uint_as_float(yv.y << 16), y3 = __uint_as_float(yv.y & 0xffff0000u);
    uint2 o; o.x = pack2(y0 * (a[0] + b[0] + c[0]) * inv, y1 * (a[1] + b[1] + c[1]) * inv); o.y = pack2(y2 * (a[2] + b[2] + c[2]) * inv, y3 * (a[3] + b[3] + c[3]) * inv);
    if (!DRY(p)) *(uint2*)y = o;
  }
}

__device__ void pool_item(const Params& p, int layer, int item, unsigned char* smem) {
  const int tid = get_tid(), lane = tid & 63, wave = tid >> 6, dl = lane & 15, gq = lane >> 4;
  const int g = item & 3, T0 = (item >> 2) * 64;
  int sstart, slen; seq_of(T0, sstart, slen);
  const int P0 = T0 - sstart;
  const int hw = 1 << g;
  float* u = (float*)smem;
  bf16_t* db = (bf16_t*)(u + 80 * 64);
  for (int i = tid; i < 80 * 64; i += 256) {
    const int rr = i >> 6, c = i & 63, pos = P0 - 8 + rr;
    u[i] = (pos >= 0 && pos < slen) ? bf2f(p.rest[(size_t)(sstart + pos) * RESTW + g * 64 + c]) : 0.f;
  }
  const float* pw = p.pool_w + ((size_t)layer * 4 + g) * 4096 + 16 * wave + dl;
  bf16x8 af[2];
#pragma unroll
  for (int ks = 0; ks < 2; ++ks) {
    union { bf16x8 v; unsigned uu[4]; } f;
#pragma unroll
    for (int e = 0; e < 4; ++e) { const int c = ks * 32 + gq * 8 + 2 * e; f.uu[e] = pack2(pw[c * 64], pw[(c + 1) * 64]); }
    af[ks] = f.v;
  }
  __syncthreads();
  for (int i = tid; i < 64 * 64; i += 256) {
    const int t = i >> 6, c = i & 63, pos = P0 + t;
    float sm = 0.f;
    for (int o = -hw; o < hw; ++o) sm += u[(t + 8 + o) * 64 + c];
    const int lo = pos - hw > 0 ? pos - hw : 0, hi = pos + hw < slen ? pos + hw : slen;
    db[t * 72 + c] = f2bf(sm / (float)(hi - lo) - u[(t + 8) * 64 + c]);
  }
  __syncthreads();
  const f32x4 sc = *(const f32x4*)(p.pool_scale + layer * 256 + g * 64 + 16 * wave + 4 * gq);
#pragma unroll
  for (int tt = 0; tt < 4; ++tt) {
    f32x4 acc = {0.f, 0.f, 0.f, 0.f};
#pragma unroll
    for (int ks = 0; ks < 2; ++ks) {
      const bf16x8 bd = *(const bf16x8*)(db + (tt * 16 + dl) * 72 + ks * 32 + gq * 8);
      acc = __builtin_amdgcn_mfma_f32_16x16x32_bf16(af[ks], bd, acc, 0, 0, 0);
    }
    bf16_t* y = p.ys + (size_t)(T0 + tt * 16 + dl) * 1024 + 256 + g * 64 + 16 * wave + 4 * gq;
    const uint2 yv = *(const uint2*)y;
    uint2 o;
    o.x = pack2(__uint_as_float(yv.x << 16) * acc[0] * sc[0], __uint_as_float(yv.x & 0xffff0000u) * acc[1] * sc[1]);
    o.y = pack2(__uint_as_float(yv.y << 16) * acc[2] * sc[2], __uint_as_float(yv.y & 0xffff0000u) * acc[3] * sc[3]);
    if (!DRY(p)) *(uint2*)y = o;
  }
  __syncthreads();
}

__device__ void sg_item(const Params& p, int layer, int item, unsigned char* smem) {
  const int tid = get_tid(), lane = tid & 63, wave = tid >> 6, dl = lane & 15, gq = lane >> 4;
  const int g = item & 3, T0 = (item >> 2) * 128;
  bf16_t* vnT = (bf16_t*)smem;
  for (int s_ = wave; s_ < 128; s_ += 4) {
    const bf16_t* vr = p.rest + (size_t)(T0 + s_) * RESTW + 512;
    float ss = 0.f; float mine = 0.f;
#pragma unroll
    for (int j = 0; j < 4; ++j) { float v = bf2f(vr[j * 64 + lane]); ss += v * v; if (j == g) mine = v; }
    ss = wave_sum(ss);
    const float rs = rsqrtf(ss * (1.f / 256.f) + 1e-6f);
    vnT[lane * 136 + s_] = f2bf(mine * rs * p.sg_norm_g[layer * 256 + g * 64 + lane]);
  }
  __syncthreads();
  const float* gw = p.sg_w + ((size_t)layer * 4 + g) * 128 * 128;
#pragma unroll 1
  for (int tt2 = 0; tt2 < 2; ++tt2) {
    const int t = (wave * 2 + tt2) * 16 + dl;
    const float* wrow = gw + t * 128 + gq * 8;
    f32x4 acc[4];
#pragma unroll
    for (int dt = 0; dt < 4; ++dt) acc[dt] = (f32x4){0.f, 0.f, 0.f, 0.f};
#pragma unroll
    for (int ks = 0; ks < 4; ++ks) {
      const f32x4 w0 = *(const f32x4*)(wrow + ks * 32), w1 = *(const f32x4*)(wrow + ks * 32 + 4);
      union { bf16x8 v; unsigned uu[4]; } bw;
      bw.uu[0] = pack2(w0[0], w0[1]); bw.uu[1] = pack2(w0[2], w0[3]); bw.uu[2] = pack2(w1[0], w1[1]); bw.uu[3] = pack2(w1[2], w1[3]);
#pragma unroll
      for (int dt = 0; dt < 4; ++dt) {
        const bf16x8 av = *(const bf16x8*)(vnT + (dt * 16 + dl) * 136 + ks * 32 + gq * 8);
        acc[dt] = __builtin_amdgcn_mfma_f32_16x16x32_bf16(av, bw.v, acc[dt], 0, 0, 0);
      }
    }
    const float bias = p.sg_b[(layer * 4 + g) * 128 + t];
#pragma unroll
    for (int dt = 0; dt < 4; ++dt) {
      const int d0 = dt * 16 + 4 * gq;
      const uint2 uv = *(const uint2*)(p.rest + (size_t)(T0 + t) * RESTW + 256 + g * 64 + d0);
      bf16_t* y = p.ys + (size_t)(T0 + t) * 1024 + 512 + g * 64 + d0;
      const uint2 yv = *(const uint2*)y;
      uint2 o;
      o.x = pack2(__uint_as_float(yv.x << 16) * __uint_as_float(uv.x << 16) * (acc[dt][0] + bias), __uint_as_float(yv.x & 0xffff0000u) * __uint_as_float(uv.x & 0xffff0000u) * (acc[dt][1] + bias));
      o.y = pack2(__uint_as_float(yv.y << 16) * __uint_as_float(uv.y << 16) * (acc[dt][2] + bias), __uint_as_float(yv.y & 0xffff0000u) * __uint_as_float(uv.y & 0xffff0000u) * (acc[dt][3] + bias));
      if (!DRY(p)) *(uint2*)y = o;
    }
  }
  __syncthreads();
}

constexpr int SBT = 16;
struct RwkvLds {
  bf16_t twb[SBT * 72], tab[SBT * 72];
  float accw[SBT * 64], acca[SBT * 64];
  float R[SBT * 64], W[SBT * 64], K[SBT * 64], V[SBT * 64], KK[SBT * 64], B[SBT * 64];
  float ot[SBT * 64];
  float bon[SBT * 64];
};

__device__ __forceinline__ float red8(float v) { v += dpp_qx1(v); v += dpp_qx2(v); v += dpp_hm(v); return v; }
__device__ __forceinline__ float red16(float v) { v = red8(v); v += __int_as_float(__builtin_amdgcn_update_dpp(0, __float_as_int(v), 0x140, 0xF, 0xF, true)); return v; }

struct ScanOps { f32x4 w0, w1, b0, b1, kk0, kk1, k0, k1, r0, r1; float2 v; };
template <bool PASS_C>
__device__ __forceinline__ ScanOps load_ops(const RwkvLds& L, int tk, int j0, int row0) {
  ScanOps o;
  o.w0 = *(const f32x4*)(L.W + tk * 64 + j0); o.w1 = *(const f32x4*)(L.W + tk * 64 + j0 + 4);
  o.b0 = *(const f32x4*)(L.B + tk * 64 + j0); o.b1 = *(const f32x4*)(L.B + tk * 64 + j0 + 4);
  o.kk0 = *(const f32x4*)(L.KK + tk * 64 + j0); o.kk1 = *(const f32x4*)(L.KK + tk * 64 + j0 + 4);
  o.k0 = *(const f32x4*)(L.K + tk * 64 + j0); o.k1 = *(const f32x4*)(L.K + tk * 64 + j0 + 4);
  if (PASS_C) { o.r0 = *(const f32x4*)(L.R + tk * 64 + j0); o.r1 = *(const f32x4*)(L.R + tk * 64 + j0 + 4); }
  else { o.r0 = o.w0; o.r1 = o.w1; }
  o.v = *(const float2*)(L.V + tk * 64 + row0);
  return o;
}

#define RAW_LOAD(SBI) { _Pragma("unroll") for (int i = 0; i < 4; ++i) { \
      const int tau = (SBI) * SBT + wave * 4 + i; \
      const int t = dir ? (t0 + 127 - tau) : (t0 + tau); \
      const bf16_t* cr = p.rest + (size_t)t * RESTW; \
      raw[i][0] = cr[768 + cidx]; raw[i][1] = cr[1024 + cidx]; raw[i][2] = cr[1280 + cidx]; raw[i][3] = cr[1536 + dir * 128 + lane]; raw[i][4] = cr[1536 + dir * 128 + 64 + lane]; \
      if (i == 0) { const int tp = dir ? t + 1 : t - 1; const bool pv = tp >= sstart && tp < send; const bf16_t* pr = p.rest + (size_t)(pv ? tp : t) * RESTW; \
        rawp[0] = pv ? pr[768 + cidx] : (bf16_t)0; rawp[1] = pv ? pr[1024 + cidx] : (bf16_t)0; rawp[2] = pv ? pr[1280 + cidx] : (bf16_t)0; \
        rawp[3] = pv ? pr[1536 + dir * 128 + lane] : (bf16_t)0; rawp[4] = pv ? pr[1536 + dir * 128 + 64 + lane] : (bf16_t)0; } } }

template <bool PASS_C>
__device__ void rwkv_job(const Params& p, int layer, int job, unsigned char* smem) {
  RwkvLds& L = *(RwkvLds*)smem;
  const int tid = get_tid(), lane = tid & 63, wave = tid >> 6;
  const int hd = job & 3, cp = job >> 2, t0 = cp * 128;
  int sstart, slen; seq_of(t0, sstart, slen);
  const int send = sstart + slen;
  const int rp = tid >> 3, jg = tid & 7, row0 = rp * 2, j0 = jg * 8;
  float* ytg0 = p.pg + ((size_t)cp * 8 + hd) * 8192;
  float* ytg1 = p.pg + ((size_t)cp * 8 + 4 + hd) * 8192;
#pragma unroll 1
  for (int dir = 0; dir < 2; ++dir) {
    const int ld = layer * 2 + dir;
    float* slot = p.pg + ((size_t)cp * 8 + dir * 4 + hd) * 8192;
    __syncthreads();
    bf16x8 wfr[2], afr[2];
    {
      const int dl_ = lane & 15, gq_ = lane >> 4;
      const float* wsrc = p.w_up + (size_t)ld * 64 * 256 + hd * 64 + 16 * wave + dl_;
      const float* asrc = p.a_up + (size_t)ld * 64 * 256 + hd * 64 + 16 * wave + dl_;
#pragma unroll
      for (int ks = 0; ks < 2; ++ks) {
        union { bf16x8 v; unsigned u[4]; } fw, fa;
#pragma unroll
        for (int e = 0; e < 4; ++e) {
          const int m = ks * 32 + gq_ * 8 + 2 * e;
          fw.u[e] = pack2(wsrc[(size_t)m * 256], wsrc[(size_t)(m + 1) * 256]);
          fa.u[e] = pack2(asrc[(size_t)m * 256], asrc[(size_t)(m + 1) * 256]);
        }
        wfr[ks] = fw.v; afr[ks] = fa.v;
      }
    }
    f32x2 S[2][4], Pst[2][4];
#pragma unroll
    for (int rr = 0; rr < 2; ++rr)
#pragma unroll
      for (int q = 0; q < 4; ++q) {
        if (PASS_C) { S[rr][q] = *(const f32x2*)(slot + 4096 + (row0 + rr) * 64 + j0 + 2 * q); Pst[rr][q] = (f32x2){0.f, 0.f}; }
        else { S[rr][q] = (f32x2){0.f, 0.f}; Pst[rr][q] = (f32x2){(row0 + rr == j0 + 2 * q) ? 1.f : 0.f, (row0 + rr == j0 + 2 * q + 1) ? 1.f : 0.f}; }
      }
    const int cidx = hd * 64 + lane;
    const float mu_r = p.mu_rkv[ld * 768 + cidx], mu_k = p.mu_rkv[ld * 768 + 256 + cidx], mu_v = p.mu_rkv[ld * 768 + 512 + cidx];
    const float mu_w = p.mu_lat[ld * 128 + lane], mu_a = p.mu_lat[ld * 128 + 64 + lane];
    const float w0v = p.w0[ld * 256 + cidx], a0v = p.a0[ld * 256 + cidx];
    const float kkv = p.k_k[ld * 256 + cidx], kav = p.k_a[ld * 256 + cidx], rkv_ = p.r_k[ld * 256 + cidx];
    bf16_t raw[4][5], rawp[5];
    RAW_LOAD(0)
#pragma unroll 1
    for (int sb = 0; sb < 128 / SBT; ++sb) {
      __syncthreads();
#pragma unroll
      for (int i = 0; i < 4; ++i) {
        const int tk = wave * 4 + i;
        const float cr_r = bf2f(raw[i][0]), cr_k = bf2f(raw[i][1]), cr_v = bf2f(raw[i][2]), cr_w = bf2f(raw[i][3]), cr_a = bf2f(raw[i][4]);
        const float pr_r = bf2f(i ? raw[i ? i - 1 : 0][0] : rawp[0]), pr_k = bf2f(i ? raw[i ? i - 1 : 0][1] : rawp[1]), pr_v = bf2f(i ? raw[i ? i - 1 : 0][2] : rawp[2]);
        const float pr_w = bf2f(i ? raw[i ? i - 1 : 0][3] : rawp[3]), pr_a = bf2f(i ? raw[i ? i - 1 : 0][4] : rawp[4]);
        L.R[tk * 64 + lane] = cr_r + (pr_r - cr_r) * mu_r;
        L.K[tk * 64 + lane] = cr_k + (pr_k - cr_k) * mu_k;
        L.V[tk * 64 + lane] = cr_v + (pr_v - cr_v) * mu_v;
        { const float xw = cr_w + (pr_w - cr_w) * mu_w; L.twb[tk * 72 + lane] = f2bf(1.f - 2.f * __builtin_amdgcn_rcpf(1.f + __expf(2.f * xw))); }
        L.tab[tk * 72 + lane] = f2bf(cr_a + (pr_a - cr_a) * mu_a);
      }
      if (sb + 1 < 128 / SBT) RAW_LOAD(sb + 1)
      __syncthreads();
      {
        const int dl_ = lane & 15, gq_ = lane >> 4;
        f32x4 dw = {0.f, 0.f, 0.f, 0.f}, da = {0.f, 0.f, 0.f, 0.f};
#pragma unroll
        for (int ks = 0; ks < 2; ++ks) {
          const bf16x8 bw = *(const bf16x8*)(L.twb + dl_ * 72 + ks * 32 + gq_ * 8);
          const bf16x8 ba = *(const bf16x8*)(L.tab + dl_ * 72 + ks * 32 + gq_ * 8);
          dw = __builtin_amdgcn_mfma_f32_16x16x32_bf16(wfr[ks], bw, dw, 0, 0, 0);
          da = __builtin_amdgcn_mfma_f32_16x16x32_bf16(afr[ks], ba, da, 0, 0, 0);
        }
        *(f32x4*)(L.accw + dl_ * 64 + 16 * wave + 4 * gq_) = dw;
        *(f32x4*)(L.acca + dl_ * 64 + 16 * wave + 4 * gq_) = da;
      }
      __syncthreads();
      float accw[4], acca[4];
#pragma unroll
      for (int i = 0; i < 4; ++i) { accw[i] = L.accw[(wave * 4 + i) * 64 + lane]; acca[i] = L.acca[(wave * 4 + i) * 64 + lane]; }
#pragma unroll
      for (int i = 0; i < 4; ++i) {
        const int tk = wave * 4 + i;
        const float wpre = w0v + accw[i];
        const float nx = -wpre;
        const float sp = fmaxf(nx, 0.f) + __logf(1.f + __expf(-fabsf(nx)));
        const float wlog = -sp - 0.5f;
        const float decay = __expf(-__expf(wlog));
        const float a = sigmoidf_(a0v + acca[i]);
        const float k = L.K[tk * 64 + lane], r = L.R[tk * 64 + lane], v = L.V[tk * 64 + lane];
        float kk = k * kkv;
        const float ss = wave_sum(kk * kk);
        kk *= rsqrtf(ss + 1e-12f);
        const float k2 = k * (1.f + (a - 1.f) * kav);
        L.W[tk * 64 + lane] = decay; L.K[tk * 64 + lane] = k2; L.KK[tk * 64 + lane] = kk; L.B[tk * 64 + lane] = kk * a;
        if (PASS_C) { const float bs = wave_sum(r * k2 * rkv_); L.bon[tk * 64 + lane] = bs * v; }
      }
      __syncthreads();
      ScanOps cur = load_ops<PASS_C>(L, 0, j0, row0);
#pragma unroll 8
      for (int tk = 0; tk < SBT; ++tk) {
        const ScanOps nx = load_ops<PASS_C>(L, (tk + 1) & (SBT - 1), j0, row0);
        const f32x2 w2[4] = {cur.w0.lo, cur.w0.hi, cur.w1.lo, cur.w1.hi};
        const f32x2 b2[4] = {cur.b0.lo, cur.b0.hi, cur.b1.lo, cur.b1.hi};
        const f32x2 kk2[4] = {cur.kk0.lo, cur.kk0.hi, cur.kk1.lo, cur.kk1.hi};
        const f32x2 k2[4] = {cur.k0.lo, cur.k0.hi, cur.k1.lo, cur.k1.hi};
        const float vr[2] = {cur.v.x, cur.v.y};
        float sa[2], sp[2] = {0.f, 0.f};
#pragma unroll
        for (int rr = 0; rr < 2; ++rr) {
          f32x2 a = S[rr][0] * kk2[0];
          a += S[rr][1] * kk2[1]; a += S[rr][2] * kk2[2]; a += S[rr][3] * kk2[3];
          sa[rr] = a.x + a.y;
          if (!PASS_C) {
            f32x2 q_ = Pst[rr][0] * kk2[0];
            q_ += Pst[rr][1] * kk2[1]; q_ += Pst[rr][2] * kk2[2]; q_ += Pst[rr][3] * kk2[3];
            sp[rr] = q_.x + q_.y;
          }
        }
        sa[0] = red8(sa[0]); sa[1] = red8(sa[1]);
        if (!PASS_C) { sp[0] = red8(sp[0]); sp[1] = red8(sp[1]); }
#pragma unroll
        for (int rr = 0; rr < 2; ++rr)
#pragma unroll
          for (int q = 0; q < 4; ++q) {
            S[rr][q] = S[rr][q] * w2[q] + (k2[q] * vr[rr] - b2[q] * sa[rr]);
            if (!PASS_C) Pst[rr][q] = Pst[rr][q] * w2[q] - b2[q] * sp[rr];
          }
        if (PASS_C) {
          const f32x2 r2[4] = {cur.r0.lo, cur.r0.hi, cur.r1.lo, cur.r1.hi};
          f32x2 oa = S[0][0] * r2[0]; oa += S[0][1] * r2[1]; oa += S[0][2] * r2[2]; oa += S[0][3] * r2[3];
          f32x2 ob = S[1][0] * r2[0]; ob += S[1][1] * r2[1]; ob += S[1][2] * r2[2]; ob += S[1][3] * r2[3];
          float o0 = red8(oa.x + oa.y), o1 = red8(ob.x + ob.y);
          if (jg == 0) { L.ot[tk * 64 + row0] = o0; L.ot[tk * 64 + row0 + 1] = o1; }
        }
        cur = nx;
      }
      if (PASS_C) {
        __syncthreads();
        const int x = tid >> 4, part = tid & 15;
        const int tk = dir ? (SBT - 1 - x) : x, tau = sb * SBT + tk;
        const int tl = dir ? (127 - tau) : tau;
        const f32x4 ov = *(const f32x4*)(L.ot + tk * 64 + part * 4);
        float o[4] = {ov[0], ov[1], ov[2], ov[3]};
        float s1 = red16(o[0] + o[1] + o[2] + o[3]);
        const float mu = s1 * (1.f / 64.f);
        float s2 = 0.f;
#pragma unroll
        for (int e = 0; e < 4; ++e) { o[e] -= mu; s2 += o[e] * o[e]; }
        s2 = red16(s2);
        const float rs = rsqrtf(s2 * (1.f / 64.f) + 64e-5f);
        const int ch = hd * 64 + part * 4;
        const f32x4 lg = *(const f32x4*)(p.ln_g + layer * 256 + ch), lb = *(const f32x4*)(p.ln_b + layer * 256 + ch);
        const f32x4 bo = *(const f32x4*)(L.bon + tk * 64 + part * 4);
        f32x4 y;
#pragma unroll
        for (int e = 0; e < 4; ++e) y[e] = o[e] * rs * lg[e] + lb[e] + bo[e];
        float* yg = (tl < 64 ? ytg0 + tl * 64 : ytg1 + (tl - 64) * 64) + part * 4;
        if (dir == 0) *(f32x4*)yg = y;
        else {
          const f32x4 y0 = *(const f32x4*)yg;
          bf16_t* yp = p.ys + (size_t)(t0 + tl) * 1024 + 768 + ch;
          const uint2 yv = *(const uint2*)yp;
          uint2 ov2;
          ov2.x = pack2(__uint_as_float(yv.x << 16) * (y[0] + y0[0]), __uint_as_float(yv.x & 0xffff0000u) * (y[1] + y0[1]));
          ov2.y = pack2(__uint_as_float(yv.y << 16) * (y[2] + y0[2]), __uint_as_float(yv.y & 0xffff0000u) * (y[3] + y0[3]));
          if (!DRY(p)) *(uint2*)yp = ov2;
        }
      }
    }
    if (!PASS_C) {
#pragma unroll
      for (int rr = 0; rr < 2; ++rr)
#pragma unroll
        for (int q = 0; q < 4; ++q) { *(f32x2*)(slot + (row0 + rr) * 64 + j0 + 2 * q) = Pst[rr][q]; *(f32x2*)(slot + 4096 + (row0 + rr) * 64 + j0 + 2 * q) = S[rr][q]; }
    }
  }
  __syncthreads();
}

__device__ void rwkv_passB(const Params& p, unsigned char* smem) {
  float* Pl = (float*)smem;
  float* Sl = Pl + 2 * 4096;
  const int tid = get_tid();
  for (int wk = blockIdx.x; wk < 128; wk += gridDim.x) {
    const int rg = wk & 3, hd = (wk >> 2) & 3, dir = (wk >> 4) & 1, seq = wk >> 5;
    const int cbase = seq == 0 ? 0 : seq == 1 ? 64 : seq == 2 ? 128 : 256;
    const int nch = seq < 2 ? 64 : 128;
    const int row = tid >> 4, jq = tid & 15;
    __syncthreads();
    for (int i = tid; i < 2 * 16 * 64; i += 256) Sl[i] = 0.f;
    float4 pf0, pf1, pf2, pf3, gf;
    {
      const int c = dir ? nch - 1 : 0;
      const float* slot = p.pg + ((size_t)(cbase + c) * 8 + dir * 4 + hd) * 8192;
      pf0 = ((const float4*)slot)[tid]; pf1 = ((const float4*)slot)[tid + 256]; pf2 = ((const float4*)slot)[tid + 512]; pf3 = ((const float4*)slot)[tid + 768];
      gf = *(const float4*)(slot + 4096 + (rg * 16 + row) * 64 + jq * 4);
    }
#pragma unroll 1
    for (int ci = 0; ci < nch; ++ci) {
      const int c = dir ? nch - 1 - ci : ci;
      float* slot = p.pg + ((size_t)(cbase + c) * 8 + dir * 4 + hd) * 8192;
      float* Pb = Pl + (ci & 1) * 4096;
      ((float4*)Pb)[tid] = pf0; ((float4*)Pb)[tid + 256] = pf1; ((float4*)Pb)[tid + 512] = pf2; ((float4*)Pb)[tid + 768] = pf3;
      float* gp = slot + 4096 + (rg * 16 + row) * 64 + jq * 4;
      float4 acc = gf;
      if (ci + 1 < nch) {
        const int c2 = dir ? nch - 2 - ci : ci + 1;
        const float* s2 = p.pg + ((size_t)(cbase + c2) * 8 + dir * 4 + hd) * 8192;
        pf0 = ((const float4*)s2)[tid]; pf1 = ((const float4*)s2)[tid + 256]; pf2 = ((const float4*)s2)[tid + 512]; pf3 = ((const float4*)s2)[tid + 768];
        gf = *(const float4*)(s2 + 4096 + (rg * 16 + row) * 64 + jq * 4);
      }
      __syncthreads();
      const float* Sc = Sl + (ci & 1) * 1024;
      const float4 sold = *(const float4*)(Sc + row * 64 + jq * 4);
#pragma unroll 4
      for (int m4 = 0; m4 < 16; ++m4) {
        const float4 s4 = *(const float4*)(Sc + row * 64 + m4 * 4);
        const float sv[4] = {s4.x, s4.y, s4.z, s4.w};
#pragma unroll
        for (int e = 0; e < 4; ++e) {
          const float4 pv = *(const float4*)(Pb + (m4 * 4 + e) * 64 + jq * 4);
          acc.x += sv[e] * pv.x; acc.y += sv[e] * pv.y; acc.z += sv[e] * pv.z; acc.w += sv[e] * pv.w;
        }
      }
      if (!DRY(p)) *(float4*)gp = sold;
      *(float4*)(Sl + ((ci + 1) & 1) * 1024 + row * 64 + jq * 4) = acc;
    }
  }
}

__device__ void phase_bmix(const Params& p, int layer, unsigned char* smem) {
  const int NA = 9216, NS = 1536, NP = 3072;
  const bool weighted = gridDim.x == 512;
  if (!weighted || blockIdx.x < 128) { __builtin_amdgcn_s_setprio(3); rwkv_passB(p, smem); __builtin_amdgcn_s_setprio(0); }
  int first, cnt, stride;
  if (weighted) {
    if (blockIdx.x >= 128) { first = (blockIdx.x - 128) * 24; cnt = 24; } else { first = 0; cnt = 0; }
    stride = 1;
  } else { first = blockIdx.x; stride = gridDim.x; cnt = (NA - first + stride - 1) / stride; if (first >= NA) cnt = 0; }
  if (cnt > 0) {
    AttnRaw R;
    attn_issue(p, first, R);
#pragma unroll 1
    for (int k = 0; k < cnt; ++k) attn_item(p, layer, first + k * stride, R, k + 1 < cnt ? first + (k + 1) * stride : -1, smem);
  }
  const int b0 = (int)blockIdx.x, bs = (int)gridDim.x;
  if (b0 >= 0) {
#pragma unroll 1
    for (int it = b0; it < NS + NP; it += bs) {
      if (it < NS) sg_item(p, layer, it, smem);
      else pool_item(p, layer, it - NS, smem);
    }
  }
}

#define XB_TMO      128
#define XB_XCNT(j)  (256  + 64 * (j))
#define XB_XSUB(j)  (1280 + 64 * (j))
#define XB_XGEN(j)  (2304 + 64 * (j))
#define XB_TOP      3328
#define XB_TOPGEN   3392
#define XCD_BAR_WORDS 3456
#define XB_SPIN_CAP (1u << 22)
__device__ __forceinline__ unsigned xb_ld(unsigned* q)              { return __hip_atomic_load(q, __ATOMIC_RELAXED, __HIP_MEMORY_SCOPE_AGENT); }
__device__ __forceinline__ unsigned xb_add(unsigned* q, unsigned v) { return __hip_atomic_fetch_add(q, v, __ATOMIC_RELAXED, __HIP_MEMORY_SCOPE_AGENT); }
__device__ __forceinline__ unsigned xb_xcc_id() { return (unsigned)__builtin_amdgcn_s_getreg((3 << 11) | 20) & 0xFu; }
#define XB_SPIN(cond, bar) do { unsigned _sp = 0; while (cond) { __builtin_amdgcn_s_sleep(1); \
    if ((++_sp & 255u) == 0u) { if (xb_ld(&(bar)[XB_TMO])) break; if (_sp > XB_SPIN_CAP) { atomicAdd(&(bar)[XB_TMO], 1u); break; } } } } while (0)
struct XcdBarrier { unsigned* bar; unsigned x; volatile LAS unsigned* st; };
__device__ __forceinline__ XcdBarrier xcd_barrier_post(unsigned* bar, volatile LAS unsigned* st) {
  XcdBarrier b; b.bar = bar; b.x = xb_xcc_id(); b.st = st;
  if (threadIdx.x == 0) (void)xb_add(&bar[XB_XCNT(b.x)], 1u);
  return b;
}
__device__ __forceinline__ void xcd_barrier_complete(unsigned* bar, unsigned x, unsigned& nloc, unsigned& nx) {
  const unsigned G = gridDim.x * gridDim.y * gridDim.z;
  unsigned sum, cnt, mine, sp = 0u;
  for (;;) {
    sum = 0u; cnt = 0u; mine = 0u;
#pragma unroll
    for (unsigned j = 0; j < 16; ++j) { const unsigned c = xb_ld(&bar[XB_XCNT(j)]); sum += c; cnt += (c > 0u) ? 1u : 0u; mine = (j == x) ? c : mine; }
    if (sum == G) break;
    __builtin_amdgcn_s_sleep(1);
    if ((++sp & 255u) == 0u) { if (xb_ld(&bar[XB_TMO])) break; if (sp > XB_SPIN_CAP) { atomicAdd(&bar[XB_TMO], 1u); break; } }
  }
  nloc = mine > 0u ? mine : 1u; nx = cnt > 0u ? cnt : 1u;
}
__device__ __forceinline__ void xcd_barrier(const XcdBarrier& b) {
  asm volatile("s_waitcnt vmcnt(0)" ::: "memory");
  __syncthreads();
  if (threadIdx.x == 0) {
    unsigned* bar = b.bar;
    __builtin_amdgcn_s_waitcnt(0);
    unsigned nloc = b.st[0], nx = b.st[1];
    if (nloc == 0u) { xcd_barrier_complete(bar, b.x, nloc, nx); b.st[0] = nloc; b.st[1] = nx; }
    const unsigned old = xb_add(&bar[XB_XSUB(b.x)], 1u);
    const unsigned gen = old / nloc;
    if (old + 1u == (gen + 1u) * nloc) {
      __builtin_amdgcn_fence(__ATOMIC_RELEASE, "agent");
      asm volatile("s_waitcnt vmcnt(0)" ::: "memory");
      const unsigned og = xb_add(&bar[XB_TOP], 1u);
      const unsigned tg = og / nx;
      if (og + 1u == (tg + 1u) * nx) xb_add(&bar[XB_TOPGEN], 1u);
      else XB_SPIN(xb_ld(&bar[XB_TOPGEN]) == tg, bar);
      __builtin_amdgcn_fence(__ATOMIC_ACQUIRE, "agent");
      xb_add(&bar[XB_XGEN(b.x)], 1u);
      asm volatile("s_waitcnt vmcnt(0)" ::: "memory");
    } else {
      XB_SPIN(xb_ld(&bar[XB_XGEN(b.x)]) == gen, bar);
      __builtin_amdgcn_fence(__ATOMIC_ACQUIRE, "agent");
      asm volatile("s_waitcnt vmcnt(0)" ::: "memory");
    }
  }
  __syncthreads();
}

__device__ __forceinline__ void run_phase(const Params& p, int layer, int sub, unsigned char* smem) {
  switch (sub) {
    case 0: phase_prep(p, layer, smem); break;
    case 1: phase_g1(p, layer, smem); break;
    case 2: for (int j = blockIdx.x; j < 1536; j += gridDim.x) rwkv_job<false>(p, layer, j, smem); break;
    case 3: phase_bmix(p, layer, smem); break;
    case 4: for (int j = blockIdx.x; j < 1536; j += gridDim.x) rwkv_job<true>(p, layer, j, smem); attn_combine(p); break;
    case 5: phase_branch(p, smem); break;
    case 6: phase_gate(p, layer, smem); break;
    case 7: phase_out(p, layer, smem); break;
  }
}
__global__ void __launch_bounds__(256, 2) mega(Params p) {
  extern __shared__ __attribute__((aligned(16))) unsigned char smem[];
  cg::grid_group grid = cg::this_grid();
  volatile LAS unsigned* bst = (volatile LAS unsigned*)((LAS unsigned char*)smem + 73728);
  if (threadIdx.x < 4) bst[threadIdx.x] = 0u;
  __syncthreads();
  const XcdBarrier xbar = xcd_barrier_post(p.bar, bst);
  for (int ph = p.phase_lo; ph < p.phase_hi; ++ph) {
    const int layer = ph / NPH, sub = ph % NPH;
#if PROBE_MASK
    for (int rep = (PROBE_MASK >> sub) & 1; rep >= 0; --rep) {
      __syncthreads(); if (get_tid() == 0) s_dry = rep; __syncthreads();
      run_phase(p, layer, sub, smem);
      if (rep) grid.sync();
    }
#else
    run_phase(p, layer, sub, smem);
#endif
    if (ph + 1 < p.phase_hi) { if (p.phase_hi < 0) grid.sync(); else xcd_barrier(xbar); }
  }
}

extern "C" void kernel_launch(void* const* d_in, const int* in_sizes, int n_in, void* d_out, int out_size, void* d_ws, size_t ws_size, hipStream_t stream) {
  static int grid_blocks = 0;
  if (!grid_blocks) {
    hipFuncSetAttribute((const void*)mega, hipFuncAttributeMaxDynamicSharedMemorySize, SMEM_BYTES);
    int dev = 0, cus = 0, per_cu = 0;
    hipGetDevice(&dev);
    hipDeviceGetAttribute(&cus, hipDeviceAttributeMultiprocessorCount, dev);
    hipOccupancyMaxActiveBlocksPerMultiprocessor(&per_cu, mega, 256, SMEM_BYTES);
    if (per_cu < 1) per_cu = 1;
    grid_blocks = cus * per_cu;
  }
  Params p{};
  p.xp = (const float*)d_in[0]; p.xs = (const float*)d_in[1];
  p.norm_g = (const float*)d_in[2]; p.w_in = (const float*)d_in[3]; p.q_norm_g = (const float*)d_in[4]; p.k_norm_g = (const float*)d_in[5];
  p.pool_w = (const float*)d_in[6]; p.pool_scale = (const float*)d_in[7]; p.sg_norm_g = (const float*)d_in[8]; p.sg_w = (const float*)d_in[9]; p.sg_b = (const float*)d_in[10];
  p.mu_rkv = (const float*)d_in[11]; p.mu_lat = (const float*)d_in[12]; p.w0 = (const float*)d_in[13]; p.w_up = (const float*)d_in[14]; p.a0 = (const float*)d_in[15]; p.a_up = (const float*)d_in[16];
  p.k_k = (const float*)d_in[17]; p.k_a = (const float*)d_in[18]; p.r_k = (const float*)d_in[19]; p.ln_g = (const float*)d_in[20]; p.ln_b = (const float*)d_in[21];
  p.w_branch = (const float*)d_in[22]; p.w_out = (const float*)d_in[23];
  p.out = (float*)d_out;
  unsigned char* ws = (unsigned char*)d_ws;
  size_t off = 0;
  p.qkv = (bf16_t*)(ws + off); off += (size_t)MTOK * QKVW * 2;
  p.rest = (bf16_t*)(ws + off); off += (size_t)MTOK * RESTW * 2;
  p.ys = (bf16_t*)(ws + off); off += (size_t)MTOK * 1024 * 2;
  p.w1t = (bf16_t*)(ws + off); off += (size_t)5120 * 1024 * 2;
  p.wgt = (bf16_t*)(ws + off); off += (size_t)4096 * 1024 * 2;
  p.wbrt = (bf16_t*)(ws + off); off += (size_t)4096 * 256 * 2;
  p.woutt = (bf16_t*)(ws + off); off += (size_t)1024 * 1024 * 2;
  p.rstd = nullptr;
  p.xb = (bf16_t*)(ws + off); off += (size_t)MTOK * 1024 * 2;
  p.pnum = (bf16_t*)(ws + off); off += (size_t)3 * MTOK * 256 * 2;
  p.pden = (float*)p.w1t;
  p.pg = (float*)(ws + off); off += (size_t)3072 * 8192 * 4;
  p.bar = (unsigned*)(ws + off); off += (size_t)XCD_BAR_WORDS * 4;
  p.branch = p.qkv;
  if (off > ws_size) { fprintf(stderr, "workspace too small: need %zu have %zu\n", off, ws_size); return; }
  (void)hipMemsetAsync(p.bar, 0, (size_t)XCD_BAR_WORDS * 4, stream);
#if MULTI_LAUNCH
  for (int ph = 0; ph < 2 * NPH; ++ph) {
    p.phase_lo = ph; p.phase_hi = ph + 1;
    hipLaunchKernelGGL(mega, dim3(grid_blocks), dim3(256), SMEM_BYTES, stream, p);
  }
#else
  p.phase_lo = 0; p.phase_hi = 2 * NPH;
  void* args[] = {&p};
  hipError_t e = hipLaunchCooperativeKernel((void*)mega, dim3(grid_blocks), dim3(256), args, SMEM_BYTES, stream);
  if (e != hipSuccess) fprintf(stderr, "cooperative launch failed: %s (grid %d)\n", hipGetErrorString(e), grid_blocks);
#endif
}
```

```cpp
#include <hip/hip_runtime.h>
#include <hip/hip_cooperative_groups.h>
#include <cstdio>
namespace cg = cooperative_groups;

#ifndef PROBE_MASK
#define PROBE_MASK 0
#endif
#ifndef PROBE_NOGL
#define PROBE_NOGL 0
#endif
#if PROBE_MASK
__shared__ int s_dry;
#define DRY(p) (s_dry)
#define NOGL (PROBE_NOGL && s_dry)
#else
#define DRY(p) 0
#define NOGL 0
#endif
#ifndef MULTI_LAUNCH
#define MULTI_LAUNCH 0
#endif

typedef unsigned short bf16_t;
typedef short bf16x8 __attribute__((ext_vector_type(8)));
typedef float f32x4 __attribute__((ext_vector_type(4)));
typedef unsigned u32x4 __attribute__((ext_vector_type(4)));
typedef float f32x2 __attribute__((ext_vector_type(2)));
typedef __bf16 bf2v __attribute__((ext_vector_type(2)));

constexpr int MTOK = 49152;
constexpr int DM = 1024;
constexpr int PW = 9216;
constexpr int QKVW = 2304;
constexpr int RESTW = 1792;
constexpr int SMEM_BYTES = 73728 + 16;
constexpr int NPH = 8;

struct Params {
  const float* xp; const float* xs;
  const float* norm_g; const float* w_in; const float* q_norm_g; const float* k_norm_g;
  const float* pool_w; const float* pool_scale; const float* sg_norm_g; const float* sg_w; const float* sg_b;
  const float* mu_rkv; const float* mu_lat; const float* w0; const float* w_up; const float* a0; const float* a_up;
  const float* k_k; const float* k_a; const float* r_k; const float* ln_g; const float* ln_b;
  const float* w_branch; const float* w_out;
  float* out;
  bf16_t* qkv; bf16_t* rest; bf16_t* ys;
  bf16_t* w1t; bf16_t* wgt; bf16_t* wbrt; bf16_t* woutt;
  float* rstd; float* pg; bf16_t* branch; bf16_t* xb; bf16_t* pnum; float* pden; unsigned* bar;
  int phase_lo, phase_hi;
  int dry, pad_;
};

__device__ __forceinline__ int get_tid() { int t = threadIdx.x; asm volatile("" : "+v"(t)); return t; }
__device__ __forceinline__ float bf2f(bf16_t v) { return __uint_as_float(((unsigned)v) << 16); }
__device__ __forceinline__ bf16_t f2bf(float f) { unsigned u = __float_as_uint(f); u += 0x7fffu + ((u >> 16) & 1u); return (bf16_t)(u >> 16); }
__device__ __forceinline__ unsigned pack2(float a, float b) { return (unsigned)f2bf(a) | ((unsigned)f2bf(b) << 16); }
__device__ __forceinline__ float sigmoidf_(float x) { return __builtin_amdgcn_rcpf(1.f + __expf(-x)); }
__device__ __forceinline__ float dpp_qx1(float v) { return __int_as_float(__builtin_amdgcn_update_dpp(0, __float_as_int(v), 0xB1, 0xF, 0xF, true)); }
__device__ __forceinline__ float dpp_qx2(float v) { return __int_as_float(__builtin_amdgcn_update_dpp(0, __float_as_int(v), 0x4E, 0xF, 0xF, true)); }
__device__ __forceinline__ float dpp_hm(float v) { return __int_as_float(__builtin_amdgcn_update_dpp(0, __float_as_int(v), 0x141, 0xF, 0xF, true)); }
__device__ __forceinline__ float wave_sum(float v) {
  v += __int_as_float(__builtin_amdgcn_update_dpp(0, __float_as_int(v), 0xB1, 0xF, 0xF, true));
  v += __int_as_float(__builtin_amdgcn_update_dpp(0, __float_as_int(v), 0x4E, 0xF, 0xF, true));
  v += __int_as_float(__builtin_amdgcn_update_dpp(0, __float_as_int(v), 0x141, 0xF, 0xF, true));
  v += __int_as_float(__builtin_amdgcn_update_dpp(0, __float_as_int(v), 0x140, 0xF, 0xF, true));
  v += __shfl_xor(v, 16); v += __shfl_xor(v, 32);
  return v;
}
__device__ __forceinline__ const float* xrow_ptr(const Params& p, int layer, int row) {
  if (layer == 0) return row < 16384 ? p.xp + (size_t)row * DM : p.xs + (size_t)(row - 16384) * DM;
  return p.out + (size_t)row * DM;
}
__device__ __forceinline__ void seq_of(int T0, int& sstart, int& slen) {
  if (T0 < 16384) { sstart = T0 & ~8191; slen = 8192; } else { sstart = 16384 + ((T0 - 16384) & ~16383); slen = 16384; }
}

__device__ void prep_xb(const Params& p, int layer) {
  const int tid = get_tid(), lane = tid & 63;
  const int gw = (blockIdx.x * 256 + tid) >> 6, nw = gridDim.x * 4;
  for (int row = gw; row < MTOK; row += nw) {
    const float4* x = (const float4*)xrow_ptr(p, layer, row);
    float ss = 0.f;
    float4 xv[4];
#pragma unroll
    for (int i = 0; i < 4; ++i) { xv[i] = x[lane + i * 64]; ss += xv[i].x * xv[i].x + xv[i].y * xv[i].y + xv[i].z * xv[i].z + xv[i].w * xv[i].w; }
    ss = wave_sum(ss);
    const float rs = rsqrtf(ss * (1.f / 1024.f) + 1e-6f);
#pragma unroll
    for (int i = 0; i < 4; ++i) { const float4 v = xv[i]; uint2 o; o.x = pack2(v.x * rs, v.y * rs); o.y = pack2(v.z * rs, v.w * rs); *(uint2*)(p.xb + (size_t)row * 1024 + (lane + i * 64) * 4) = o; }
  }
}

__device__ __forceinline__ int w1_col(int n) {
  if (n < 2304) return n; if (n < 2560) return 2560 + (n - 2304); if (n < 3072) return 3072 + (n - 2560);
  if (n < 3840) return 3840 + (n - 3072); if (n < 4096) return 4608 + (n - 3840);
  if (n < 4352) return 2304 + (n - 4096); if (n < 4608) return 2816 + (n - 4352);
  if (n < 4864) return 3584 + (n - 4608); return 4864 + (n - 4864);
}
__device__ __forceinline__ int wg_col(int n) {
  const int tn = n >> 8, c = n & 255, wn = c >> 7, nn = (c >> 4) & 7, dl = c & 15, dg = nn >> 2, b = nn & 3;
  return 5120 + b * 1024 + tn * 64 + wn * 32 + dg * 16 + dl;
}

__device__ void phase_prep(const Params& p, int layer, unsigned char* smem) {
  const int tid = get_tid(), lane = tid & 63, wave = tid >> 6;
  prep_xb(p, layer);
  const float* w_in = p.w_in + (size_t)layer * DM * PW;
  const float* ng = p.norm_g + layer * DM;
  const float* wb = p.w_branch + (size_t)layer * 4 * 256 * 1024;
  const float* wo = p.w_out + (size_t)layer * 1024 * 1024;
  bf16_t* T = (bf16_t*)smem;
  const int NT0 = 80 * 16, NT1 = 64 * 16, NT2 = 64 * 4, NT3 = 16 * 16;
  for (int tile = blockIdx.x; tile < NT0 + NT1 + NT2 + NT3; tile += gridDim.x) {
    int kind, tl = tile;
    if (tl < NT0) kind = 0; else if ((tl -= NT0) < NT1) kind = 1; else if ((tl -= NT1) < NT2) kind = 2; else { tl -= NT2; kind = 3; }
    const int nkt = kind == 2 ? 4 : 16;
    const int n0 = (tl / nkt) * 64, k0 = (tl % nkt) * 64;
    const int n = n0 + lane;
    const float* src; size_t ls; bf16_t* dst; int K;
    if (kind == 0) { src = w_in + w1_col(n); ls = PW; dst = p.w1t; K = 1024; }
    else if (kind == 1) { src = w_in + wg_col(n); ls = PW; dst = p.wgt; K = 1024; }
    else if (kind == 2) { src = wb + (size_t)(n >> 10) * 256 * 1024 + (n & 1023); ls = 1024; dst = p.wbrt; K = 256; }
    else { src = wo + n; ls = 1024; dst = p.woutt; K = 1024; }
    float v[16];
#pragma unroll
    for (int i = 0; i < 16; ++i) v[i] = src[(size_t)(k0 + wave * 16 + i) * ls];
    if (kind < 2) {
#pragma unroll
      for (int i = 0; i < 16; ++i) v[i] *= ng[k0 + wave * 16 + i];
    }
#pragma unroll
    for (int i = 0; i < 8; ++i) *(unsigned*)(T + lane * 72 + wave * 16 + 2 * i) = pack2(v[2 * i], v[2 * i + 1]);
    __syncthreads();
#pragma unroll
    for (int i = 0; i < 2; ++i) {
      const int id = tid + i * 256, nl = id >> 3, kc = id & 7;
      *(u32x4*)(dst + (size_t)(n0 + nl) * K + k0 + kc * 8) = *(const u32x4*)(T + nl * 72 + kc * 8);
    }
    __syncthreads();
  }
}

__device__ __forceinline__ int lds_off(int r, int c) { return r * 128 + ((c ^ ((r >> 1) & 7)) << 4); }

#define LAS __attribute__((address_space(3)))
constexpr int GSTAGE = 24576;
#define DMA16(G, L) __builtin_amdgcn_global_load_lds((const unsigned*)(G), (LAS unsigned*)(L), 16, 0, 0)
#define DMA_TILE(T, ST) { const size_t ko = (size_t)(T) * 64; LAS unsigned char* d_ = lds + (ST) * GSTAGE + ldsw; \
    DMA16(Ab + ko + voffA, d_); DMA16(Ab + ko + (voffA + 64u * lda2), d_ + 4096); \
    DMA16(Bb + ko + voffB, d_ + 8192); DMA16(Bb + ko + (voffB + 64u * ldb2), d_ + 12288); \
    DMA16(Bb + ko + (voffB + 128u * ldb2), d_ + 16384); DMA16(Bb + ko + (voffB + 192u * ldb2), d_ + 20480); }

__device__ __forceinline__ void gemm_compute(f32x4 (&acc)[4][8], const LAS unsigned char* a_, int aoff, int boff) {
  const LAS unsigned char* b_ = a_ + 8192;
  bf16x8 af[4], bfr[8];
#pragma unroll
  for (int m = 0; m < 4; ++m) af[m] = *(const LAS bf16x8*)(a_ + aoff + m * 1024);
#pragma unroll
  for (int n = 0; n < 8; ++n) bfr[n] = *(const LAS bf16x8*)(b_ + boff + n * 1024);
  asm volatile("" :: "v"(af[0]), "v"(af[1]), "v"(af[2]), "v"(af[3]));
#pragma unroll
  for (int m = 0; m < 4; ++m)
#pragma unroll
    for (int n = 0; n < 8; ++n) acc[m][n] = __builtin_amdgcn_mfma_f32_16x16x32_bf16(bfr[n], af[m], acc[m][n], 0, 0, 0);
}

#define DMA_HALF0(T, ST) { const size_t ko = (size_t)(T) * 64; LAS unsigned char* d_ = lds + (ST) * GSTAGE + ldsw; \
    DMA16(Ab + ko + voffA, d_); DMA16(Ab + ko + (voffA + 64u * lda2), d_ + 4096); DMA16(Bb + ko + voffB, d_ + 8192); }
#define DMA_HALF1(T, ST) { const size_t ko = (size_t)(T) * 64; LAS unsigned char* d_ = lds + (ST) * GSTAGE + ldsw; \
    DMA16(Bb + ko + (voffB + 64u * ldb2), d_ + 12288); DMA16(Bb + ko + (voffB + 128u * ldb2), d_ + 16384); DMA16(Bb + ko + (voffB + 192u * ldb2), d_ + 20480); }
__device__ __forceinline__ void gemm_core(f32x4 (&acc)[4][8], const bf16_t* Aptr, int lda, const bf16_t* Bt, int ldb, int K, unsigned char* smem) {
  const int tid = get_tid(), lane = tid & 63, wave = tid >> 6, wm = wave >> 1, wn = wave & 1;
  const int dl = lane & 15, gq = lane >> 4, swz = ((dl >> 3) & 1) * 3;
  const int aoff = (wm * 64 + dl) * 64 + ((gq ^ swz) << 4);
  const int boff = (wn * 128 + dl) * 64 + ((gq ^ swz) << 4);
  LAS unsigned char* lds = (LAS unsigned char*)smem;
  const int r0 = tid >> 2, csrc = (tid & 3) ^ (((r0 >> 3) & 1) * 3);
  const int ldsw = tid * 16;
  const unsigned lda2 = (unsigned)lda * 2u, ldb2 = (unsigned)ldb * 2u;
  const unsigned voffA = (unsigned)r0 * lda2 + csrc * 16, voffB = (unsigned)r0 * ldb2 + csrc * 16;
  const unsigned char* Ab = (const unsigned char*)Aptr; const unsigned char* Bb = (const unsigned char*)Bt;
  const int nt = K >> 5;
  DMA_TILE(0, 0) DMA_TILE(1, 1)
  int st = 0, st2 = 2;
#pragma unroll 1
  for (int t = 0; t < nt; ++t) {
    if (t + 1 < nt) asm volatile("s_waitcnt vmcnt(6)" ::: "memory"); else asm volatile("s_waitcnt vmcnt(0)" ::: "memory");
    asm volatile("" ::: "memory"); __builtin_amdgcn_s_barrier(); asm volatile("" ::: "memory");
    {
      const LAS unsigned char* a_ = lds + st * GSTAGE; const LAS unsigned char* b_ = a_ + 8192;
      bf16x8 af[4], bfr[8];
#pragma unroll
      for (int m = 0; m < 4; ++m) af[m] = *(const LAS bf16x8*)(a_ + aoff + m * 1024);
#pragma unroll
      for (int n = 0; n < 8; ++n) bfr[n] = *(const LAS bf16x8*)(b_ + boff + n * 1024);
      asm volatile("" :: "v"(af[0]), "v"(af[1]), "v"(af[2]), "v"(af[3]));
      __builtin_amdgcn_sched_barrier(0);
#pragma unroll
      for (int m = 0; m < 2; ++m)
#pragma unroll
        for (int n = 0; n < 8; ++n) acc[m][n] = __builtin_amdgcn_mfma_f32_16x16x32_bf16(bfr[n], af[m], acc[m][n], 0, 0, 0);
      __builtin_amdgcn_sched_barrier(0);
      if (t + 2 < nt) DMA_HALF0(t + 2, st2)
      __builtin_amdgcn_sched_barrier(0);
#pragma unroll
      for (int m = 2; m < 4; ++m)
#pragma unroll
        for (int n = 0; n < 8; ++n) acc[m][n] = __builtin_amdgcn_mfma_f32_16x16x32_bf16(bfr[n], af[m], acc[m][n], 0, 0, 0);
      __builtin_amdgcn_sched_barrier(0);
      if (t + 2 < nt) DMA_HALF1(t + 2, st2)
    }
    st = st == 2 ? 0 : st + 1; st2 = st2 == 2 ? 0 : st2 + 1;
  }
  asm volatile("" ::: "memory"); __builtin_amdgcn_s_barrier(); asm volatile("" ::: "memory");
}

__device__ __forceinline__ void zero_acc(f32x4 (&acc)[4][8]) {
#pragma unroll
  for (int m = 0; m < 4; ++m)
#pragma unroll
    for (int n = 0; n < 8; ++n) acc[m][n] = (f32x4){0.f, 0.f, 0.f, 0.f};
}

__device__ __forceinline__ bool tile_of(int it, int ntn, int& tm, int& tn) {
  if (gridDim.x == 256 || gridDim.x == 512) {
    const int xcd = blockIdx.x & 7, s = blockIdx.x >> 3;
    const int gmh = gridDim.x == 512 ? 16 : 8;
    const int gn_cnt = ntn >> 2, g = it * 8 + xcd;
    if (g >= (384 / gmh) * gn_cnt) return false;
    const int gm = g / gn_cnt, gn = g % gn_cnt;
    tm = gm * gmh + (s & (gmh - 1)); tn = gn * 4 + s / gmh;
    return true;
  }
  const int tile = blockIdx.x + it * gridDim.x;
  if (tile >= 384 * ntn) return false;
  tm = tile / ntn; tn = tile % ntn; return true;
}

__device__ void phase_g1(const Params& p, int layer, unsigned char* smem) {
  const int lane = get_tid() & 63, wave = get_tid() >> 6, wm = wave >> 1, wn = wave & 1;
  int tm, tn;
  for (int it = 0; tile_of(it, 20, tm, tn); ++it) {
    const int row0 = tm * 128, col0 = tn * 256;
    f32x4 acc[4][8]; zero_acc(acc);
    gemm_core(acc, p.xb + (size_t)row0 * 1024, 1024, p.w1t + (size_t)col0 * 1024, 1024, 1024, smem);
    if (col0 < 1536) {
      const float* gn = (col0 < 768 ? p.q_norm_g : p.k_norm_g) + layer * 64;
      const float sc = col0 < 768 ? 0.125f : 1.f;
#pragma unroll
      for (int m = 0; m < 4; ++m)
#pragma unroll
        for (int hh = 0; hh < 2; ++hh) {
          float ss = 0.f;
#pragma unroll
          for (int n = 0; n < 4; ++n)
#pragma unroll
            for (int j = 0; j < 4; ++j) ss += acc[m][hh * 4 + n][j] * acc[m][hh * 4 + n][j];
          ss += __shfl_xor(ss, 16); ss += __shfl_xor(ss, 32);
          const float rs = rsqrtf(ss * (1.f / 64.f) + 1e-6f) * sc;
#pragma unroll
          for (int n = 0; n < 4; ++n) {
            const f32x4 gv = *(const f32x4*)(gn + n * 16 + (lane >> 4) * 4);
#pragma unroll
            for (int j = 0; j < 4; ++j) acc[m][hh * 4 + n][j] *= rs * gv[j];
          }
        }
    }
    {
      unsigned char* wl = smem + wave * 17408;
      const bool act = col0 >= 4096;
#pragma unroll
      for (int m = 0; m < 4; ++m)
#pragma unroll
        for (int n = 0; n < 8; ++n) {
          float v0 = acc[m][n][0], v1 = acc[m][n][1], v2 = acc[m][n][2], v3 = acc[m][n][3];
          if (act) { v0 *= sigmoidf_(v0); v1 *= sigmoidf_(v1); v2 *= sigmoidf_(v2); v3 *= sigmoidf_(v3); }
          uint2 o; o.x = pack2(v0, v1); o.y = pack2(v2, v3);
          *(uint2*)(wl + (m * 16 + (lane & 15)) * 272 + (n * 16 + (lane >> 4) * 4) * 2) = o;
        }
      bf16_t* dst; int ld;
      if (col0 < QKVW) { dst = p.qkv + col0; ld = QKVW; }
      else if (col0 < 4096) { dst = p.rest + (col0 - QKVW); ld = RESTW; }
      else { dst = p.ys + (col0 - 4096); ld = 1024; }
      dst += (size_t)(row0 + wm * 64) * ld + wn * 128;
#pragma unroll
      for (int i = 0; i < 16; ++i) {
        const int id = i * 64 + lane, r = id >> 4, c16 = id & 15;
        const u32x4 v = *(const u32x4*)(wl + r * 272 + c16 * 16);
        *(u32x4*)(dst + (size_t)r * ld + c16 * 8) = v;
      }
    }
    __syncthreads();
  }
}

__device__ void phase_branch(const Params& p, unsigned char* smem) {
  const int lane = get_tid() & 63, wave = get_tid() >> 6, wm = wave >> 1, wn = wave & 1;
  int tm, tn;
  for (int it = 0; tile_of(it, 16, tm, tn); ++it) {
    const int row0 = tm * 128, col0 = tn * 256, b = tn >> 2;
    f32x4 acc[4][8]; zero_acc(acc);
    gemm_core(acc, p.ys + (size_t)row0 * 1024 + b * 256, 1024, p.wbrt + (size_t)col0 * 256, 256, 256, smem);
#pragma unroll
    for (int m = 0; m < 4; ++m) {
      const int row = row0 + wm * 64 + m * 16 + (lane & 15);
#pragma unroll
      for (int n = 0; n < 8; ++n) {
        const int colt = col0 + wn * 128 + n * 16, bb = colt >> 10, d16 = (colt & 1023) >> 4;
        uint2 o; o.x = pack2(acc[m][n][0], acc[m][n][1]); o.y = pack2(acc[m][n][2], acc[m][n][3]);
        *(uint2*)(p.branch + ((((((size_t)tm * 2 + wm) * 4 + m) * 4 + bb) * 64 + d16) * 64 + lane) * 4) = o;
      }
    }
  }
}

__device__ void phase_gate(const Params& p, int layer, unsigned char* smem) {
  const int lane = get_tid() & 63, wave = get_tid() >> 6, wm = wave >> 1, wn = wave & 1;
  int tm, tn;
  for (int it = 0; tile_of(it, 16, tm, tn); ++it) {
    const int row0 = tm * 128;
    f32x4 acc[4][8]; zero_acc(acc);
    gemm_core(acc, p.xb + (size_t)row0 * 1024, 1024, p.wgt + (size_t)tn * 256 * 1024, 1024, 1024, smem);
#pragma unroll
    for (int m = 0; m < 4; ++m) {
      const int row = row0 + wm * 64 + m * 16 + (lane & 15);
#pragma unroll
      for (int dg = 0; dg < 2; ++dg) {
        const int d = tn * 64 + wn * 32 + dg * 16 + (lane >> 4) * 4;
        float s0 = 0.f, s1 = 0.f, s2 = 0.f, s3 = 0.f;
#pragma unroll
        for (int b = 0; b < 4; ++b) {
          uint2 br = *(const uint2*)(p.branch + ((((((size_t)tm * 2 + wm) * 4 + m) * 4 + b) * 64 + (tn * 4 + wn * 2 + dg)) * 64 + lane) * 4);
          s0 += sigmoidf_(acc[m][dg * 4 + b][0]) * __uint_as_float(br.x << 16);
          s1 += sigmoidf_(acc[m][dg * 4 + b][1]) * __uint_as_float(br.x & 0xffff0000u);
          s2 += sigmoidf_(acc[m][dg * 4 + b][2]) * __uint_as_float(br.y << 16);
          s3 += sigmoidf_(acc[m][dg * 4 + b][3]) * __uint_as_float(br.y & 0xffff0000u);
        }
        uint2 o; o.x = pack2(s0, s1); o.y = pack2(s2, s3);
        *(uint2*)(p.ys + (size_t)row * 1024 + d) = o;
        asm volatile("" ::: "memory");
      }
    }
  }
}

__device__ void phase_out(const Params& p, int layer, unsigned char* smem) {
  const int lane = get_tid() & 63, wave = get_tid() >> 6, wm = wave >> 1, wn = wave & 1;
  int tm, tn;
  for (int it = 0; tile_of(it, 4, tm, tn); ++it) {
    const int row0 = tm * 128, col0 = tn * 256;
    f32x4 acc[4][8]; zero_acc(acc);
    gemm_core(acc, p.ys + (size_t)row0 * 1024, 1024, p.woutt + (size_t)col0 * 1024, 1024, 1024, smem);
#pragma unroll
    for (int m = 0; m < 4; ++m) {
      const int row = row0 + wm * 64 + m * 16 + (lane & 15);
      const float* xr = xrow_ptr(p, layer, row);
#pragma unroll
      for (int n = 0; n < 8; ++n) {
        const int col = col0 + wn * 128 + n * 16 + (lane >> 4) * 4;
        float4 xv = *(const float4*)(xr + col);
        float4 o; o.x = xv.x + acc[m][n][0]; o.y = xv.y + acc[m][n][1]; o.z = xv.z + acc[m][n][2]; o.w = xv.w + acc[m][n][3];
        if (!DRY(p)) *(float4*)(p.out + (size_t)row * 1024 + col) = o;
      }
    }
  }
}

constexpr int QS_STRIDE = 144, KS_STRIDE = 144, VT_STRIDE = 432;
struct AttnRaw { u32x4 q0, q1, ka0, kb0, va0, vb0, ka1, kb1, va1, vb1, ka2, kb2, va2, vb2, ka3, kb3, va3, vb3; };
__device__ __forceinline__ void attn_issue(const Params& p, int item, AttnRaw& R) {
  const int tid = get_tid();
  const int n = item % 12, run = item / 12, T0 = run * 64;
  const int g = n >> 2, d = g == 0 ? 1 : (g == 1 ? 4 : 16);
  int sstart, slen; seq_of(T0, sstart, slen);
  const int rho = (T0 - sstart) >> 6;
  const int r = rho % d, i0 = (rho / d) * 64;
  const int part = tid & 3;
  {
    const int q = tid >> 2;
    const int pq = d * (i0 + q) + r;
    const bf16_t* base = p.qkv + (size_t)(sstart + pq) * QKVW + n * 64 + part * 16;
    R.q0 = *(const u32x4*)base; R.q1 = *(const u32x4*)(base + 8);
  }
#define ATTN_ISSUE1(IT, KA, KB, VA, VB) { const int rr = (tid >> 2) + (IT) * 64; const int pos = d * (i0 - 64 + rr) + r; \
    const bool ok = rr < 192 && pos >= 0 && pos < slen; const u32x4 z = {0u, 0u, 0u, 0u}; KA = z; KB = z; VA = z; VB = z; \
    if (ok) { const bf16_t* base = p.qkv + (size_t)(sstart + pos) * QKVW + n * 64 + part * 16; \
      KA = *(const u32x4*)(base + 768); KB = *(const u32x4*)(base + 768 + 8); VA = *(const u32x4*)(base + 1536); VB = *(const u32x4*)(base + 1536 + 8); } }
  ATTN_ISSUE1(0, R.ka0, R.kb0, R.va0, R.vb0)
  ATTN_ISSUE1(1, R.ka1, R.kb1, R.va1, R.vb1)
  ATTN_ISSUE1(2, R.ka2, R.kb2, R.va2, R.vb2)
}

__device__ __forceinline__ void attn_item(const Params& p, int layer, int item, AttnRaw& R, int next_item, unsigned char* smem) {
  const int tid = get_tid(), lane = tid & 63, w = tid >> 6;
  const int n = item % 12, run = item / 12, T0 = run * 64;
  const int g = n >> 2, h = n & 3, d = g == 0 ? 1 : (g == 1 ? 4 : 16);
  int sstart, slen; seq_of(T0, sstart, slen);
  const int rho = (T0 - sstart) >> 6;
  const int r = rho % d, i0 = (rho / d) * 64;
  unsigned char* Qs = smem;
  unsigned char* Ks = smem + 64 * QS_STRIDE;
  unsigned char* Vt = Ks + 208 * KS_STRIDE;
  const float* kg = p.k_norm_g + layer * 64;
  const float* qg = p.q_norm_g + layer * 64;
  const int part = tid & 3;
  {
    const int q = tid >> 2;
    *(u32x4*)(Qs + q * QS_STRIDE + part * 32) = R.q0;
    *(u32x4*)(Qs + q * QS_STRIDE + part * 32 + 16) = R.q1;
  }
#define ATTN_PUT1(IT, KA, KB, VA, VB) { const int rr = (tid >> 2) + (IT) * 64; \
    if (rr < 208) { *(u32x4*)(Ks + rr * KS_STRIDE + part * 32) = KA; *(u32x4*)(Ks + rr * KS_STRIDE + part * 32 + 16) = KB; \
      const unsigned vw[8] = {VA[0], VA[1], VA[2], VA[3], VB[0], VB[1], VB[2], VB[3]}; \
      _Pragma("unroll") for (int j = 0; j < 8; ++j) { \
        *(bf16_t*)(Vt + (part * 16 + 2 * j) * VT_STRIDE + rr * 2) = (bf16_t)(vw[j] & 0xffffu); \
        *(bf16_t*)(Vt + (part * 16 + 2 * j + 1) * VT_STRIDE + rr * 2) = (bf16_t)(vw[j] >> 16); } } }
  ATTN_PUT1(0, R.ka0, R.kb0, R.va0, R.vb0)
  ATTN_PUT1(1, R.ka1, R.kb1, R.va1, R.vb1)
  ATTN_PUT1(2, R.ka2, R.kb2, R.va2, R.vb2)
  if (next_item >= 0) attn_issue(p, next_item, R);
  __syncthreads();
  const int dl = lane & 15, gq = lane >> 4;
  bf16x8 qf0 = *(const bf16x8*)(Qs + (16 * w + dl) * QS_STRIDE + gq * 16);
  bf16x8 qf1 = *(const bf16x8*)(Qs + (16 * w + dl) * QS_STRIDE + 64 + gq * 16);
  const float slope = exp2f(-8.f * (float)(n + 1) / 12.f) * (float)d;
  float pv[10][4];
  float dsum = 0.f;
#pragma unroll
  for (int j = 0; j < 4; ++j) pv[9][j] = 0.f;
#pragma unroll
  for (int t = 0; t < 9; ++t) {
    const unsigned char* kp = Ks + ((w + t) * 16 + dl) * KS_STRIDE + gq * 16;
    f32x4 sacc = {0.f, 0.f, 0.f, 0.f};
    sacc = __builtin_amdgcn_mfma_f32_16x16x32_bf16(*(const bf16x8*)kp, qf0, sacc, 0, 0, 0);
    sacc = __builtin_amdgcn_mfma_f32_16x16x32_bf16(*(const bf16x8*)(kp + 64), qf1, sacc, 0, 0, 0);
#pragma unroll
    for (int j = 0; j < 4; ++j) {
      const int m = 16 * t + 4 * gq + j - dl;
      const int kr = (w + t) * 16 + 4 * gq + j;
      const int pos = d * (i0 - 64 + kr) + r;
      const bool ok = m >= 0 && m <= 128 && pos >= 0 && pos < slen;
      const float e = ok ? __expf(sacc[j] - slope * fabsf((float)(m - 64))) : 0.f;
      pv[t][j] = e; dsum += e;
    }
  }
  f32x4 oacc[4];
#pragma unroll
  for (int dt = 0; dt < 4; ++dt) oacc[dt] = (f32x4){0.f, 0.f, 0.f, 0.f};
#pragma unroll
  for (int u = 0; u < 5; ++u) {
    union { bf16x8 v; unsigned uu[4]; } pb;
    pb.uu[0] = pack2(pv[2 * u][0], pv[2 * u][1]); pb.uu[1] = pack2(pv[2 * u][2], pv[2 * u][3]);
    pb.uu[2] = pack2(pv[2 * u + 1][0], pv[2 * u + 1][1]); pb.uu[3] = pack2(pv[2 * u + 1][2], pv[2 * u + 1][3]);
#pragma unroll
    for (int dt = 0; dt < 4; ++dt) {
      const unsigned char* vp = Vt + (dt * 16 + dl) * VT_STRIDE + ((w + 2 * u) * 16 + 4 * gq) * 2;
      union { bf16x8 v; uint2 h2[2]; } va;
      va.h2[0] = *(const uint2*)vp; va.h2[1] = u < 4 ? *(const uint2*)(vp + 32) : make_uint2(0u, 0u);
      oacc[dt] = __builtin_amdgcn_mfma_f32_16x16x32_bf16(va.v, pb.v, oacc[dt], 0, 0, 0);
    }
  }
  dsum += __shfl_xor(dsum, 16); dsum += __shfl_xor(dsum, 32);
  {
    const int ql = 16 * w + dl;
    const size_t tok = (size_t)(sstart + d * (i0 + ql) + r);
    bf16_t* np = p.pnum + (size_t)g * ((size_t)MTOK * 256) + (tok * 4 + h) * 64 + 4 * gq;
#pragma unroll
    for (int dt = 0; dt < 4; ++dt) { uint2 o; o.x = pack2(oacc[dt][0], oacc[dt][1]); o.y = pack2(oacc[dt][2], oacc[dt][3]); *(uint2*)(np + dt * 16) = o; }
    if (gq == 0) p.pden[(size_t)g * ((size_t)MTOK * 4) + tok * 4 + h] = dsum;
  }
  __syncthreads();
}

__device__ void attn_combine(const Params& p) {
  const size_t nvec = (size_t)MTOK * 64;
  for (size_t i = (size_t)blockIdx.x * 256 + get_tid(); i < nvec; i += (size_t)gridDim.x * 256) {
    const size_t th = i >> 4;
    const int e4 = (int)(i & 15);
    f32x4 a, b, c;
    { const uint2 u0 = *(const uint2*)(p.pnum + i * 4), u1 = *(const uint2*)(p.pnum + (size_t)MTOK * 256 + i * 4), u2 = *(const uint2*)(p.pnum + 2 * (size_t)MTOK * 256 + i * 4);
      a[0] = __uint_as_float(u0.x << 16); a[1] = __uint_as_float(u0.x & 0xffff0000u); a[2] = __uint_as_float(u0.y << 16); a[3] = __uint_as_float(u0.y & 0xffff0000u);
      b[0] = __uint_as_float(u1.x << 16); b[1] = __uint_as_float(u1.x & 0xffff0000u); b[2] = __uint_as_float(u1.y << 16); b[3] = __uint_as_float(u1.y & 0xffff0000u);
      c[0] = __uint_as_float(u2.x << 16); c[1] = __uint_as_float(u2.x & 0xffff0000u); c[2] = __uint_as_float(u2.y << 16); c[3] = __uint_as_float(u2.y & 0xffff0000u); }
    const float den = p.pden[th] + p.pden[(size_t)MTOK * 4 + th] + p.pden[2 * (size_t)MTOK * 4 + th];
    const float inv = 1.f / den;
    const size_t tok = th >> 2; const int h = (int)(th & 3);
    bf16_t* y = p.ys + tok * 1024 + h * 64 + e4 * 4;
    uint2 yv = *(const uint2*)y;
    float y0 = __uint_as_float(yv.x << 16), y1 = __uint_as_float(yv.x & 0xffff0000u), y2 = __uint_as_float(yv.y << 16), y3 = __uint_as_float(yv.y & 0xffff0000u);
    uint2 o; o.x = pack2(y0 * (a[0] + b[0] + c[0]) * inv, y1 * (a[1] + b[1] + c[1]) * inv); o.y = pack2(y2 * (a[2] + b[2] + c[2]) * inv, y3 * (a[3] + b[3] + c[3]) * inv);
    if (!DRY(p)) *(uint2*)y = o;
  }
}

__device__ void pool_item(const Params& p, int layer, int item, unsigned char* smem) {
  const int tid = get_tid(), lane = tid & 63, wave = tid >> 6, dl = lane & 15, gq = lane >> 4;
  const int g = item & 3, T0 = (item >> 2) * 64;
  int sstart, slen; seq_of(T0, sstart, slen);
  const int P0 = T0 - sstart;
  const int hw = 1 << g;
  float* u = (float*)smem;
  bf16_t* db = (bf16_t*)(u + 80 * 64);
  for (int i = tid; i < 80 * 64; i += 256) {
    const int rr = i >> 6, c = i & 63, pos = P0 - 8 + rr;
    u[i] = (pos >= 0 && pos < slen) ? bf2f(p.rest[(size_t)(sstart + pos) * RESTW + g * 64 + c]) : 0.f;
  }
  const float* pw = p.pool_w + ((size_t)layer * 4 + g) * 4096 + 16 * wave + dl;
  bf16x8 af[2];
#pragma unroll
  for (int ks = 0; ks < 2; ++ks) {
    union { bf16x8 v; unsigned uu[4]; } f;
#pragma unroll
    for (int e = 0; e < 4; ++e) { const int c = ks * 32 + gq * 8 + 2 * e; f.uu[e] = pack2(pw[c * 64], pw[(c + 1) * 64]); }
    af[ks] = f.v;
  }
  __syncthreads();
  for (int i = tid; i < 64 * 64; i += 256) {
    const int t = i >> 6, c = i & 63, pos = P0 + t;
    float sm = 0.f;
    for (int o = -hw; o < hw; ++o) sm += u[(t + 8 + o) * 64 + c];
    const int lo = pos - hw > 0 ? pos - hw : 0, hi = pos + hw < slen ? pos + hw : slen;
    db[t * 72 + c] = f2bf(sm / (float)(hi - lo) - u[(t + 8) * 64 + c]);
  }
  __syncthreads();
  const f32x4 sc = *(const f32x4*)(p.pool_scale + layer * 256 + g * 64 + 16 * wave + 4 * gq);
#pragma unroll
  for (int tt = 0; tt < 4; ++tt) {
    f32x4 acc = {0.f, 0.f, 0.f, 0.f};
#pragma unroll
    for (int ks = 0; ks < 2; ++ks) {
      const bf16x8 bd = *(const bf16x8*)(db + (tt * 16 + dl) * 72 + ks * 32 + gq * 8);
      acc = __builtin_amdgcn_mfma_f32_16x16x32_bf16(af[ks], bd, acc, 0, 0, 0);
    }
    bf16_t* y = p.ys + (size_t)(T0 + tt * 16 + dl) * 1024 + 256 + g * 64 + 16 * wave + 4 * gq;
    const uint2 yv = *(const uint2*)y;
    uint2 o;
    o.x = pack2(__uint_as_float(yv.x << 16) * acc[0] * sc[0], __uint_as_float(yv.x & 0xffff0000u) * acc[1] * sc[1]);
    o.y = pack2(__uint_as_float(yv.y << 16) * acc[2] * sc[2], __uint_as_float(yv.y & 0xffff0000u) * acc[3] * sc[3]);
    if (!DRY(p)) *(uint2*)y = o;
  }
  __syncthreads();
}

__device__ void sg_item(const Params& p, int layer, int item, unsigned char* smem) {
  const int tid = get_tid(), lane = tid & 63, wave = tid >> 6, dl = lane & 15, gq = lane >> 4;
  const int g = item & 3, T0 = (item >> 2) * 128;
  bf16_t* vnT = (bf16_t*)smem;
  for (int s_ = wave; s_ < 128; s_ += 4) {
    const bf16_t* vr = p.rest + (size_t)(T0 + s_) * RESTW + 512;
    float ss = 0.f; float mine = 0.f;
#pragma unroll
    for (int j = 0; j < 4; ++j) { float v = bf2f(vr[j * 64 + lane]); ss += v * v; if (j == g) mine = v; }
    ss = wave_sum(ss);
    const float rs = rsqrtf(ss * (1.f / 256.f) + 1e-6f);
    vnT[lane * 136 + s_] = f2bf(mine * rs * p.sg_norm_g[layer * 256 + g * 64 + lane]);
  }
  __syncthreads();
  const float* gw = p.sg_w + ((size_t)layer * 4 + g) * 128 * 128;
#pragma unroll 1
  for (int tt2 = 0; tt2 < 2; ++tt2) {
    const int t = (wave * 2 + tt2) * 16 + dl;
    const float* wrow = gw + t * 128 + gq * 8;
    f32x4 acc[4];
#pragma unroll
    for (int dt = 0; dt < 4; ++dt) acc[dt] = (f32x4){0.f, 0.f, 0.f, 0.f};
#pragma unroll
    for (int ks = 0; ks < 4; ++ks) {
      const f32x4 w0 = *(const f32x4*)(wrow + ks * 32), w1 = *(const f32x4*)(wrow + ks * 32 + 4);
      union { bf16x8 v; unsigned uu[4]; } bw;
      bw.uu[0] = pack2(w0[0], w0[1]); bw.uu[1] = pack2(w0[2], w0[3]); bw.uu[2] = pack2(w1[0], w1[1]); bw.uu[3] = pack2(w1[2], w1[3]);
#pragma unroll
      for (int dt = 0; dt < 4; ++dt) {
        const bf16x8 av = *(const bf16x8*)(vnT + (dt * 16 + dl) * 136 + ks * 32 + gq * 8);
        acc[dt] = __builtin_amdgcn_mfma_f32_16x16x32_bf16(av, bw.v, acc[dt], 0, 0, 0);
      }
    }
    const float bias = p.sg_b[(layer * 4 + g) * 128 + t];
#pragma unroll
    for (int dt = 0; dt < 4; ++dt) {
      const int d0 = dt * 16 + 4 * gq;
      const uint2 uv = *(const uint2*)(p.rest + (size_t)(T0 + t) * RESTW + 256 + g * 64 + d0);
      bf16_t* y = p.ys + (size_t)(T0 + t) * 1024 + 512 + g * 64 + d0;
      const uint2 yv = *(const uint2*)y;
      uint2 o;
      o.x = pack2(__uint_as_float(yv.x << 16) * __uint_as_float(uv.x << 16) * (acc[dt][0] + bias), __uint_as_float(yv.x & 0xffff0000u) * __uint_as_float(uv.x & 0xffff0000u) * (acc[dt][1] + bias));
      o.y = pack2(__uint_as_float(yv.y << 16) * __uint_as_float(uv.y << 16) * (acc[dt][2] + bias), __uint_as_float(yv.y & 0xffff0000u) * __uint_as_float(uv.y & 0xffff0000u) * (acc[dt][3] + bias));
      if (!DRY(p)) *(uint2*)y = o;
    }
  }
  __syncthreads();
}

constexpr int SBT = 16;
struct RwkvLds {
  bf16_t twb[SBT * 72], tab[SBT * 72];
  float accw[SBT * 64], acca[SBT * 64];
  float R[SBT * 64], W[SBT * 64], K[SBT * 64], V[SBT * 64], KK[SBT * 64], B[SBT * 64];
  float ot[SBT * 64];
  float bon[SBT * 64];
};

__device__ __forceinline__ float red8(float v) { v += dpp_qx1(v); v += dpp_qx2(v); v += dpp_hm(v); return v; }
__device__ __forceinline__ float red16(float v) { v = red8(v); v += __int_as_float(__builtin_amdgcn_update_dpp(0, __float_as_int(v), 0x140, 0xF, 0xF, true)); return v; }

struct ScanOps { f32x4 w0, w1, b0, b1, kk0, kk1, k0, k1, r0, r1; float2 v; };
template <bool PASS_C>
__device__ __forceinline__ ScanOps load_ops(const RwkvLds& L, int tk, int j0, int row0) {
  ScanOps o;
  o.w0 = *(const f32x4*)(L.W + tk * 64 + j0); o.w1 = *(const f32x4*)(L.W + tk * 64 + j0 + 4);
  o.b0 = *(const f32x4*)(L.B + tk * 64 + j0); o.b1 = *(const f32x4*)(L.B + tk * 64 + j0 + 4);
  o.kk0 = *(const f32x4*)(L.KK + tk * 64 + j0); o.kk1 = *(const f32x4*)(L.KK + tk * 64 + j0 + 4);
  o.k0 = *(const f32x4*)(L.K + tk * 64 + j0); o.k1 = *(const f32x4*)(L.K + tk * 64 + j0 + 4);
  if (PASS_C) { o.r0 = *(const f32x4*)(L.R + tk * 64 + j0); o.r1 = *(const f32x4*)(L.R + tk * 64 + j0 + 4); }
  else { o.r0 = o.w0; o.r1 = o.w1; }
  o.v = *(const float2*)(L.V + tk * 64 + row0);
  return o;
}

#define RAW_LOAD(SBI) { _Pragma("unroll") for (int i = 0; i < 4; ++i) { \
      const int tau = (SBI) * SBT + wave * 4 + i; \
      const int t = dir ? (t0 + 127 - tau) : (t0 + tau); \
      const bf16_t* cr = p.rest + (size_t)t * RESTW; \
      raw[i][0] = cr[768 + cidx]; raw[i][1] = cr[1024 + cidx]; raw[i][2] = cr[1280 + cidx]; raw[i][3] = cr[1536 + dir * 128 + lane]; raw[i][4] = cr[1536 + dir * 128 + 64 + lane]; \
      if (i == 0) { const int tp = dir ? t + 1 : t - 1; const bool pv = tp >= sstart && tp < send; const bf16_t* pr = p.rest + (size_t)(pv ? tp : t) * RESTW; \
        rawp[0] = pv ? pr[768 + cidx] : (bf16_t)0; rawp[1] = pv ? pr[1024 + cidx] : (bf16_t)0; rawp[2] = pv ? pr[1280 + cidx] : (bf16_t)0; \
        rawp[3] = pv ? pr[1536 + dir * 128 + lane] : (bf16_t)0; rawp[4] = pv ? pr[1536 + dir * 128 + 64 + lane] : (bf16_t)0; } } }

template <bool PASS_C>
__device__ void rwkv_job(const Params& p, int layer, int job, unsigned char* smem) {
  RwkvLds& L = *(RwkvLds*)smem;
  const int tid = get_tid(), lane = tid & 63, wave = tid >> 6;
  const int hd = job & 3, cp = job >> 2, t0 = cp * 128;
  int sstart, slen; seq_of(t0, sstart, slen);
  const int send = sstart + slen;
  const int rp = tid >> 3, jg = tid & 7, row0 = rp * 2, j0 = jg * 8;
  float* ytg0 = p.pg + ((size_t)cp * 8 + hd) * 8192;
  float* ytg1 = p.pg + ((size_t)cp * 8 + 4 + hd) * 8192;
#pragma unroll 1
  for (int dir = 0; dir < 2; ++dir) {
    const int ld = layer * 2 + dir;
    float* slot = p.pg + ((size_t)cp * 8 + dir * 4 + hd) * 8192;
    __syncthreads();
    bf16x8 wfr[2], afr[2];
    {
      const int dl_ = lane & 15, gq_ = lane >> 4;
      const float* wsrc = p.w_up + (size_t)ld * 64 * 256 + hd * 64 + 16 * wave + dl_;
      const float* asrc = p.a_up + (size_t)ld * 64 * 256 + hd * 64 + 16 * wave + dl_;
#pragma unroll
      for (int ks = 0; ks < 2; ++ks) {
        union { bf16x8 v; unsigned u[4]; } fw, fa;
#pragma unroll
        for (int e = 0; e < 4; ++e) {
          const int m = ks * 32 + gq_ * 8 + 2 * e;
          fw.u[e] = pack2(wsrc[(size_t)m * 256], wsrc[(size_t)(m + 1) * 256]);
          fa.u[e] = pack2(asrc[(size_t)m * 256], asrc[(size_t)(m + 1) * 256]);
        }
        wfr[ks] = fw.v; afr[ks] = fa.v;
      }
    }
    f32x2 S[2][4], Pst[2][4];
#pragma unroll
    for (int rr = 0; rr < 2; ++rr)
#pragma unroll
      for (int q = 0; q < 4; ++q) {
        if (PASS_C) { S[rr][q] = *(const f32x2*)(slot + 4096 + (row0 + rr) * 64 + j0 + 2 * q); Pst[rr][q] = (f32x2){0.f, 0.f}; }
        else { S[rr][q] = (f32x2){0.f, 0.f}; Pst[rr][q] = (f32x2){(row0 + rr == j0 + 2 * q) ? 1.f : 0.f, (row0 + rr == j0 + 2 * q + 1) ? 1.f : 0.f}; }
      }
    const int cidx = hd * 64 + lane;
    const float mu_r = p.mu_rkv[ld * 768 + cidx], mu_k = p.mu_rkv[ld * 768 + 256 + cidx], mu_v = p.mu_rkv[ld * 768 + 512 + cidx];
    const float mu_w = p.mu_lat[ld * 128 + lane], mu_a = p.mu_lat[ld * 128 + 64 + lane];
    const float w0v = p.w0[ld * 256 + cidx], a0v = p.a0[ld * 256 + cidx];
    const float kkv = p.k_k[ld * 256 + cidx], kav = p.k_a[ld * 256 + cidx], rkv_ = p.r_k[ld * 256 + cidx];
    bf16_t raw[4][5], rawp[5];
    RAW_LOAD(0)
#pragma unroll 1
    for (int sb = 0; sb < 128 / SBT; ++sb) {
      __syncthreads();
#pragma unroll
      for (int i = 0; i < 4; ++i) {
        const int tk = wave * 4 + i;
        const float cr_r = bf2f(raw[i][0]), cr_k = bf2f(raw[i][1]), cr_v = bf2f(raw[i][2]), cr_w = bf2f(raw[i][3]), cr_a = bf2f(raw[i][4]);
        const float pr_r = bf2f(i ? raw[i ? i - 1 : 0][0] : rawp[0]), pr_k = bf2f(i ? raw[i ? i - 1 : 0][1] : rawp[1]), pr_v = bf2f(i ? raw[i ? i - 1 : 0][2] : rawp[2]);
        const float pr_w = bf2f(i ? raw[i ? i - 1 : 0][3] : rawp[3]), pr_a = bf2f(i ? raw[i ? i - 1 : 0][4] : rawp[4]);
        L.R[tk * 64 + lane] = cr_r + (pr_r - cr_r) * mu_r;
        L.K[tk * 64 + lane] = cr_k + (pr_k - cr_k) * mu_k;
        L.V[tk * 64 + lane] = cr_v + (pr_v - cr_v) * mu_v;
        { const float xw = cr_w + (pr_w - cr_w) * mu_w; L.twb[tk * 72 + lane] = f2bf(1.f - 2.f * __builtin_amdgcn_rcpf(1.f + __expf(2.f * xw))); }
        L.tab[tk * 72 + lane] = f2bf(cr_a + (pr_a - cr_a) * mu_a);
      }
      if (sb + 1 < 128 / SBT) RAW_LOAD(sb + 1)
      __syncthreads();
      {
        const int dl_ = lane & 15, gq_ = lane >> 4;
        f32x4 dw = {0.f, 0.f, 0.f, 0.f}, da = {0.f, 0.f, 0.f, 0.f};
#pragma unroll
        for (int ks = 0; ks < 2; ++ks) {
          const bf16x8 bw = *(const bf16x8*)(L.twb + dl_ * 72 + ks * 32 + gq_ * 8);
          const bf16x8 ba = *(const bf16x8*)(L.tab + dl_ * 72 + ks * 32 + gq_ * 8);
          dw = __builtin_amdgcn_mfma_f32_16x16x32_bf16(wfr[ks], bw, dw, 0, 0, 0);
          da = __builtin_amdgcn_mfma_f32_16x16x32_bf16(afr[ks], ba, da, 0, 0, 0);
        }
        *(f32x4*)(L.accw + dl_ * 64 + 16 * wave + 4 * gq_) = dw;
        *(f32x4*)(L.acca + dl_ * 64 + 16 * wave + 4 * gq_) = da;
      }
      __syncthreads();
      float accw[4], acca[4];
#pragma unroll
      for (int i = 0; i < 4; ++i) { accw[i] = L.accw[(wave * 4 + i) * 64 + lane]; acca[i] = L.acca[(wave * 4 + i) * 64 + lane]; }
#pragma unroll
      for (int i = 0; i < 4; ++i) {
        const int tk = wave * 4 + i;
        const float wpre = w0v + accw[i];
        const float nx = -wpre;
        const float sp = fmaxf(nx, 0.f) + __logf(1.f + __expf(-fabsf(nx)));
        const float wlog = -sp - 0.5f;
        const float decay = __expf(-__expf(wlog));
        const float a = sigmoidf_(a0v + acca[i]);
        const float k = L.K[tk * 64 + lane], r = L.R[tk * 64 + lane], v = L.V[tk * 64 + lane];
        float kk = k * kkv;
        const float ss = wave_sum(kk * kk);
        kk *= rsqrtf(ss + 1e-12f);
        const float k2 = k * (1.f + (a - 1.f) * kav);
        L.W[tk * 64 + lane] = decay; L.K[tk * 64 + lane] = k2; L.KK[tk * 64 + lane] = kk; L.B[tk * 64 + lane] = kk * a;
        if (PASS_C) { const float bs = wave_sum(r * k2 * rkv_); L.bon[tk * 64 + lane] = bs * v; }
      }
      __syncthreads();
      ScanOps cur = load_ops<PASS_C>(L, 0, j0, row0);
#pragma unroll 8
      for (int tk = 0; tk < SBT; ++tk) {
        const ScanOps nx = load_ops<PASS_C>(L, (tk + 1) & (SBT - 1), j0, row0);
        const f32x2 w2[4] = {cur.w0.lo, cur.w0.hi, cur.w1.lo, cur.w1.hi};
        const f32x2 b2[4] = {cur.b0.lo, cur.b0.hi, cur.b1.lo, cur.b1.hi};
        const f32x2 kk2[4] = {cur.kk0.lo, cur.kk0.hi, cur.kk1.lo, cur.kk1.hi};
        const f32x2 k2[4] = {cur.k0.lo, cur.k0.hi, cur.k1.lo, cur.k1.hi};
        const float vr[2] = {cur.v.x, cur.v.y};
        float sa[2], sp[2] = {0.f, 0.f};
#pragma unroll
        for (int rr = 0; rr < 2; ++rr) {
          f32x2 a = S[rr][0] * kk2[0];
          a += S[rr][1] * kk2[1]; a += S[rr][2] * kk2[2]; a += S[rr][3] * kk2[3];
          sa[rr] = a.x + a.y;
          if (!PASS_C) {
            f32x2 q_ = Pst[rr][0] * kk2[0];
            q_ += Pst[rr][1] * kk2[1]; q_ += Pst[rr][2] * kk2[2]; q_ += Pst[rr][3] * kk2[3];
            sp[rr] = q_.x + q_.y;
          }
        }
        sa[0] = red8(sa[0]); sa[1] = red8(sa[1]);
        if (!PASS_C) { sp[0] = red8(sp[0]); sp[1] = red8(sp[1]); }
#pragma unroll
        for (int rr = 0; rr < 2; ++rr)
#pragma unroll
          for (int q = 0; q < 4; ++q) {
            S[rr][q] = S[rr][q] * w2[q] + (k2[q] * vr[rr] - b2[q] * sa[rr]);
            if (!PASS_C) Pst[rr][q] = Pst[rr][q] * w2[q] - b2[q] * sp[rr];
          }
        if (PASS_C) {
          const f32x2 r2[4] = {cur.r0.lo, cur.r0.hi, cur.r1.lo, cur.r1.hi};
          f32x2 oa = S[0][0] * r2[0]; oa += S[0][1] * r2[1]; oa += S[0][2] * r2[2]; oa += S[0][3] * r2[3];
          f32x2 ob = S[1][0] * r2[0]; ob += S[1][1] * r2[1]; ob += S[1][2] * r2[2]; ob += S[1][3] * r2[3];
          float o0 = red8(oa.x + oa.y), o1 = red8(ob.x + ob.y);
          if (jg == 0) { L.ot[tk * 64 + row0] = o0; L.ot[tk * 64 + row0 + 1] = o1; }
        }
        cur = nx;
      }
      if (PASS_C) {
        __syncthreads();
        const int x = tid >> 4, part = tid & 15;
        const int tk = dir ? (SBT - 1 - x) : x, tau = sb * SBT + tk;
        const int tl = dir ? (127 - tau) : tau;
        const f32x4 ov = *(const f32x4*)(L.ot + tk * 64 + part * 4);
        float o[4] = {ov[0], ov[1], ov[2], ov[3]};
        float s1 = red16(o[0] + o[1] + o[2] + o[3]);
        const float mu = s1 * (1.f / 64.f);
        float s2 = 0.f;
#pragma unroll
        for (int e = 0; e < 4; ++e) { o[e] -= mu; s2 += o[e] * o[e]; }
        s2 = red16(s2);
        const float rs = rsqrtf(s2 * (1.f / 64.f) + 64e-5f);
        const int ch = hd * 64 + part * 4;
        const f32x4 lg = *(const f32x4*)(p.ln_g + layer * 256 + ch), lb = *(const f32x4*)(p.ln_b + layer * 256 + ch);
        const f32x4 bo = *(const f32x4*)(L.bon + tk * 64 + part * 4);
        f32x4 y;
#pragma unroll
        for (int e = 0; e < 4; ++e) y[e] = o[e] * rs * lg[e] + lb[e] + bo[e];
        float* yg = (tl < 64 ? ytg0 + tl * 64 : ytg1 + (tl - 64) * 64) + part * 4;
        if (dir == 0) *(f32x4*)yg = y;
        else {
          const f32x4 y0 = *(const f32x4*)yg;
          bf16_t* yp = p.ys + (size_t)(t0 + tl) * 1024 + 768 + ch;
          const uint2 yv = *(const uint2*)yp;
          uint2 ov2;
          ov2.x = pack2(__uint_as_float(yv.x << 16) * (y[0] + y0[0]), __uint_as_float(yv.x & 0xffff0000u) * (y[1] + y0[1]));
          ov2.y = pack2(__uint_as_float(yv.y << 16) * (y[2] + y0[2]), __uint_as_float(yv.y & 0xffff0000u) * (y[3] + y0[3]));
          if (!DRY(p)) *(uint2*)yp = ov2;
        }
      }
    }
    if (!PASS_C) {
#pragma unroll
      for (int rr = 0; rr < 2; ++rr)
#pragma unroll
        for (int q = 0; q < 4; ++q) { *(f32x2*)(slot + (row0 + rr) * 64 + j0 + 2 * q) = Pst[rr][q]; *(f32x2*)(slot + 4096 + (row0 + rr) * 64 + j0 + 2 * q) = S[rr][q]; }
    }
  }
  __syncthreads();
}

__device__ void rwkv_passB(const Params& p, unsigned char* smem) {
  float* Pl = (float*)smem;
  float* Sl = Pl + 2 * 4096;
  const int tid = get_tid();
  for (int wk = blockIdx.x; wk < 128; wk += gridDim.x) {
    const int rg = wk & 3, hd = (wk >> 2) & 3, dir = (wk >> 4) & 1, seq = wk >> 5;
    const int cbase = seq == 0 ? 0 : seq == 1 ? 64 : seq == 2 ? 128 : 256;
    const int nch = seq < 2 ? 64 : 128;
    const int row = tid >> 4, jq = tid & 15;
    __syncthreads();
    for (int i = tid; i < 2 * 16 * 64; i += 256) Sl[i] = 0.f;
    float4 pf0, pf1, pf2, pf3, gf;
    {
      const int c = dir ? nch - 1 : 0;
      const float* slot = p.pg + ((size_t)(cbase + c) * 8 + dir * 4 + hd) * 8192;
      pf0 = ((const float4*)slot)[tid]; pf1 = ((const float4*)slot)[tid + 256]; pf2 = ((const float4*)slot)[tid + 512]; pf3 = ((const float4*)slot)[tid + 768];
      gf = *(const float4*)(slot + 4096 + (rg * 16 + row) * 64 + jq * 4);
    }
#pragma unroll 1
    for (int ci = 0; ci < nch; ++ci) {
      const int c = dir ? nch - 1 - ci : ci;
      float* slot = p.pg + ((size_t)(cbase + c) * 8 + dir * 4 + hd) * 8192;
      float* Pb = Pl + (ci & 1) * 4096;
      ((float4*)Pb)[tid] = pf0; ((float4*)Pb)[tid + 256] = pf1; ((float4*)Pb)[tid + 512] = pf2; ((float4*)Pb)[tid + 768] = pf3;
      float* gp = slot + 4096 + (rg * 16 + row) * 64 + jq * 4;
      float4 acc = gf;
      if (ci + 1 < nch) {
        const int c2 = dir ? nch - 2 - ci : ci + 1;
        const float* s2 = p.pg + ((size_t)(cbase + c2) * 8 + dir * 4 + hd) * 8192;
        pf0 = ((const float4*)s2)[tid]; pf1 = ((const float4*)s2)[tid + 256]; pf2 = ((const float4*)s2)[tid + 512]; pf3 = ((const float4*)s2)[tid + 768];
        gf = *(const float4*)(s2 + 4096 + (rg * 16 + row) * 64 + jq * 4);
      }
      __syncthreads();
      const float* Sc = Sl + (ci & 1) * 1024;
      const float4 sold = *(const float4*)(Sc + row * 64 + jq * 4);
#pragma unroll 4
      for (int m4 = 0; m4 < 16; ++m4) {
        const float4 s4 = *(const float4*)(Sc + row * 64 + m4 * 4);
        const float sv[4] = {s4.x, s4.y, s4.z, s4.w};
#pragma unroll
        for (int e = 0; e < 4; ++e) {
          const float4 pv = *(const float4*)(Pb + (m4 * 4 + e) * 64 + jq * 4);
          acc.x += sv[e] * pv.x; acc.y += sv[e] * pv.y; acc.z += sv[e] * pv.z; acc.w += sv[e] * pv.w;
        }
      }
      if (!DRY(p)) *(float4*)gp = sold;
      *(float4*)(Sl + ((ci + 1) & 1) * 1024 + row * 64 + jq * 4) = acc;
    }
  }
}

__device__ void phase_bmix(const Params& p, int layer, unsigned char* smem) {
  const int NA = 9216, NS = 1536, NP = 3072;
  const bool weighted = gridDim.x == 512;
  if (!weighted || blockIdx.x < 128) { __builtin_amdgcn_s_setprio(3); rwkv_passB(p, smem); __builtin_amdgcn_s_setprio(0); }
  int first, cnt, stride;
  if (weighted) {
    if (blockIdx.x >= 128) { first = (blockIdx.x - 128) * 24; cnt = 24; } else { first = 0; cnt = 0; }
    stride = 1;
  } else { first = blockIdx.x; stride = gridDim.x; cnt = (NA - first + stride - 1) / stride; if (first >= NA) cnt = 0; }
  if (cnt > 0) {
    AttnRaw R;
    attn_issue(p, first, R);
#pragma unroll 1
    for (int k = 0; k < cnt; ++k) attn_item(p, layer, first + k * stride, R, k + 1 < cnt ? first + (k + 1) * stride : -1, smem);
  }
  const int b0 = (int)blockIdx.x, bs = (int)gridDim.x;
  if (b0 >= 0) {
#pragma unroll 1
    for (int it = b0; it < NS + NP; it += bs) {
      if (it < NS) sg_item(p, layer, it, smem);
      else pool_item(p, layer, it - NS, smem);
    }
  }
}

#define XB_TMO      128
#define XB_XCNT(j)  (256  + 64 * (j))
#define XB_XSUB(j)  (1280 + 64 * (j))
#define XB_XGEN(j)  (2304 + 64 * (j))
#define XB_TOP      3328
#define XB_TOPGEN   3392
#define XCD_BAR_WORDS 3456
#define XB_SPIN_CAP (1u << 22)
__device__ __forceinline__ unsigned xb_ld(unsigned* q)              { return __hip_atomic_load(q, __ATOMIC_RELAXED, __HIP_MEMORY_SCOPE_AGENT); }
__device__ __forceinline__ unsigned xb_add(unsigned* q, unsigned v) { return __hip_atomic_fetch_add(q, v, __ATOMIC_RELAXED, __HIP_MEMORY_SCOPE_AGENT); }
__device__ __forceinline__ unsigned xb_xcc_id() { return (unsigned)__builtin_amdgcn_s_getreg((3 << 11) | 20) & 0xFu; }
#define XB_SPIN(cond, bar) do { unsigned _sp = 0; while (cond) { __builtin_amdgcn_s_sleep(0); \
    if ((++_sp & 255u) == 0u) { if (xb_ld(&(bar)[XB_TMO])) break; if (_sp > XB_SPIN_CAP) { atomicAdd(&(bar)[XB_TMO], 1u); break; } } } } while (0)
struct XcdBarrier { unsigned* bar; unsigned x; volatile LAS unsigned* st; };
__device__ __forceinline__ XcdBarrier xcd_barrier_post(unsigned* bar, volatile LAS unsigned* st) {
  XcdBarrier b; b.bar = bar; b.x = xb_xcc_id(); b.st = st;
  if (threadIdx.x == 0) (void)xb_add(&bar[XB_XCNT(b.x)], 1u);
  return b;
}
__device__ __forceinline__ void xcd_barrier_complete(unsigned* bar, unsigned x, unsigned& nloc, unsigned& nx) {
  const unsigned G = gridDim.x * gridDim.y * gridDim.z;
  unsigned sum, cnt, mine, sp = 0u;
  for (;;) {
    sum = 0u; cnt = 0u; mine = 0u;
#pragma unroll
    for (unsigned j = 0; j < 16; ++j) { const unsigned c = xb_ld(&bar[XB_XCNT(j)]); sum += c; cnt += (c > 0u) ? 1u : 0u; mine = (j == x) ? c : mine; }
    if (sum == G) break;
    __builtin_amdgcn_s_sleep(1);
    if ((++sp & 255u) == 0u) { if (xb_ld(&bar[XB_TMO])) break; if (sp > XB_SPIN_CAP) { atomicAdd(&bar[XB_TMO], 1u); break; } }
  }
  nloc = mine > 0u ? mine : 1u; nx = cnt > 0u ? cnt : 1u;
}
__device__ __forceinline__ void xcd_barrier(const XcdBarrier& b) {
  asm volatile("s_waitcnt vmcnt(0)" ::: "memory");
  __syncthreads();
  if (threadIdx.x == 0) {
    unsigned* bar = b.bar;
    __builtin_amdgcn_s_waitcnt(0);
    unsigned nloc = b.st[0], nx = b.st[1];
    if (nloc == 0u) { xcd_barrier_complete(bar, b.x, nloc, nx); b.st[0] = nloc; b.st[1] = nx; }
    const unsigned old = xb_add(&bar[XB_XSUB(b.x)], 1u);
    const unsigned gen = old / nloc;
    if (old + 1u == (gen + 1u) * nloc) {
      __builtin_amdgcn_fence(__ATOMIC_RELEASE, "agent");
      asm volatile("s_waitcnt vmcnt(0)" ::: "memory");
      const unsigned og = xb_add(&bar[XB_TOP], 1u);
      const unsigned tg = og / nx;
      if (og + 1u == (tg + 1u) * nx) xb_add(&bar[XB_TOPGEN], 1u);
      else XB_SPIN(xb_ld(&bar[XB_TOPGEN]) == tg, bar);
      __builtin_amdgcn_fence(__ATOMIC_ACQUIRE, "agent");
      xb_add(&bar[XB_XGEN(b.x)], 1u);
      asm volatile("s_waitcnt vmcnt(0)" ::: "memory");
    } else {
      XB_SPIN(xb_ld(&bar[XB_XGEN(b.x)]) == gen, bar);
      __builtin_amdgcn_fence(__ATOMIC_ACQUIRE, "agent");
      asm volatile("s_waitcnt vmcnt(0)" ::: "memory");
    }
  }
  __syncthreads();
}

__device__ __forceinline__ void run_phase(const Params& p, int layer, int sub, unsigned char* smem) {
  switch (sub) {
    case 0: phase_prep(p, layer, smem); break;
    case 1: phase_g1(p, layer, smem); break;
    case 2: for (int j = blockIdx.x; j < 1536; j += gridDim.x) rwkv_job<false>(p, layer, j, smem); break;
    case 3: phase_bmix(p, layer, smem); break;
    case 4: for (int j = blockIdx.x; j < 1536; j += gridDim.x) rwkv_job<true>(p, layer, j, smem); attn_combine(p); break;
    case 5: phase_branch(p, smem); break;
    case 6: phase_gate(p, layer, smem); break;
    case 7: phase_out(p, layer, smem); break;
  }
}
__global__ void __launch_bounds__(256, 2) mega(Params p) {
  extern __shared__ __attribute__((aligned(16))) unsigned char smem[];
  cg::grid_group grid = cg::this_grid();
  volatile LAS unsigned* bst = (volatile LAS unsigned*)((LAS unsigned char*)smem + 73728);
  if (threadIdx.x < 4) bst[threadIdx.x] = 0u;
  __syncthreads();
  const XcdBarrier xbar = xcd_barrier_post(p.bar, bst);
  for (int ph = p.phase_lo; ph < p.phase_hi; ++ph) {
    const int layer = ph / NPH, sub = ph % NPH;
#if PROBE_MASK
    for (int rep = (PROBE_MASK >> sub) & 1; rep >= 0; --rep) {
      __syncthreads(); if (get_tid() == 0) s_dry = rep; __syncthreads();
      run_phase(p, layer, sub, smem);
      if (rep) grid.sync();
    }
#else
    run_phase(p, layer, sub, smem);
#endif
    if (ph + 1 < p.phase_hi) { if (p.phase_hi < 0) grid.sync(); else xcd_barrier(xbar); }
  }
}

extern "C" void kernel_launch(void* const* d_in, const int* in_sizes, int n_in, void* d_out, int out_size, void* d_ws, size_t ws_size, hipStream_t stream) {
  static int grid_blocks = 0;
  if (!grid_blocks) {
    hipFuncSetAttribute((const void*)mega, hipFuncAttributeMaxDynamicSharedMemorySize, SMEM_BYTES);
    int dev = 0, cus = 0, per_cu = 0;
    hipGetDevice(&dev);
    hipDeviceGetAttribute(&cus, hipDeviceAttributeMultiprocessorCount, dev);
    hipOccupancyMaxActiveBlocksPerMultiprocessor(&per_cu, mega, 256, SMEM_BYTES);
    if (per_cu < 1) per_cu = 1;
    grid_blocks = cus * per_cu;
  }
  Params p{};
  p.xp = (const float*)d_in[0]; p.xs = (const float*)d_in[1];
  p.norm_g = (const float*)d_in[2]; p.w_in = (const float*)d_in[3]; p.q_norm_g = (const float*)d_in[4]; p.k_norm_g = (const float*)d_in[5];
  p.pool_w = (const float*)d_in[6]; p.pool_scale = (const float*)d_in[7]; p.sg_norm_g = (const float*)d_in[8]; p.sg_w = (const float*)d_in[9]; p.sg_b = (const float*)d_in[10];
  p.mu_rkv = (const float*)d_in[11]; p.mu_lat = (const float*)d_in[12]; p.w0 = (const float*)d_in[13]; p.w_up = (const float*)d_in[14]; p.a0 = (const float*)d_in[15]; p.a_up = (const float*)d_in[16];
  p.k_k = (const float*)d_in[17]; p.k_a = (const float*)d_in[18]; p.r_k = (const float*)d_in[19]; p.ln_g = (const float*)d_in[20]; p.ln_b = (const float*)d_in[21];
  p.w_branch = (const float*)d_in[22]; p.w_out = (const float*)d_in[23];
  p.out = (float*)d_out;
  unsigned char* ws = (unsigned char*)d_ws;
  size_t off = 0;
  p.qkv = (bf16_t*)(ws + off); off += (size_t)MTOK * QKVW * 2;
  p.rest = (bf16_t*)(ws + off); off += (size_t)MTOK * RESTW * 2;
  p.ys = (bf16_t*)(ws + off); off += (size_t)MTOK * 1024 * 2;
  p.w1t = (bf16_t*)(ws + off); off += (size_t)5120 * 1024 * 2;
  p.wgt = (bf16_t*)(ws + off); off += (size_t)4096 * 1024 * 2;
  p.wbrt = (bf16_t*)(ws + off); off += (size_t)4096 * 256 * 2;
  p.woutt = (bf16_t*)(ws + off); off += (size_t)1024 * 1024 * 2;
  p.rstd = nullptr;
  p.xb = (bf16_t*)(ws + off); off += (size_t)MTOK * 1024 * 2;
  p.pnum = (bf16_t*)(ws + off); off += (size_t)3 * MTOK * 256 * 2;
  p.pden = (float*)p.w1t;
  p.pg = (float*)(ws + off); off += (size_t)3072 * 8192 * 4;
  p.bar = (unsigned*)(ws + off); off += (size_t)XCD_BAR_WORDS * 4;
  p.branch = p.qkv;
  if (off > ws_size) { fprintf(stderr, "workspace too small: need %zu have %zu\n", off, ws_size); return; }
  (void)hipMemsetAsync(p.bar, 0, (size_t)XCD_BAR_WORDS * 4, stream);
#if MULTI_LAUNCH
  for (int ph = 0; ph < 2 * NPH; ++ph) {
    p.phase_lo = ph; p.phase_hi = ph + 1;
    hipLaunchKernelGGL(mega, dim3(grid_blocks), dim3(256), SMEM_BYTES, stream, p);
  }
#else
  p.phase_lo = 0; p.phase_hi = 2 * NPH;
  void* args[] = {&p};
  hipError_t e = hipLaunchCooperativeKernel((void*)mega, dim3(grid_blocks), dim3(256), args, SMEM_BYTES, stream);
  if (e != hipSuccess) fprintf(stderr, "cooperative launch failed: %s (grid %d)\n", hipGetErrorString(e), grid_blocks);
#endif
}
```
